# Optimizing an MI355X kernel written in HIP

```python
import math
import jax
import jax.numpy as jnp
from jax import lax
import numpy as np

D_MODEL = 2048
BATCH = 2
SEQ = 8192
DEPTH = 2

GRID_W = 64
CTX_LEN = 256
N_BRANCH = 4
BRANCH_W = D_MODEL // N_BRANCH
NORM_EPS = 1e-6
NEG_INF = -1e30
Q_BLOCK = 128

NA_DIM = 64
NA_HEADS = BRANCH_W // NA_DIM
NA_WIN_R = 8
NA_WIN_C = 16

RW_DIM = 64
RW_HEADS = BRANCH_W // RW_DIM
RW_LORA_W = 64
RW_LORA_A = 64
RW_GN_EPS = 64e-5
RW_SHIFT_W = 3 * BRANCH_W + 2 * RW_LORA_W + 2 * RW_LORA_A

SSM_HEAD_DIM = 64
SSM_HEADS = BRANCH_W // SSM_HEAD_DIM
SSM_GROUPS = 2
SSM_STATE = 128
SSM_CONV = 3
SSM_CHUNK = 128
SSM_CONV_CH = BRANCH_W + 2 * SSM_GROUPS * SSM_STATE

DA_DIM = 64
DA_HEADS = BRANCH_W // (2 * DA_DIM)
ROPE_BASE = 10000.0

BRANCH_COLS = (
    4 * BRANCH_W,
    RW_SHIFT_W + BRANCH_W,
    SSM_CONV_CH + 2 * SSM_HEADS + BRANCH_W,
    4 * BRANCH_W,
)
IN_W = sum(BRANCH_COLS)

kernel_name = 'hybrid_diffusion_trunk'

F32 = jnp.float32


def split_cols(p, sizes):
    idx = np.cumsum(sizes)[:-1].tolist()
    return jnp.split(p, idx, axis=-1)


def rms_norm(x, w, eps=NORM_EPS):
    xf = x.astype(F32)
    y = xf * lax.rsqrt(jnp.mean(xf * xf, axis=-1, keepdims=True) + eps)
    return (y * w).astype(x.dtype)


def grid_positions(length):
    t = jnp.arange(length, dtype=jnp.int32)
    return t // GRID_W, t % GRID_W


def axial_rope(x, rows, cols):
    d = x.shape[-1]
    nf = d // 4
    inv = ROPE_BASE ** (-jnp.arange(nf, dtype=F32) / nf)
    ang_r = rows.astype(F32)[:, None] * inv
    ang_c = cols.astype(F32)[:, None] * inv
    ang = jnp.concatenate([ang_r, ang_r, ang_c, ang_c], axis=-1)
    shape = (1, x.shape[1]) + (1,) * (x.ndim - 3) + (d,)
    cos = jnp.cos(ang).reshape(shape)
    sin = jnp.sin(ang).reshape(shape)
    xf = x.astype(F32)
    x1, x2, x3, x4 = jnp.split(xf, 4, axis=-1)
    rot = jnp.concatenate([-x2, x1, -x4, x3], axis=-1)
    return (xf * cos + rot * sin).astype(x.dtype)


def dense_softmax_attn(q, k, v, scale):
    s = jnp.einsum('bqhd,bkhd->bhqk', q, k).astype(F32) * scale
    p = jax.nn.softmax(s, axis=-1).astype(v.dtype)
    return jnp.einsum('bhqk,bkhe->bqhe', p, v)


def centred_token_shift(x, mu):
    xp = jnp.pad(x, ((0, 0), (1, 1), (0, 0)))
    nb = 0.5 * (xp[:, :-2] + xp[:, 2:])
    return x + (nb - x) * mu


def centred_depthwise_conv(x, w, b):
    y = lax.conv_general_dilated(x, w[:, None, :], window_strides=(1,), padding='SAME',
                                 dimension_numbers=('NWC', 'WIO', 'NWC'),
                                 feature_group_count=x.shape[-1])
    return y + b


def neighbourhood_attention(pc, px, q_norm_w, k_norm_w, rpb, need_ctx_out):
    def heads(p):
        b, l, _ = p.shape
        qkv, g = split_cols(p, (3 * BRANCH_W, BRANCH_W))
        qkv = qkv.reshape(b, l, 3, NA_HEADS, NA_DIM)
        return rms_norm(qkv[:, :, 0], q_norm_w), rms_norm(qkv[:, :, 1], k_norm_w), qkv[:, :, 2], g

    qc, kc, vc, gc = heads(pc)
    qx, kx, vx, gx = heads(px)
    scale = NA_DIM ** -0.5
    B, L = px.shape[:2]
    n_rows = L // GRID_W
    wr = min(NA_WIN_R, n_rows)
    grid = (B, n_rows, GRID_W, NA_HEADS, NA_DIM)
    qg, kg, vg = qx.reshape(grid), kx.reshape(grid), vx.reshape(grid)
    r = jnp.arange(n_rows)
    r0 = jnp.clip(r - wr // 2, 0, n_rows - wr)
    row_idx = r0[:, None] + jnp.arange(wr)[None, :]
    kb = kg[:, row_idx]
    vb = vg[:, row_idx]
    col = jnp.arange(GRID_W)
    c0 = jnp.clip(col - NA_WIN_C // 2, 0, GRID_W - NA_WIN_C)
    col_ok = (col[None, :] >= c0[:, None]) & (col[None, :] < c0[:, None] + NA_WIN_C)
    d_row = row_idx - r[:, None] + (NA_WIN_R - 1)
    d_col = jnp.clip(col[None, :] - col[:, None] + (NA_WIN_C - 1), 0, 2 * NA_WIN_C - 2)
    bias = rpb[:, d_row[:, None, :, None], d_col[None, :, None, :]]
    s_loc = jnp.einsum('brqhd,bruwhd->bhrquw', qg, kb).astype(F32) * scale + bias[None].astype(F32)
    s_loc = jnp.where(col_ok[:, None, :], s_loc, NEG_INF)
    s_ctx = jnp.einsum('brqhd,bchd->bhrqc', qg, kc).astype(F32) * scale
    n_loc = wr * GRID_W
    s = jnp.concatenate([s_loc.reshape(B, NA_HEADS, n_rows, GRID_W, n_loc), s_ctx], axis=-1)
    p = jax.nn.softmax(s, axis=-1).astype(vx.dtype)
    p_loc = p[..., :n_loc].reshape(B, NA_HEADS, n_rows, GRID_W, wr, GRID_W)
    p_ctx = p[..., n_loc:]
    ox = jnp.einsum('bhrquw,bruwhd->brqhd', p_loc, vb) + jnp.einsum('bhrqc,bchd->brqhd', p_ctx, vc)
    ox = ox.reshape(B, L, BRANCH_W) * jax.nn.silu(gx)
    oc = None
    if need_ctx_out:
        oc = dense_softmax_attn(qc, kc, vc, scale).reshape(B, pc.shape[1], BRANCH_W) * jax.nn.silu(gc)
    return oc, ox


def rwkv7_scan(s0, r, w, k, v, a, b, reverse, emit):
    def step(S, inp):
        r_t, w_t, k_t, v_t, a_t, b_t = inp
        sa = jnp.einsum('bhvk,bhk->bhv', S, a_t)
        S = S * w_t[:, :, None, :] + sa[..., None] * b_t[:, :, None, :] + v_t[..., None] * k_t[:, :, None, :]
        y = jnp.einsum('bhvk,bhk->bhv', S, r_t) if emit else None
        return S, y

    xs = tuple(jnp.moveaxis(t, 1, 0) for t in (r, w, k, v, a, b))
    s_fin, ys = lax.scan(step, s0, xs, reverse=reverse)
    return s_fin, (jnp.moveaxis(ys, 0, 1) if emit else None)


def rwkv7_time_mix(pc, px, mu, w0, w2, a0, a2, k_k, k_a, r_k, ln_w, ln_b, need_ctx_out):
    def heads(t):
        return t.reshape(t.shape[:-1] + (RW_HEADS, RW_DIM))

    def prep(p):
        b, l, _ = p.shape
        core, g = split_cols(p, (RW_SHIFT_W, BRANCH_W))
        core = centred_token_shift(core, mu)
        r, k, v, wd, ad = split_cols(core, (BRANCH_W, BRANCH_W, BRANCH_W, 2 * RW_LORA_W, 2 * RW_LORA_A))
        wd = jnp.tanh(wd.reshape(b, l, 2, RW_LORA_W))
        ad = ad.reshape(b, l, 2, RW_LORA_A)
        w_log = (w0 + jnp.einsum('bldr,drc->bldc', wd, w2)).astype(F32)
        decay = jnp.exp(-jnp.exp(-jax.nn.softplus(-w_log) - 0.5))
        a = jax.nn.sigmoid((a0 + jnp.einsum('bldr,drc->bldc', ad, a2)).astype(F32))
        kk = heads((k * k_k).astype(F32))
        kk = kk / jnp.maximum(jnp.sqrt(jnp.sum(kk * kk, axis=-1, keepdims=True)), 1e-12)
        kd = k.astype(F32)[:, :, None] * (1.0 + (a - 1.0) * k_a)
        return heads(r.astype(F32)), heads(v.astype(F32)), kk, heads(decay), heads(kd), heads(a), g

    def finish(y, r, kd, v, g):
        b, l = y.shape[:2]
        mean = jnp.mean(y, axis=-1, keepdims=True)
        var = jnp.mean(jnp.square(y - mean), axis=-1, keepdims=True)
        yn = ((y - mean) * lax.rsqrt(var + RW_GN_EPS)).reshape(b, l, BRANCH_W) * ln_w + ln_b
        bonus = jnp.sum(r[:, :, None] * kd * r_k, axis=(2, 4))[..., None] * v
        out = (yn + bonus.reshape(b, l, BRANCH_W)) * jax.nn.silu(g.astype(F32))
        return out.astype(g.dtype)

    rc, vc, kkc, wc, kdc, ac, gc = prep(pc)
    rx, vx, kkx, wx, kdx, ax, gx = prep(px)
    s_zero = jnp.zeros((px.shape[0], RW_HEADS, RW_DIM, RW_DIM), F32)
    y_x, y_c = None, None
    for d in range(2):
        rev = d == 1
        s_ctx, yc_d = rwkv7_scan(s_zero, rc, wc[:, :, d], kdc[:, :, d], vc, -kkc, kkc * ac[:, :, d], rev, need_ctx_out)
        _, yx_d = rwkv7_scan(s_ctx, rx, wx[:, :, d], kdx[:, :, d], vx, -kkx, kkx * ax[:, :, d], rev, True)
        y_x = yx_d if d == 0 else y_x + yx_d
        if need_ctx_out:
            y_c = yc_d if d == 0 else y_c + yc_d
    ox = finish(y_x, rx, kdx, vx, gx)
    oc = finish(y_c, rc, kdc, vc, gc) if need_ctx_out else None
    return oc, ox


def ssd_chunked(x, dt, A, Bm, Cm, s0, emit):
    b, l, H, P = x.shape
    N = Bm.shape[-1]
    Q = SSM_CHUNK
    nc = l // Q
    xq = (x * dt[..., None]).reshape(b, nc, Q, H, P)
    a_cum = jnp.cumsum((dt * A).reshape(b, nc, Q, H), axis=2)
    Bq = Bm.reshape(b, nc, Q, H, N)
    Cq = Cm.reshape(b, nc, Q, H, N)
    decay_end = jnp.exp(a_cum[:, :, -1:] - a_cum)
    states = jnp.einsum('bcjhn,bcjh,bcjhp->bchpn', Bq, decay_end, xq)
    chunk_decay = jnp.exp(a_cum[:, :, -1])

    def step(s, inp):
        st, dec = inp
        return s * dec[:, :, None, None] + st, s

    s_fin, s_start = lax.scan(step, s0, (jnp.moveaxis(states, 1, 0), jnp.moveaxis(chunk_decay, 1, 0)))
    if not emit:
        return None, s_fin
    s_start = jnp.moveaxis(s_start, 0, 1)
    i = jnp.arange(Q)
    causal = i[:, None] >= i[None, :]
    seg = a_cum[:, :, :, None, :] - a_cum[:, :, None, :, :]
    l_mat = jnp.exp(jnp.where(causal[:, :, None], seg, NEG_INF))
    g = jnp.einsum('bcihn,bcjhn->bcijh', Cq, Bq) * l_mat
    y = jnp.einsum('bcijh,bcjhp->bcihp', g, xq)
    y = y + jnp.einsum('bcihn,bchpn->bcihp', Cq, s_start) * jnp.exp(a_cum)[..., None]
    return y.reshape(b, l, H, P), s_fin


def mamba2_mixer(pc, px, conv_w, conv_b, dt_bias, A_log, D_skip, norm_w, need_ctx_out):
    A = -jnp.exp(A_log.astype(F32))
    rep = SSM_HEADS // SSM_GROUPS

    def prep(p):
        b, l, _ = p.shape
        xbc, dt, z = split_cols(p, (SSM_CONV_CH, 2 * SSM_HEADS, BRANCH_W))
        xbc = jax.nn.silu(centred_depthwise_conv(xbc, conv_w, conv_b)).astype(F32)
        xs, Bm, Cm = split_cols(xbc, (BRANCH_W, SSM_GROUPS * SSM_STATE, SSM_GROUPS * SSM_STATE))
        Bm = jnp.repeat(Bm.reshape(b, l, SSM_GROUPS, SSM_STATE), rep, axis=2)
        Cm = jnp.repeat(Cm.reshape(b, l, SSM_GROUPS, SSM_STATE), rep, axis=2)
        dt = jax.nn.softplus(dt.astype(F32).reshape(b, l, 2, SSM_HEADS) + dt_bias)
        return xs.reshape(b, l, SSM_HEADS, SSM_HEAD_DIM), dt, Bm, Cm, z

    def finish(y, z):
        b, l = y.shape[:2]
        g = y.reshape(b, l, BRANCH_W) * jax.nn.silu(z.astype(F32))
        g = rms_norm(g.reshape(b, l, SSM_GROUPS, BRANCH_W // SSM_GROUPS), norm_w.reshape(SSM_GROUPS, -1))
        return g.reshape(b, l, BRANCH_W).astype(z.dtype)

    xc, dtc, Bc, Cc, zc = prep(pc)
    xx, dtx, Bx, Cx, zx = prep(px)
    s_zero = jnp.zeros((px.shape[0], SSM_HEADS, SSM_HEAD_DIM, SSM_STATE), F32)
    y_x = D_skip[:, None] * xx
    y_c = D_skip[:, None] * xc if need_ctx_out else None
    for d in range(2):
        orient = (lambda t: t) if d == 0 else (lambda t: jnp.flip(t, axis=1))
        yc_d, s_ctx = ssd_chunked(orient(xc), orient(dtc[:, :, d]), A[d], orient(Bc), orient(Cc), s_zero, need_ctx_out)
        yx_d, _ = ssd_chunked(orient(xx), orient(dtx[:, :, d]), A[d], orient(Bx), orient(Cx), s_ctx, True)
        y_x = y_x + orient(yx_d)
        if need_ctx_out:
            y_c = y_c + orient(yc_d)
    ox = finish(y_x, zx)
    oc = finish(y_c, zc) if need_ctx_out else None
    return oc, ox


def diff_attention(pc, px, q_norm_w, k_norm_w, lq1, lk1, lq2, lk2, subln_w, lam_init, need_ctx_out):
    def heads(p):
        b, l, _ = p.shape
        q, k, v, g = split_cols(p, (BRANCH_W, BRANCH_W, BRANCH_W, BRANCH_W))
        q = rms_norm(q.reshape(b, l, DA_HEADS, 2, DA_DIM), q_norm_w)
        k = rms_norm(k.reshape(b, l, DA_HEADS, 2, DA_DIM), k_norm_w)
        return q, k, v.reshape(b, l, DA_HEADS, 2 * DA_DIM), g

    qc, kc, vc, gc = heads(pc)
    qx, kx, vx, gx = heads(px)
    B, L = px.shape[:2]
    rows, cols = grid_positions(L)
    qx = axial_rope(qx, rows, cols)
    kx = axial_rope(kx, rows, cols)
    lam = (jnp.exp(jnp.sum(lq1.astype(F32) * lk1.astype(F32)))
           - jnp.exp(jnp.sum(lq2.astype(F32) * lk2.astype(F32))) + lam_init)
    scale = DA_DIM ** -0.5

    def attend(q, k, v):
        s = jnp.einsum('bqhcd,bkhcd->bhcqk', q, k).astype(F32) * scale
        p = jax.nn.softmax(s, axis=-1)
        p = p[:, :, 0] - lam * p[:, :, 1]
        return jnp.einsum('bhqk,bkhe->bqhe', p.astype(v.dtype), v)

    def finish(o, g):
        b, l = o.shape[:2]
        o = rms_norm(o, subln_w) * (1.0 - lam_init)
        return o.reshape(b, l, BRANCH_W) * jax.nn.silu(g)

    k_all = jnp.concatenate([kc, kx], axis=1)
    v_all = jnp.concatenate([vc, vx], axis=1)
    q_blocks = jnp.moveaxis(qx.reshape(B, L // Q_BLOCK, Q_BLOCK, DA_HEADS, 2, DA_DIM), 1, 0)
    ox = lax.map(lambda qb: attend(qb, k_all, v_all), q_blocks)
    ox = jnp.moveaxis(ox, 0, 1).reshape(B, L, DA_HEADS, 2 * DA_DIM)
    oc = finish(attend(qc, kc, vc), gc) if need_ctx_out else None
    return oc, finish(ox, gx)


def merge_branches(h, ys, w_gate, w_up, w_out):
    acc = jax.nn.sigmoid(h @ w_gate[0]) * (ys[0] @ w_up[0])
    for i in range(1, N_BRANCH):
        acc = acc + jax.nn.sigmoid(h @ w_gate[i]) * (ys[i] @ w_up[i])
    return acc @ w_out


def setup_inputs(seed: int = 0) -> dict:
    key = jax.random.key(seed)
    keys = iter(jax.random.split(key, 64))
    D, W, Lr = D_MODEL, BRANCH_W, DEPTH

    def normal(shape, scale):
        return jax.random.normal(next(keys), shape, F32) * scale

    def gain(shape):
        return 1.0 + normal(shape, 0.02)

    dt0 = jnp.exp(jax.random.uniform(next(keys), (Lr, 2, SSM_HEADS), F32, math.log(1e-3), math.log(1e-1)))
    return {
        'x': normal((BATCH, SEQ, D), 1.0),
        'c': normal((BATCH, D), 1.0),
        'ctx': normal((BATCH, CTX_LEN, D), 1.0),
        'c_ctx': normal((D,), 1.0),
        'norm_w': gain((Lr, D)),
        'w_ada': normal((Lr, D, 3 * D), 0.5 * D ** -0.5),
        'b_ada': normal((Lr, 3 * D), 0.01),
        'w_in': normal((Lr, D, IN_W), D ** -0.5),
        'na_q_norm': gain((Lr, NA_DIM)),
        'na_k_norm': gain((Lr, NA_DIM)),
        'na_rpb': normal((Lr, NA_HEADS, 2 * NA_WIN_R - 1, 2 * NA_WIN_C - 1), 0.02),
        'rw_mu': jax.random.uniform(next(keys), (Lr, RW_SHIFT_W), F32, 0.2, 0.8),
        'rw_w0': jax.random.uniform(next(keys), (Lr, 2, W), F32, -6.0, -1.0),
        'rw_w2': normal((Lr, 2, RW_LORA_W, W), 0.1),
        'rw_a0': normal((Lr, 2, W), 0.1),
        'rw_a2': normal((Lr, 2, RW_LORA_A, W), RW_LORA_A ** -0.5),
        'rw_k_k': 0.85 + normal((Lr, W), 0.02),
        'rw_k_a': gain((Lr, W)),
        'rw_r_k': normal((Lr, RW_HEADS, RW_DIM), 0.1),
        'rw_ln_w': gain((Lr, W)),
        'rw_ln_b': normal((Lr, W), 0.01),
        'ssm_conv_w': normal((Lr, SSM_CONV, SSM_CONV_CH), SSM_CONV ** -0.5),
        'ssm_conv_b': normal((Lr, SSM_CONV_CH), 0.01),
        'ssm_dt_bias': dt0 + jnp.log(-jnp.expm1(-dt0)),
        'ssm_A_log': jnp.log(jax.random.uniform(next(keys), (Lr, 2, SSM_HEADS), F32, 1.0, 16.0)),
        'ssm_D': gain((Lr, SSM_HEADS)),
        'ssm_norm_w': gain((Lr, W)),
        'da_q_norm': gain((Lr, DA_DIM)),
        'da_k_norm': gain((Lr, DA_DIM)),
        'da_lq1': normal((Lr, DA_DIM), 0.1),
        'da_lk1': normal((Lr, DA_DIM), 0.1),
        'da_lq2': normal((Lr, DA_DIM), 0.1),
        'da_lk2': normal((Lr, DA_DIM), 0.1),
        'da_subln': gain((Lr, 2 * DA_DIM)),
        'w_gate': normal((Lr, N_BRANCH, D, D), D ** -0.5),
        'w_up': normal((Lr, N_BRANCH, W, D), W ** -0.5),
        'w_out': normal((Lr, D, D), D ** -0.5),
    }


def reference(x, c, ctx, c_ctx, norm_w, w_ada, b_ada, w_in,
              na_q_norm, na_k_norm, na_rpb,
              rw_mu, rw_w0, rw_w2, rw_a0, rw_a2, rw_k_k, rw_k_a, rw_r_k, rw_ln_w, rw_ln_b,
              ssm_conv_w, ssm_conv_b, ssm_dt_bias, ssm_A_log, ssm_D, ssm_norm_w,
              da_q_norm, da_k_norm, da_lq1, da_lk1, da_lq2, da_lk2, da_subln,
              w_gate, w_up, w_out):
    c_act = jax.nn.silu(c)
    cc_act = jax.nn.silu(c_ctx)
    xc = ctx
    for l in range(DEPTH):
        need_ctx = l < DEPTH - 1
        lam_init = 0.8 - 0.6 * math.exp(-0.3 * l)
        shift, scale, gate = jnp.split(c_act @ w_ada[l] + b_ada[l], 3, axis=-1)
        shift_c, scale_c, gate_c = jnp.split(cc_act @ w_ada[l] + b_ada[l], 3, axis=-1)
        h = rms_norm(x, norm_w[l]) * (1.0 + scale[:, None]) + shift[:, None]
        hc = rms_norm(xc, norm_w[l]) * (1.0 + scale_c) + shift_c
        pa_x, pb_x, pm_x, pd_x = split_cols(h @ w_in[l], BRANCH_COLS)
        pa_c, pb_c, pm_c, pd_c = split_cols(hc @ w_in[l], BRANCH_COLS)
        oa_c, oa_x = neighbourhood_attention(pa_c, pa_x, na_q_norm[l], na_k_norm[l], na_rpb[l], need_ctx)
        ob_c, ob_x = rwkv7_time_mix(pb_c, pb_x, rw_mu[l], rw_w0[l], rw_w2[l], rw_a0[l], rw_a2[l],
                                    rw_k_k[l], rw_k_a[l], rw_r_k[l], rw_ln_w[l], rw_ln_b[l], need_ctx)
        om_c, om_x = mamba2_mixer(pm_c, pm_x, ssm_conv_w[l], ssm_conv_b[l], ssm_dt_bias[l], ssm_A_log[l],
                                  ssm_D[l], ssm_norm_w[l], need_ctx)
        od_c, od_x = diff_attention(pd_c, pd_x, da_q_norm[l], da_k_norm[l], da_lq1[l], da_lk1[l],
                                    da_lq2[l], da_lk2[l], da_subln[l], lam_init, need_ctx)
        x = x + gate[:, None] * merge_branches(h, (oa_x, ob_x, om_x, od_x), w_gate[l], w_up[l], w_out[l])
        if need_ctx:
            xc = xc + gate_c * merge_branches(hc, (oa_c, ob_c, om_c, od_c), w_gate[l], w_up[l], w_out[l])
    return x
```

```cpp
#include <hip/hip_runtime.h>
#include <hip/hip_cooperative_groups.h>
#include <stdint.h>
#include <cstdio>
#include <cstring>
namespace cg = cooperative_groups;

typedef unsigned short bf16_t;
typedef __attribute__((ext_vector_type(8))) short bf16x8;
typedef __attribute__((ext_vector_type(4))) short s16x4;
typedef __attribute__((ext_vector_type(16))) float f32x16;
typedef __attribute__((ext_vector_type(2))) float f2v;
typedef __attribute__((ext_vector_type(4))) float f4v;
#define DI __device__ __forceinline__
#define MFMA(a, b, c) __builtin_amdgcn_mfma_f32_32x32x16_bf16((a), (b), (c), 0, 0, 0)

constexpr int DM = 2048, TPB = 8448, T = 16896, CTXL = 256;
constexpr int SPA = 1536, SPB = 2304, SPC = 1664, SPD = 1536;
constexpr int NPAD = 8064;
constexpr float LOG2E = 1.4426950408889634f;
constexpr float QS = 0.125f * LOG2E;

constexpr size_t al256(size_t x) { return (x + 255) & ~(size_t)255; }
constexpr size_t OFF_MOD = 0;
constexpr size_t OFF_CTR = al256(OFF_MOD + 2 * 3 * 6144 * 4);
constexpr size_t OFF_BAR = al256(OFF_CTR + 256);
constexpr size_t OFF_CUF = al256(OFF_BAR + 3456 * 4);
constexpr size_t OFF_ROPE = al256(OFF_CUF + 2 * 4096 * 4);
constexpr size_t OFF_BONUS = al256(OFF_ROPE + 128 * 16 * 8);
constexpr size_t OFF_MDT = al256(OFF_BONUS + (size_t)T * 64 * 4);
constexpr size_t OFF_MCB = al256(OFF_MDT + (size_t)T * 32 * 4);
constexpr size_t OFF_W3 = al256(OFF_MCB + (size_t)T * 2 * 4);
constexpr size_t OFF_LA = al256(OFF_W3 + 4 * 512 * 64 * 2);
constexpr size_t OFF_XC1 = al256(OFF_LA + (size_t)T * 256 * 2);
constexpr size_t OFF_W1 = al256(OFF_XC1 + (size_t)2 * 256 * 2048 * 4);
constexpr size_t OFF_H = al256(OFF_W1 + (size_t)NPAD * 2048 * 2);
constexpr size_t OFF_PA = al256(OFF_H + (size_t)T * 2048 * 2);
constexpr size_t OFF_PB = al256(OFF_PA + (size_t)T * SPA * 2);
constexpr size_t OFF_PC = al256(OFF_PB + (size_t)T * SPB * 2);
constexpr size_t OFF_PD = al256(OFF_PC + (size_t)T * SPC * 2);
constexpr size_t OFF_VTA = al256(OFF_PD + (size_t)T * SPD * 2);
constexpr size_t OFF_VTD = al256(OFF_VTA + (size_t)2 * 512 * TPB * 2);
constexpr size_t OFF_R1 = al256(OFF_VTD + (size_t)2 * 512 * TPB * 2);
constexpr size_t OFF_R2 = al256(OFF_R1 + (size_t)4 * T * 512 * 2);
constexpr size_t WS_NEED = al256(OFF_R2 + (size_t)4 * T * 512 * 2);
constexpr size_t R1_GATE = 0, R1_UP = (size_t)4 * 2048 * 2048 * 2, R1_OUT = R1_UP + (size_t)4 * 2048 * 512 * 2;

struct Params {
  const float* in[37];
  float* out;
  char* ws;
  int ph_lo, ph_hi;
};


typedef const __attribute__((address_space(4))) Params& CP;
DI int ltid() { int t = threadIdx.x; asm volatile("" : "+v"(t)); return t; }
DI int lbid() { int t = blockIdx.x; asm volatile("" : "+s"(t)); return t; }
DI int lgdim() { int t = gridDim.x; asm volatile("" : "+s"(t)); return t; }
#define TIDX ltid()
#define BIDX lbid()
#define GDIM lgdim()
DI CP launder_params() {
  auto kp = __builtin_amdgcn_kernarg_segment_ptr();
  asm volatile("" : "+s"(kp));
  return *(const __attribute__((address_space(4))) Params*)kp;
}


#define XB_TMO      128
#define XB_XCNT(j)  (256  + 64 * (j))
#define XB_XSUB(j)  (1280 + 64 * (j))
#define XB_XGEN(j)  (2304 + 64 * (j))
#define XB_TOP      3328
#define XB_TOPGEN   3392
#define XCD_BAR_WORDS 3456
#define XB_SPIN_CAP (1u << 22)
#define LAS __attribute__((address_space(3)))
DI unsigned xb_ld(unsigned* p) { return __hip_atomic_load(p, __ATOMIC_RELAXED, __HIP_MEMORY_SCOPE_AGENT); }
DI unsigned xb_add(unsigned* p, unsigned v) { return __hip_atomic_fetch_add(p, v, __ATOMIC_RELAXED, __HIP_MEMORY_SCOPE_AGENT); }
DI unsigned xb_xcc_id() { return (unsigned)__builtin_amdgcn_s_getreg((3 << 11) | 20) & 0xFu; }
#define XB_SPIN(cond, bar) do { unsigned _sp = 0; while (cond) { __builtin_amdgcn_s_sleep(1); \
    if ((++_sp & 255u) == 0u) { if (xb_ld(&(bar)[XB_TMO])) break; if (_sp > XB_SPIN_CAP) { atomicAdd(&(bar)[XB_TMO], 1u); break; } } } } while (0)
struct XcdBarrier { unsigned* bar; unsigned x; volatile LAS unsigned* st; };
DI XcdBarrier xcd_barrier_post(unsigned* bar, volatile LAS unsigned* st) {
  XcdBarrier b; b.bar = bar; b.x = xb_xcc_id(); b.st = st;
  if (threadIdx.x == 0) (void)xb_add(&bar[XB_XCNT(b.x)], 1u);
  return b;
}
DI void xcd_barrier_complete(unsigned* bar, unsigned x, unsigned& nloc, unsigned& nx) {
  const unsigned G = gridDim.x * gridDim.y * gridDim.z;
  unsigned sum, cnt, mine, sp = 0u;
  for (;;) {
    sum = 0u; cnt = 0u; mine = 0u;
#pragma unroll
    for (unsigned j = 0; j < 16; ++j) { const unsigned c = xb_ld(&bar[XB_XCNT(j)]); sum += c; cnt += (c > 0u) ? 1u : 0u; mine = (j == x) ? c : mine; }
    if (sum == G) break;
    __builtin_amdgcn_s_sleep(1);
    if ((++sp & 255u) == 0u) { if (xb_ld(&bar[XB_TMO])) break; if (sp > XB_SPIN_CAP) { atomicAdd(&bar[XB_TMO], 1u); break; } }
  }
  nloc = mine > 0u ? mine : 1u; nx = cnt > 0u ? cnt : 1u;
}
DI void xcd_barrier(const XcdBarrier& b) {
  asm volatile("s_waitcnt vmcnt(0)" ::: "memory");
  __syncthreads();
  if (threadIdx.x == 0) {
    unsigned* bar = b.bar;
    __builtin_amdgcn_s_waitcnt(0);
    unsigned nloc = b.st[0], nx = b.st[1];
    if (nloc == 0u) { xcd_barrier_complete(bar, b.x, nloc, nx); b.st[0] = nloc; b.st[1] = nx; }
    const unsigned old = xb_add(&bar[XB_XSUB(b.x)], 1u);
    const unsigned gen = old / nloc;
    if (old + 1u == (gen + 1u) * nloc) {
      __builtin_amdgcn_fence(__ATOMIC_RELEASE, "agent");
      asm volatile("s_waitcnt vmcnt(0)" ::: "memory");
      const unsigned og = xb_add(&bar[XB_TOP], 1u);
      const unsigned tg = og / nx;
      if (og + 1u == (tg + 1u) * nx) xb_add(&bar[XB_TOPGEN], 1u);
      else XB_SPIN(xb_ld(&bar[XB_TOPGEN]) == tg, bar);
      __builtin_amdgcn_fence(__ATOMIC_ACQUIRE, "agent");
      xb_add(&bar[XB_XGEN(b.x)], 1u);
      asm volatile("s_waitcnt vmcnt(0)" ::: "memory");
    } else {
      XB_SPIN(xb_ld(&bar[XB_XGEN(b.x)]) == gen, bar);
      __builtin_amdgcn_fence(__ATOMIC_ACQUIRE, "agent");
      asm volatile("s_waitcnt vmcnt(0)" ::: "memory");
    }
  }
  __syncthreads();
}

DI bf16_t f2bf(float x) { return __builtin_bit_cast(bf16_t, (__bf16)x); }
DI float bf2f(bf16_t h) { return __uint_as_float(((unsigned)h) << 16); }
typedef __attribute__((ext_vector_type(2))) __bf16 bf16x2_t;
DI unsigned pack2(float a, float b) { bf16x2_t v; v.x = (__bf16)a; v.y = (__bf16)b; return __builtin_bit_cast(unsigned, v); }
DI bf16x8 pack8_mfma(float a0, float a1, float a2, float a3, float a4, float a5, float a6, float a7) {
  uint4 u = make_uint4(pack2(a0, a1), pack2(a2, a3), pack2(a4, a5), pack2(a6, a7));
  return __builtin_bit_cast(bf16x8, u);
}
DI float sigmf(float x) { return __builtin_amdgcn_rcpf(1.f + __expf(-x)); }
DI float siluf(float x) { return x * sigmf(x); }
DI float dppf(float v, const int ctrl_sel) {
  int iv = __float_as_int(v), r;
  switch (ctrl_sel) {
    case 0: r = __builtin_amdgcn_update_dpp(0, iv, 0xB1, 0xf, 0xf, false); break;
    case 1: r = __builtin_amdgcn_update_dpp(0, iv, 0x4E, 0xf, 0xf, false); break;
    case 2: r = __builtin_amdgcn_update_dpp(0, iv, 0x141, 0xf, 0xf, false); break;
    default: r = __builtin_amdgcn_update_dpp(0, iv, 0x140, 0xf, 0xf, false); break;
  }
  return __int_as_float(r);
}
DI float row16_sum(float v) { v += dppf(v, 0); v += dppf(v, 1); v += dppf(v, 2); v += dppf(v, 3); return v; }
DI float wave_sum(float v) { v = row16_sum(v); v += __shfl_xor(v, 16); v += __shfl_xor(v, 32); return v; }
DI float wave_max(float v) {
  for (int o = 1; o < 64; o <<= 1) v = fmaxf(v, __shfl_xor(v, o));
  return v;
}
DI int crow(int i, int h) { return (i & 3) + 8 * (i >> 2) + 4 * h; }

struct Ptrs {
  float* mod; int* ctr; int* cuf; float* rope; float* bonus; float* mdt; float* mcb; bf16_t* W3; bf16_t* LA; float* xc1; bf16_t* W1; bf16_t* H;
  bf16_t *pA, *pB, *pC, *pD, *VtA, *VtD; bf16_t* R1; bf16_t* R2;
};
DI Ptrs mkptrs(char* ws) {
  Ptrs q;
  q.mod = (float*)(ws + OFF_MOD); q.ctr = (int*)(ws + OFF_CTR); q.rope = (float*)(ws + OFF_ROPE); q.cuf = (int*)(ws + OFF_CUF); q.bonus = (float*)(ws + OFF_BONUS); q.mdt = (float*)(ws + OFF_MDT); q.mcb = (float*)(ws + OFF_MCB);
  q.W3 = (bf16_t*)(ws + OFF_W3); q.LA = (bf16_t*)(ws + OFF_LA); q.xc1 = (float*)(ws + OFF_XC1);
  q.W1 = (bf16_t*)(ws + OFF_W1); q.H = (bf16_t*)(ws + OFF_H);
  q.pA = (bf16_t*)(ws + OFF_PA); q.pB = (bf16_t*)(ws + OFF_PB); q.pC = (bf16_t*)(ws + OFF_PC); q.pD = (bf16_t*)(ws + OFF_PD);
  q.VtA = (bf16_t*)(ws + OFF_VTA); q.VtD = (bf16_t*)(ws + OFF_VTD);
  q.R1 = (bf16_t*)(ws + OFF_R1); q.R2 = (bf16_t*)(ws + OFF_R2);
  return q;
}

DI const float* xrow(CP p, const Ptrs& w, int l, int tok) {
  int b = tok / TPB, i = tok - b * TPB;
  if (l == 0) return i < CTXL ? p.in[2] + (size_t)(b * CTXL + i) * DM : p.in[0] + (size_t)(b * 8192 + i - CTXL) * DM;
  return i < CTXL ? w.xc1 + (size_t)(b * CTXL + i) * DM : p.out + (size_t)(b * 8192 + i - CTXL) * DM;
}

DI void transpose_tile(const float* __restrict__ src, int ld_src, int k0, int n0, bool win_map, bf16_t* __restrict__ dst, int ld_dst, float* sm) {
  const int tid = TIDX;
  __syncthreads();
  {
    int cgp = (tid & 15) * 4, n = n0 + cgp;
    int ns = n;
    if (win_map) ns = n < 5904 ? n : (n < 6016 ? -1 : n - 112);
#pragma unroll
    for (int i = 0; i < 4; ++i) {
      int kk = (tid >> 4) + 16 * i;
      float4 v = make_float4(0.f, 0.f, 0.f, 0.f);
      if (ns >= 0) v = *(const float4*)(src + (size_t)(k0 + kk) * ld_src + ns);
      float* d = sm + kk * 65 + cgp;
      d[0] = v.x; d[1] = v.y; d[2] = v.z; d[3] = v.w;
    }
  }
  __syncthreads();
  {
    int n = tid >> 2, kq = (tid & 3) * 16;
    unsigned o[8];
#pragma unroll
    for (int j = 0; j < 8; ++j) o[j] = pack2(sm[(kq + 2 * j) * 65 + n], sm[(kq + 2 * j + 1) * 65 + n]);
    uint4* dp = (uint4*)(dst + (size_t)(n0 + n) * ld_dst + k0 + kq);
    dp[0] = make_uint4(o[0], o[1], o[2], o[3]);
    dp[1] = make_uint4(o[4], o[5], o[6], o[7]);
  }
}

DI void gemm_128(const bf16_t* __restrict__ A, int lda, const bf16_t* __restrict__ B, int ldb, int K, f32x16 (&acc)[2][2], bf16_t* sA, bf16_t* sB) {
  const int tid = TIDX, lane = tid & 63, wid = tid >> 6, wm = wid >> 1, wn = wid & 1, r = lane & 31, h = lane >> 5;
  const int lrow = tid >> 3, lkc = (tid & 7) * 8;
  const bf16_t* ga = A + (size_t)lrow * lda + lkc;
  const bf16_t* gb = B + (size_t)lrow * ldb + lkc;
  uint4 ra0, ra1, ra2, ra3, rb0, rb1, rb2, rb3;
  ra0 = *(const uint4*)(ga); ra1 = *(const uint4*)(ga + (size_t)32 * lda); ra2 = *(const uint4*)(ga + (size_t)64 * lda); ra3 = *(const uint4*)(ga + (size_t)96 * lda);
  rb0 = *(const uint4*)(gb); rb1 = *(const uint4*)(gb + (size_t)32 * ldb); rb2 = *(const uint4*)(gb + (size_t)64 * ldb); rb3 = *(const uint4*)(gb + (size_t)96 * ldb);
  for (int k0 = 0; k0 < K; k0 += 64) {
    __syncthreads();
    *(uint4*)(sA + (lrow) * 72 + lkc) = ra0; *(uint4*)(sA + (lrow + 32) * 72 + lkc) = ra1; *(uint4*)(sA + (lrow + 64) * 72 + lkc) = ra2; *(uint4*)(sA + (lrow + 96) * 72 + lkc) = ra3;
    *(uint4*)(sB + (lrow) * 72 + lkc) = rb0; *(uint4*)(sB + (lrow + 32) * 72 + lkc) = rb1; *(uint4*)(sB + (lrow + 64) * 72 + lkc) = rb2; *(uint4*)(sB + (lrow + 96) * 72 + lkc) = rb3;
    __syncthreads();
    if (k0 + 64 < K) {
      const bf16_t* ga2 = ga + k0 + 64; const bf16_t* gb2 = gb + k0 + 64;
      ra0 = *(const uint4*)(ga2); ra1 = *(const uint4*)(ga2 + (size_t)32 * lda); ra2 = *(const uint4*)(ga2 + (size_t)64 * lda); ra3 = *(const uint4*)(ga2 + (size_t)96 * lda);
      rb0 = *(const uint4*)(gb2); rb1 = *(const uint4*)(gb2 + (size_t)32 * ldb); rb2 = *(const uint4*)(gb2 + (size_t)64 * ldb); rb3 = *(const uint4*)(gb2 + (size_t)96 * ldb);
    }
#pragma unroll
    for (int s = 0; s < 4; ++s) {
      bf16x8 a0 = *(const bf16x8*)(sA + (wm * 64 + r) * 72 + s * 16 + h * 8);
      bf16x8 a1 = *(const bf16x8*)(sA + (wm * 64 + 32 + r) * 72 + s * 16 + h * 8);
      bf16x8 b0 = *(const bf16x8*)(sB + (wn * 64 + r) * 72 + s * 16 + h * 8);
      bf16x8 b1 = *(const bf16x8*)(sB + (wn * 64 + 32 + r) * 72 + s * 16 + h * 8);
      acc[0][0] = MFMA(a0, b0, acc[0][0]); acc[0][1] = MFMA(a0, b1, acc[0][1]);
      acc[1][0] = MFMA(a1, b0, acc[1][0]); acc[1][1] = MFMA(a1, b1, acc[1][1]);
    }
  }
}
DI void gemm_128_deep(const bf16_t* __restrict__ A, int lda, const bf16_t* __restrict__ B, int ldb, int K, f32x16 (&acc)[2][2], bf16_t* sA, bf16_t* sBunused) {
  (void)sBunused;
  const int tid = TIDX, lane = tid & 63, wid = tid >> 6, wm = wid >> 1, wn = wid & 1, r = lane & 31, h = lane >> 5;
  const int lrow = tid >> 3, lkc = (tid & 7) * 8;
  const bf16_t* ga = A + (size_t)lrow * lda + lkc;
  const bf16_t* gb = B + (size_t)lrow * ldb + lkc;
  uint4 pa0, pa1, pa2, pa3, pb0, pb1, pb2, pb3, qa0, qa1, qa2, qa3, qb0, qb1, qb2, qb3;
#define GL_P(off) { const bf16_t* x = ga + (off); const bf16_t* y = gb + (off); \
    pa0 = *(const uint4*)(x); pa1 = *(const uint4*)(x + (size_t)32 * lda); pa2 = *(const uint4*)(x + (size_t)64 * lda); pa3 = *(const uint4*)(x + (size_t)96 * lda); \
    pb0 = *(const uint4*)(y); pb1 = *(const uint4*)(y + (size_t)32 * ldb); pb2 = *(const uint4*)(y + (size_t)64 * ldb); pb3 = *(const uint4*)(y + (size_t)96 * ldb); }
#define GL_Q(off) { const bf16_t* x = ga + (off); const bf16_t* y = gb + (off); \
    qa0 = *(const uint4*)(x); qa1 = *(const uint4*)(x + (size_t)32 * lda); qa2 = *(const uint4*)(x + (size_t)64 * lda); qa3 = *(const uint4*)(x + (size_t)96 * lda); \
    qb0 = *(const uint4*)(y); qb1 = *(const uint4*)(y + (size_t)32 * ldb); qb2 = *(const uint4*)(y + (size_t)64 * ldb); qb3 = *(const uint4*)(y + (size_t)96 * ldb); }
#define ST_LDS(buf, a0, a1, a2, a3, b0, b1, b2, b3) { bf16_t* da = sA + (buf) * (2 * 128 * 72); bf16_t* db = da + 128 * 72; \
    *(uint4*)(da + (lrow) * 72 + lkc) = a0; *(uint4*)(da + (lrow + 32) * 72 + lkc) = a1; *(uint4*)(da + (lrow + 64) * 72 + lkc) = a2; *(uint4*)(da + (lrow + 96) * 72 + lkc) = a3; \
    *(uint4*)(db + (lrow) * 72 + lkc) = b0; *(uint4*)(db + (lrow + 32) * 72 + lkc) = b1; *(uint4*)(db + (lrow + 64) * 72 + lkc) = b2; *(uint4*)(db + (lrow + 96) * 72 + lkc) = b3; }
#define MMA_TILE(buf) { const bf16_t* ca = sA + (buf) * (2 * 128 * 72); const bf16_t* cb = ca + 128 * 72; \
    _Pragma("unroll") for (int s = 0; s < 4; ++s) { \
      bf16x8 a0 = *(const bf16x8*)(ca + (wm * 64 + r) * 72 + s * 16 + h * 8); \
      bf16x8 a1 = *(const bf16x8*)(ca + (wm * 64 + 32 + r) * 72 + s * 16 + h * 8); \
      bf16x8 b0 = *(const bf16x8*)(cb + (wn * 64 + r) * 72 + s * 16 + h * 8); \
      bf16x8 b1 = *(const bf16x8*)(cb + (wn * 64 + 32 + r) * 72 + s * 16 + h * 8); \
      acc[0][0] = MFMA(a0, b0, acc[0][0]); acc[0][1] = MFMA(a0, b1, acc[0][1]); \
      acc[1][0] = MFMA(a1, b0, acc[1][0]); acc[1][1] = MFMA(a1, b1, acc[1][1]); } }
  GL_P(0)
  GL_Q(64)
  __syncthreads();
  ST_LDS(0, pa0, pa1, pa2, pa3, pb0, pb1, pb2, pb3)
  GL_P(128)
  __syncthreads();
  for (int k0 = 0; k0 < K; k0 += 128) {
    MMA_TILE(0)
    ST_LDS(1, qa0, qa1, qa2, qa3, qb0, qb1, qb2, qb3)
    if (k0 + 192 < K) GL_Q(k0 + 192)
    __syncthreads();
    MMA_TILE(1)
    if (k0 + 128 < K) {
      ST_LDS(0, pa0, pa1, pa2, pa3, pb0, pb1, pb2, pb3)
      if (k0 + 256 < K) GL_P(k0 + 256)
    }
    __syncthreads();
  }
#undef GL_P
#undef GL_Q
#undef ST_LDS
#undef MMA_TILE
}
DI bool tile_map(int k, int MT, int NT, int& mt, int& nt) {
  const int gd = GDIM, b = BIDX;
  if (gd & 63) { int it = b + k * gd; if (it >= MT * NT) return false; mt = it / NT; nt = it - mt * NT; return true; }
  const int gsm = gd >> 6, x = b & 7, j = b >> 3;
  const int ngn = (NT + 7) >> 3, ngm = (MT + gsm - 1) / gsm;
  const int g = k * 8 + x;
  if (g >= ngm * ngn) return false;
  const int gm = g / ngn, gn = g - gm * ngn;
  mt = gm * gsm + (j >> 3); nt = gn * 8 + (j & 7);
  return mt < MT && nt < NT;
}
DI int tile_rounds(int MT, int NT) {
  const int gd = GDIM;
  if (gd & 63) return (MT * NT + gd - 1) / gd;
  const int gsm = gd >> 6;
  return (((NT + 7) >> 3) * ((MT + gsm - 1) / gsm) + 7) >> 3;
}
DI void zero_acc(f32x16 (&acc)[2][2]) {
#pragma unroll
  for (int a = 0; a < 2; ++a)
#pragma unroll
    for (int b = 0; b < 2; ++b)
#pragma unroll
      for (int i = 0; i < 16; ++i) acc[a][b][i] = 0.f;
}

DI void phase_ada_item(CP p, const Ptrs& w, int l, int item, int ksplit, float* sm) {
  const int tid = TIDX, lane = tid & 63, wid = tid >> 6;
  const int cgp = item % 96, kq = item / 96, j = cgp * 64 + lane;
  const int rows_w = 512 / ksplit;
  float* act = sm;
  float* red = sm + 3 * 2048;
  __syncthreads();
  for (int e = tid; e < 3 * 2048; e += 256) {
    int v = e >> 11, k = e & 2047;
    float x = v < 2 ? p.in[1][v * 2048 + k] : p.in[3][k];
    act[e] = siluf(x);
  }
  __syncthreads();
  const float* wa = p.in[5] + (size_t)l * 2048 * 6144 + j;
  float a0 = 0.f, a1 = 0.f, a2 = 0.f;
  const int kb = kq * (2048 / ksplit) + wid * rows_w;
#pragma unroll 32
  for (int k = 0; k < rows_w; ++k) {
    float wv = wa[(size_t)(kb + k) * 6144];
    a0 += act[kb + k] * wv; a1 += act[2048 + kb + k] * wv; a2 += act[4096 + kb + k] * wv;
  }
  red[(wid * 3 + 0) * 64 + lane] = a0; red[(wid * 3 + 1) * 64 + lane] = a1; red[(wid * 3 + 2) * 64 + lane] = a2;
  __syncthreads();
  if (tid < 192) {
    int v = tid >> 6, ll = tid & 63, jj = cgp * 64 + ll;
    float s = red[(0 * 3 + v) * 64 + ll] + red[(1 * 3 + v) * 64 + ll] + red[(2 * 3 + v) * 64 + ll] + red[(3 * 3 + v) * 64 + ll];
    if (ksplit == 1) w.mod[(l * 3 + v) * 6144 + jj] = s + p.in[6][l * 6144 + jj];
    else atomicAdd(&w.mod[(l * 3 + v) * 6144 + jj], kq == 0 ? s + p.in[6][l * 6144 + jj] : s);
  }
}
DI void conv_w1(CP p, const Ptrs& w, int l, float* sm) {
  const float* src = p.in[7] + (size_t)l * 2048 * 7952;
  for (int it = BIDX; it < 126 * 32; it += GDIM) {
    int nt = it >> 5, kt = it & 31;
    transpose_tile(src, 7952, kt * 64, nt * 64, true, w.W1, 2048, sm);
  }
}
DI void conv_w3(CP p, const Ptrs& w, int l, float* sm) {
  for (int it = BIDX; it < 32; it += GDIM) {
    int m = it >> 3, nt = it & 7, type = m >> 1, dir = m & 1;
    const float* src = p.in[type == 0 ? 13 : 15] + (size_t)((l * 2 + dir) * 64) * 512;
    transpose_tile(src, 512, 0, nt * 64, false, w.W3 + (size_t)m * 512 * 64, 64, sm);
  }
}
DI void conv_w2(CP p, const Ptrs& w, int l, float* sm) {
  bf16_t* gate_t = (bf16_t*)((char*)w.R1 + R1_GATE);
  bf16_t* up_t = (bf16_t*)((char*)w.R1 + R1_UP);
  bf16_t* out_t = (bf16_t*)((char*)w.R1 + R1_OUT);
  for (int it = BIDX; it < 6144; it += GDIM) {
    if (it < 4096) {
      int i = it >> 10, r = it & 1023, nt = r >> 5, kt = r & 31;
      transpose_tile(p.in[34] + (size_t)(l * 4 + i) * 2048 * 2048, 2048, kt * 64, nt * 64, false, gate_t + (size_t)i * 2048 * 2048, 2048, sm);
    } else if (it < 5120) {
      int q = it - 4096, i = q >> 8, r = q & 255, nt = r >> 3, kt = r & 7;
      transpose_tile(p.in[35] + (size_t)(l * 4 + i) * 512 * 2048, 2048, kt * 64, nt * 64, false, up_t + (size_t)i * 2048 * 512, 512, sm);
    } else {
      int r = it - 5120, nt = r >> 5, kt = r & 31;
      transpose_tile(p.in[36] + (size_t)l * 2048 * 2048, 2048, kt * 64, nt * 64, false, out_t, 2048, sm);
    }
  }
}

DI void phase_norm(CP p, const Ptrs& w, int l) {
  const int lane = TIDX & 63, gw = BIDX * 4 + (TIDX >> 6), nw = GDIM * 4;
  const float* nwt = p.in[4] + l * 2048;
  for (int tok = gw; tok < T; tok += nw) {
    int b = tok / TPB, i = tok - b * TPB, v = i < CTXL ? 2 : b;
    const float* xr = xrow(p, w, l, tok);
    const float* md = w.mod + (l * 3 + v) * 6144;
    float4 xv[8];
    float ss = 0.f;
#pragma unroll
    for (int j = 0; j < 8; ++j) { xv[j] = *(const float4*)(xr + (j * 64 + lane) * 4); ss += xv[j].x * xv[j].x + xv[j].y * xv[j].y + xv[j].z * xv[j].z + xv[j].w * xv[j].w; }
    ss = wave_sum(ss);
    float inv = rsqrtf(ss * (1.f / 2048.f) + 1e-6f);
#pragma unroll
    for (int j = 0; j < 8; ++j) {
      int c = (j * 64 + lane) * 4;
      float4 nw4 = *(const float4*)(nwt + c), sh = *(const float4*)(md + c), sc = *(const float4*)(md + 2048 + c);
      float y0 = xv[j].x * inv * nw4.x * (1.f + sc.x) + sh.x, y1 = xv[j].y * inv * nw4.y * (1.f + sc.y) + sh.y;
      float y2 = xv[j].z * inv * nw4.z * (1.f + sc.z) + sh.z, y3 = xv[j].w * inv * nw4.w * (1.f + sc.w) + sh.w;
      *(uint2*)(w.H + (size_t)tok * 2048 + c) = make_uint2(pack2(y0, y1), pack2(y2, y3));
    }
  }
}

DI void phase_inproj(CP p, const Ptrs& w, int l, bf16_t* sA, bf16_t* sB) {
  const int tid = TIDX, lane = tid & 63, wid = tid >> 6, wm = wid >> 1, wn = wid & 1, r = lane & 31, h = lane >> 5;
  const int nrounds = tile_rounds(132, 63);
  for (int kk = 0; kk < nrounds; ++kk) {
    int mt, nt;
    if (!tile_map(kk, 132, 63, mt, nt)) continue;
    int m0 = mt * 128, n0 = nt * 128;
    f32x16 acc[2][2];
    zero_acc(acc);
    gemm_128_deep(w.H + (size_t)m0 * 2048, 2048, w.W1 + (size_t)n0 * 2048, 2048, 2048, acc, sA, sB);
    bf16_t* dst = nullptr; int stride = 0, cbase = 0; bf16_t* vt = nullptr; int vbase = 0;
    if (n0 < 2048) { int sub = n0 >> 9; if (sub == 2) { vt = w.VtA; vbase = n0 - 1024; } else { dst = w.pA; stride = SPA; cbase = sub == 3 ? n0 - 512 : n0; } }
    else if (n0 < 4352) { dst = w.pB; stride = SPB; cbase = n0 - 2048; }
    else if (n0 < 6016) { dst = w.pC; stride = SPC; cbase = n0 - 4352; }
    else { int cd = n0 - 6016, sub = cd >> 9; if (sub == 2) { vt = w.VtD; vbase = cd - 1024; } else { dst = w.pD; stride = SPD; cbase = sub == 3 ? cd - 512 : cd; } }
    if (dst) {
#pragma unroll
      for (int mi = 0; mi < 2; ++mi)
#pragma unroll
        for (int ni = 0; ni < 2; ++ni)
#pragma unroll
          for (int i = 0; i < 16; ++i) {
            int row = m0 + wm * 64 + mi * 32 + crow(i, h), col = cbase + wn * 64 + ni * 32 + r;
            dst[(size_t)row * stride + col] = f2bf(acc[mi][ni][i]);
          }
    } else {
      int b = m0 / TPB, ib = m0 - b * TPB;
#pragma unroll
      for (int mi = 0; mi < 2; ++mi)
#pragma unroll
        for (int ni = 0; ni < 2; ++ni)
#pragma unroll
          for (int g = 0; g < 4; ++g) {
            int i0 = ib + wm * 64 + mi * 32 + 8 * g + 4 * h, vcol = vbase + wn * 64 + ni * 32 + r;
            *(uint2*)(vt + (size_t)(b * 512 + vcol) * TPB + i0) =
                make_uint2(pack2(acc[mi][ni][4 * g], acc[mi][ni][4 * g + 1]), pack2(acc[mi][ni][4 * g + 2], acc[mi][ni][4 * g + 3]));
          }
    }
  }
  if (l == 0) {
    __shared__ int s_ada;
    for (;;) {
      __syncthreads();
      if (TIDX == 0) s_ada = atomicAdd(&w.ctr[40], 1);
      __syncthreads();
      const int it = s_ada;
      if (it >= 96) break;
      phase_ada_item(p, w, 1, it, 1, (float*)sA);
    }
  }
}

DI float quad_sum(float v) { v += dppf(v, 0); v += dppf(v, 1); return v; }
DI float row8_sum(float v) { v += dppf(v, 0); v += dppf(v, 1); v += dppf(v, 2); return v; }
DI void unpack8(uint4 u, float* f) {
  f[0] = __uint_as_float(u.x << 16); f[1] = __uint_as_float(u.x & 0xffff0000u); f[2] = __uint_as_float(u.y << 16); f[3] = __uint_as_float(u.y & 0xffff0000u);
  f[4] = __uint_as_float(u.z << 16); f[5] = __uint_as_float(u.z & 0xffff0000u); f[6] = __uint_as_float(u.w << 16); f[7] = __uint_as_float(u.w & 0xffff0000u);
}
DI uint4 pack8(const float* f) { return make_uint4(pack2(f[0], f[1]), pack2(f[2], f[3]), pack2(f[4], f[5]), pack2(f[6], f[7])); }
DI void phase_prep(CP p, const Ptrs& w, int l) {
  const int lane = TIDX & 63, gw = BIDX * 4 + (TIDX >> 6), nw = GDIM * 4;
  const int qd = lane & 3, vec = lane >> 2;
  float wa[16], wd[16];
  {
    const float* sa = (vec < 8 ? p.in[8] : p.in[9]) + l * 64 + qd * 16;
    const float* sd = (vec < 8 ? p.in[27] : p.in[28]) + l * 64 + qd * 16;
    const float qs = vec < 8 ? QS : 1.f;
#pragma unroll
    for (int j = 0; j < 16; ++j) { wa[j] = sa[j] * qs; wd[j] = sd[j] * qs; }
  }
  float mu4[4];
#pragma unroll
  for (int j = 0; j < 4; ++j) mu4[j] = p.in[11][l * 1792 + 1536 + lane * 4 + j];
  float cwB[4][4], cwC[4][4];
#pragma unroll
  for (int j = 0; j < 4; ++j) {
#pragma unroll
    for (int q = 0; q < 3; ++q) { cwB[q][j] = p.in[21][(l * 3 + q) * 1024 + 512 + lane * 4 + j]; cwC[q][j] = p.in[21][(l * 3 + q) * 1024 + 768 + lane * 4 + j]; }
    cwB[3][j] = p.in[22][l * 1024 + 512 + lane * 4 + j]; cwC[3][j] = p.in[22][l * 1024 + 768 + lane * 4 + j];
  }
  const float dtb_l = lane < 16 ? p.in[23][l * 16 + lane] : 0.f;
  const float Aneg_l = lane < 16 ? -__expf(p.in[24][l * 16 + lane]) : 0.f;
  for (int tok = gw; tok < T; tok += nw) {
    int b = tok / TPB, i = tok - b * TPB;
    bool isx = i >= CTXL;
    int ti = i - CTXL;
    uint4* pa = (uint4*)(w.pA + (size_t)tok * SPA) + lane * 2;
    uint4* pd = (uint4*)(w.pD + (size_t)tok * SPD) + lane * 2;
    const bf16_t* rb = w.pB + (size_t)tok * SPB + 1536 + lane * 4;
    bool hp = (i != 0) && (i != CTXL), hn = (i != CTXL - 1) && (i != TPB - 1);
    uint4 a0 = pa[0], a1 = pa[1], d0 = pd[0], d1 = pd[1];
    uint2 lc = *(const uint2*)rb, lp = make_uint2(0, 0), ln = make_uint2(0, 0);
    if (hp) lp = *(const uint2*)(rb - SPB);
    if (hn) ln = *(const uint2*)(rb + SPB);
    float4 rt[8];
    if (isx) {
      const float4* tp = (const float4*)(w.rope + (size_t)((qd < 2 ? (ti >> 6) : (ti & 63)) * 32));
#pragma unroll
      for (int j = 0; j < 8; ++j) rt[j] = tp[j];
    }
    float e[16];
    unpack8(a0, e); unpack8(a1, e + 8);
    {
      float ss = 0.f;
#pragma unroll
      for (int j = 0; j < 16; ++j) ss += e[j] * e[j];
      ss = quad_sum(ss);
      float sc = rsqrtf(ss * (1.f / 64.f) + 1e-6f);
#pragma unroll
      for (int j = 0; j < 16; ++j) e[j] = e[j] * sc * wa[j];
      pa[0] = pack8(e); pa[1] = pack8(e + 8);
    }
    unpack8(d0, e); unpack8(d1, e + 8);
    {
      float ss = 0.f;
#pragma unroll
      for (int j = 0; j < 16; ++j) ss += e[j] * e[j];
      ss = quad_sum(ss);
      float sc = rsqrtf(ss * (1.f / 64.f) + 1e-6f);
#pragma unroll
      for (int j = 0; j < 16; ++j) e[j] = e[j] * sc * wd[j];
      if (isx) {
#pragma unroll
        for (int j = 0; j < 16; ++j) {
          float pr = dppf(e[j], 0);
          float cs = (j & 1) ? rt[j >> 1].z : rt[j >> 1].x, sn = (j & 1) ? rt[j >> 1].w : rt[j >> 1].y;
          e[j] = e[j] * cs + ((qd & 1) ? pr : -pr) * sn;
        }
      }
      pd[0] = pack8(e); pd[1] = pack8(e + 8);
    }
    {
      const bf16_t* rc = w.pC + (size_t)tok * SPC;
      uint2 bc = *(const uint2*)(rc + 512 + lane * 4), cc = *(const uint2*)(rc + 768 + lane * 4);
      uint2 bp = make_uint2(0, 0), bn = make_uint2(0, 0), cp = make_uint2(0, 0), cn = make_uint2(0, 0);
      if (hp) { bp = *(const uint2*)(rc + 512 + lane * 4 - SPC); cp = *(const uint2*)(rc + 768 + lane * 4 - SPC); }
      if (hn) { bn = *(const uint2*)(rc + 512 + lane * 4 + SPC); cn = *(const uint2*)(rc + 768 + lane * 4 + SPC); }
      float dtraw = lane < 16 ? bf2f(rc[1024 + lane]) : 0.f;
      float Bc[4] = {__uint_as_float(bc.x << 16), __uint_as_float(bc.x & 0xffff0000u), __uint_as_float(bc.y << 16), __uint_as_float(bc.y & 0xffff0000u)};
      float Bp[4] = {__uint_as_float(bp.x << 16), __uint_as_float(bp.x & 0xffff0000u), __uint_as_float(bp.y << 16), __uint_as_float(bp.y & 0xffff0000u)};
      float Bn[4] = {__uint_as_float(bn.x << 16), __uint_as_float(bn.x & 0xffff0000u), __uint_as_float(bn.y << 16), __uint_as_float(bn.y & 0xffff0000u)};
      float Cc[4] = {__uint_as_float(cc.x << 16), __uint_as_float(cc.x & 0xffff0000u), __uint_as_float(cc.y << 16), __uint_as_float(cc.y & 0xffff0000u)};
      float Cp[4] = {__uint_as_float(cp.x << 16), __uint_as_float(cp.x & 0xffff0000u), __uint_as_float(cp.y << 16), __uint_as_float(cp.y & 0xffff0000u)};
      float Cn[4] = {__uint_as_float(cn.x << 16), __uint_as_float(cn.x & 0xffff0000u), __uint_as_float(cn.y << 16), __uint_as_float(cn.y & 0xffff0000u)};
      float ob[4], oc[4], prod = 0.f;
#pragma unroll
      for (int j = 0; j < 4; ++j) {
        ob[j] = bf2f(f2bf(siluf(cwB[0][j] * Bp[j] + cwB[1][j] * Bc[j] + cwB[2][j] * Bn[j] + cwB[3][j])));
        oc[j] = bf2f(f2bf(siluf(cwC[0][j] * Cp[j] + cwC[1][j] * Cc[j] + cwC[2][j] * Cn[j] + cwC[3][j])));
        prod += ob[j] * oc[j];
      }
      prod = row16_sum(prod); prod += __shfl_xor(prod, 16);
      bf16_t* mb = w.W1 + (size_t)tok * 512;
      *(uint2*)(mb + lane * 4) = make_uint2(pack2(ob[0], ob[1]), pack2(ob[2], ob[3]));
      *(uint2*)(mb + 256 + lane * 4) = make_uint2(pack2(oc[0], oc[1]), pack2(oc[2], oc[3]));
      if ((lane & 31) == 0) w.mcb[(size_t)tok * 2 + (lane >> 5)] = prod;
      if (lane < 16) {
        float dr = dtraw + dtb_l;
        float dt = dr > 20.f ? dr : log1pf(__expf(dr));
        *(float2*)(w.mdt + ((size_t)tok * 16 + lane) * 2) = make_float2(dt, __expf(dt * Aneg_l));
      }
    }
    {
      float c4[4] = {__uint_as_float(lc.x << 16), __uint_as_float(lc.x & 0xffff0000u), __uint_as_float(lc.y << 16), __uint_as_float(lc.y & 0xffff0000u)};
      float p4[4] = {__uint_as_float(lp.x << 16), __uint_as_float(lp.x & 0xffff0000u), __uint_as_float(lp.y << 16), __uint_as_float(lp.y & 0xffff0000u)};
      float n4[4] = {__uint_as_float(ln.x << 16), __uint_as_float(ln.x & 0xffff0000u), __uint_as_float(ln.y << 16), __uint_as_float(ln.y & 0xffff0000u)};
      float o[4];
#pragma unroll
      for (int j = 0; j < 4; ++j) { float sft = c4[j] + (0.5f * (p4[j] + n4[j]) - c4[j]) * mu4[j]; o[j] = lane < 32 ? tanhf(sft) : sft; }
      *(uint2*)(w.LA + (size_t)tok * 256 + lane * 4) = make_uint2(pack2(o[0], o[1]), pack2(o[2], o[3]));
    }
  }
}

DI void phase_lora(CP p, const Ptrs& w, int l, bf16_t* sA, bf16_t* sB) {
  const int tid = TIDX, lane = tid & 63, wid = tid >> 6, wm = wid >> 1, wn = wid & 1, r = lane & 31, h = lane >> 5;
  for (int it = BIDX; it < 132 * 16; it += GDIM) {
    int mt = it >> 4, q = it & 15, m = q >> 2, nt = q & 3, type = m >> 1, dir = m & 1, m0 = mt * 128, n0 = nt * 128;
    f32x16 acc[2][2];
    zero_acc(acc);
    gemm_128(w.LA + (size_t)m0 * 256 + m * 64, 256, w.W3 + (size_t)(m * 512 + n0) * 64, 64, 64, acc, sA, sB);
    const float* bias = p.in[type == 0 ? 12 : 14] + (l * 2 + dir) * 512;
    bf16_t* dst = w.R1 + (size_t)m * T * 512;
#pragma unroll
    for (int mi = 0; mi < 2; ++mi)
#pragma unroll
      for (int ni = 0; ni < 2; ++ni) {
        int col = n0 + wn * 64 + ni * 32 + r;
        float bc = bias[col];
#pragma unroll
        for (int i = 0; i < 16; ++i) {
          int row = m0 + wm * 64 + mi * 32 + crow(i, h);
          float x = acc[mi][ni][i] + bc, o;
          if (type == 0) o = 1.f - __expf(-0.6065306597126334f * sigmf(x));
          else o = sigmf(x);
          dst[(size_t)row * 512 + col] = f2bf(o);
        }
      }
  }
}

DI void phase_rwscal(CP p, const Ptrs& w, int l) {
  const int lane = TIDX & 63, gw = BIDX * 4 + (TIDX >> 6), nw = GDIM * 4;
  const int c0 = lane * 8, hd = lane >> 3;
  float mur[8], muk[8], kkc[8], kac[8], rkc[8];
#pragma unroll
  for (int j = 0; j < 8; ++j) {
    mur[j] = p.in[11][l * 1792 + c0 + j]; muk[j] = p.in[11][l * 1792 + 512 + c0 + j];
    kkc[j] = p.in[16][l * 512 + c0 + j]; kac[j] = p.in[17][l * 512 + c0 + j]; rkc[j] = p.in[18][l * 512 + c0 + j];
  }
  const bf16_t* Ad0 = w.R1 + (size_t)2 * T * 512, *Ad1 = w.R1 + (size_t)3 * T * 512;
  for (int tok = gw; tok < T; tok += nw) {
    int b = tok / TPB, i = tok - b * TPB;
    bool hp = (i != 0) && (i != CTXL), hn = (i != CTXL - 1) && (i != TPB - 1);
    const bf16_t* rb = w.pB + (size_t)tok * SPB + c0;
    uint4 ur = *(const uint4*)rb, uk = *(const uint4*)(rb + 512);
    uint4 urp = make_uint4(0, 0, 0, 0), urn = urp, ukp = urp, ukn = urp;
    if (hp) { urp = *(const uint4*)(rb - SPB); ukp = *(const uint4*)(rb + 512 - SPB); }
    if (hn) { urn = *(const uint4*)(rb + SPB); ukn = *(const uint4*)(rb + 512 + SPB); }
    uint4 ua0 = *(const uint4*)(Ad0 + (size_t)tok * 512 + c0), ua1 = *(const uint4*)(Ad1 + (size_t)tok * 512 + c0);
    float r[8], k[8], t0[8], t1[8];
    unpack8(ur, r); unpack8(urp, t0); unpack8(urn, t1);
#pragma unroll
    for (int j = 0; j < 8; ++j) r[j] = r[j] + (0.5f * (t0[j] + t1[j]) - r[j]) * mur[j];
    unpack8(uk, k); unpack8(ukp, t0); unpack8(ukn, t1);
    float ss = 0.f;
#pragma unroll
    for (int j = 0; j < 8; ++j) { k[j] = k[j] + (0.5f * (t0[j] + t1[j]) - k[j]) * muk[j]; float kv = k[j] * kkc[j]; ss += kv * kv; }
    ss = row8_sum(ss);
    float inv = 1.f / fmaxf(sqrtf(ss), 1e-12f);
    unpack8(ua0, t0); unpack8(ua1, t1);
    float br0 = 0.f, kr0 = 0.f, bo0 = 0.f, br1 = 0.f, kr1 = 0.f, bo1 = 0.f;
#pragma unroll
    for (int j = 0; j < 8; ++j) {
      float kk = k[j] * kkc[j] * inv;
      float kd0 = k[j] * (1.f + (t0[j] - 1.f) * kac[j]), kd1 = k[j] * (1.f + (t1[j] - 1.f) * kac[j]);
      br0 += kk * t0[j] * r[j]; br1 += kk * t1[j] * r[j];
      kr0 += kd0 * r[j]; kr1 += kd1 * r[j];
      bo0 += r[j] * kd0 * rkc[j]; bo1 += r[j] * kd1 * rkc[j];
    }
    br0 = row8_sum(br0); br1 = row8_sum(br1); kr0 = row8_sum(kr0); kr1 = row8_sum(kr1); bo0 = row8_sum(bo0); bo1 = row8_sum(bo1);
    if ((lane & 7) == 0) {
      float4* dst = (float4*)(w.bonus + ((size_t)tok * 8 + hd) * 8);
      dst[0] = make_float4(inv, br0, kr0, bo0);
      dst[1] = make_float4(br1, kr1, bo1, 0.f);
    }
  }
}

DI int pos2i(int pos, int dir) { return dir == 0 ? pos : (pos < CTXL ? CTXL - 1 - pos : (TPB + CTXL - 1) - pos); }

DI void rwkv_scan(CP p, const Ptrs& w, int l, int item, float* sm) {
  const int tid = TIDX, lane = tid & 63, wid = tid >> 6;
  const int chain = item >> 2, rq = item & 3, b = chain >> 4, hd = (chain >> 1) & 7, dir = chain & 1;
  const int sj = tid >> 4, skq = (tid & 15) * 4, sc_ = hd * 64 + skq;
  float mu_r[4], mu_k[4], mu_v[4], kk_c[4], ka_c[4];
#pragma unroll
  for (int j = 0; j < 4; ++j) {
    mu_r[j] = p.in[11][l * 1792 + sc_ + j]; mu_k[j] = p.in[11][l * 1792 + 512 + sc_ + j]; mu_v[j] = p.in[11][l * 1792 + 1024 + sc_ + j];
    kk_c[j] = p.in[16][l * 512 + sc_ + j]; ka_c[j] = p.in[17][l * 512 + sc_ + j];
  }
  const bf16_t* Wd = w.R1 + (size_t)(0 * 2 + dir) * T * 512;
  const bf16_t* Ad = w.R1 + (size_t)(1 * 2 + dir) * T * 512;
  bf16_t* yout = w.R2 + (size_t)dir * T * 512;
  constexpr int BUF = 6 * 1024 + 32;
  const int kg = lane & 15, rs = lane >> 4, row = rq * 16 + wid * 4 + rs;
  f2v SA = {0.f, 0.f}, SB = {0.f, 0.f};
  struct RPre { uint2 pq[3][3], pwd, pad_; float psc[3], pmk[2]; };
  RPre PA, PB;
  auto load = [&](int c, RPre& P) {
    int ii = pos2i(c * 16 + sj, dir);
    size_t tok = (size_t)b * TPB + ii;
    const bf16_t* prow = w.pB + tok * SPB + sc_;
    bool hp = (ii != 0) && (ii != CTXL), hn = (ii != CTXL - 1) && (ii != TPB - 1);
    const int op = hp ? -SPB : 0, on = hn ? SPB : 0;
    P.pmk[0] = hp ? 0.5f : 0.f; P.pmk[1] = hn ? 0.5f : 0.f;
#pragma unroll
    for (int q = 0; q < 3; ++q) {
      P.pq[q][0] = *(const uint2*)(prow + q * 512);
      P.pq[q][1] = *(const uint2*)(prow + q * 512 + op);
      P.pq[q][2] = *(const uint2*)(prow + q * 512 + on);
    }
    P.pwd = *(const uint2*)(Wd + tok * 512 + sc_);
    P.pad_ = *(const uint2*)(Ad + tok * 512 + sc_);
    const float* sc = w.bonus + (tok * 8 + hd) * 8;
    P.psc[0] = sc[0]; P.psc[1] = sc[1 + 3 * dir]; P.psc[2] = sc[2 + 3 * dir];
  };
  auto up4 = [](uint2 u, float* f) { f[0] = __uint_as_float(u.x << 16); f[1] = __uint_as_float(u.x & 0xffff0000u); f[2] = __uint_as_float(u.y << 16); f[3] = __uint_as_float(u.y & 0xffff0000u); };
  auto stage = [&](const RPre& P, float* bufp) {
    float rc[4], rp[4], rn[4], kc[4], kp[4], kn[4], vc[4], vp[4], vn[4], wd4[4], ad4[4];
    up4(P.pq[0][0], rc); up4(P.pq[0][1], rp); up4(P.pq[0][2], rn);
    up4(P.pq[1][0], kc); up4(P.pq[1][1], kp); up4(P.pq[1][2], kn);
    up4(P.pq[2][0], vc); up4(P.pq[2][1], vp); up4(P.pq[2][2], vn);
    up4(P.pwd, wd4); up4(P.pad_, ad4);
    float o0[4], o1[4], o2[4], o3[4], o4[4], o5[4];
#pragma unroll
    for (int j = 0; j < 4; ++j) {
      float r_s = rc[j] + ((P.pmk[0] * rp[j] + P.pmk[1] * rn[j]) - rc[j]) * mu_r[j];
      float k_s = kc[j] + ((P.pmk[0] * kp[j] + P.pmk[1] * kn[j]) - kc[j]) * mu_k[j];
      float v_s = vc[j] + ((P.pmk[0] * vp[j] + P.pmk[1] * vn[j]) - vc[j]) * mu_v[j];
      float kk = k_s * kk_c[j] * P.psc[0];
      float a = ad4[j], wv = 1.f - wd4[j];
      o0[j] = -kk; o1[j] = wv * r_s; o2[j] = wv; o3[j] = kk * a; o4[j] = k_s * (1.f + (a - 1.f) * ka_c[j]); o5[j] = v_s;
    }
    float* d = bufp + sj * 64 + skq;
    *(float4*)(d + 0 * 1024) = make_float4(o0[0], o0[1], o0[2], o0[3]);
    *(float4*)(d + 1 * 1024) = make_float4(o1[0], o1[1], o1[2], o1[3]);
    *(float4*)(d + 2 * 1024) = make_float4(o2[0], o2[1], o2[2], o2[3]);
    *(float4*)(d + 3 * 1024) = make_float4(o3[0], o3[1], o3[2], o3[3]);
    *(float4*)(d + 4 * 1024) = make_float4(o4[0], o4[1], o4[2], o4[3]);
    *(float4*)(d + 5 * 1024) = make_float4(o5[0], o5[1], o5[2], o5[3]);
    if (skq == 0) *(float2*)(bufp + 6 * 1024 + sj * 2) = make_float2(P.psc[1], P.psc[2]);
  };
  float* sY = sm + 2 * BUF;
  const int prow16 = wid * 4 + rs;
  const int ysel = (kg == 0) ? prow16 : (512 + tid);
  struct RStep { f4v a4, wr4, w4, b4, k4; float vv; float2 sc; };
  auto lds_step = [&](const float* bf, int j) {
    RStep q;
    q.a4 = *(const f4v*)(bf + 0 * 1024 + j * 64 + 4 * kg);
    q.wr4 = *(const f4v*)(bf + 1 * 1024 + j * 64 + 4 * kg);
    q.w4 = *(const f4v*)(bf + 2 * 1024 + j * 64 + 4 * kg);
    q.b4 = *(const f4v*)(bf + 3 * 1024 + j * 64 + 4 * kg);
    q.k4 = *(const f4v*)(bf + 4 * 1024 + j * 64 + 4 * kg);
    q.vv = bf[5 * 1024 + j * 64 + row];
    q.sc = *(const float2*)(bf + 6 * 1024 + j * 2);
    return q;
  };
  auto flush = [&](int c) {
    if (l == 0 || c >= 16) {
      int j = tid >> 4, rr = tid & 15;
      int ii = pos2i(c * 16 + j, dir);
      yout[((size_t)b * TPB + ii) * 512 + hd * 64 + rq * 16 + rr] = f2bf(sY[(c & 1) * 256 + j * 16 + rr]);
    }
  };
  __syncthreads();
  load(0, PA);
  stage(PA, sm);
  load(1, PB);
  __syncthreads();
  const int NCH = TPB / 16;
  auto run_chunk = [&](int c, const float* bf, float* sy) {
    if (c > 0) flush(c - 1);
    RStep cur = lds_step(bf, 0);
#pragma unroll
    for (int j = 0; j < 16; ++j) {
      RStep nxt = cur;
      if (j + 1 < 16) nxt = lds_step(bf, j + 1);
      f2v sa2 = SA * cur.a4.xy + SB * cur.a4.zw;
      f2v yp2 = SA * cur.wr4.xy + SB * cur.wr4.zw;
      float sa = sa2.x + sa2.y, yp = yp2.x + yp2.y;
      sa = row16_sum(sa); yp = row16_sum(yp);
      float y = yp + sa * cur.sc.x + cur.vv * cur.sc.y;
      SA = SA * cur.w4.xy + (sa * cur.b4.xy + cur.vv * cur.k4.xy);
      SB = SB * cur.w4.zw + (sa * cur.b4.zw + cur.vv * cur.k4.zw);
      sy[(kg == 0 ? j * 16 : 0) + ysel - (c & 1) * 0] = y;
      cur = nxt;
    }
  };
  for (int c = 0; c < NCH; c += 2) {
    if (c + 2 < NCH) load(c + 2, PA);
    run_chunk(c, sm, sY);
    stage(PB, sm + BUF);
    __syncthreads();
    if (c + 3 < NCH) load(c + 3, PB);
    run_chunk(c + 1, sm + BUF, sY + 256);
    if (c + 2 < NCH) stage(PA, sm);
    __syncthreads();
  }
  flush(NCH - 1);
}

DI void mamba_scan(CP p, const Ptrs& w, int l, int item, float* sm) {
  const int tid = TIDX, lane = tid & 63, wid = tid >> 6;
  const int chain = item >> 2, pq = item & 3, b = chain >> 4, hd = (chain >> 1) & 7, dir = chain & 1, gp = hd >> 2;
  const float* cw = p.in[21] + l * 3 * 1024;
  const float* cbv = p.in[22] + l * 1024;
  const int n_ = tid & 127, jh = tid >> 7;
  const int chB = 512 + gp * 128 + n_, chC = 768 + gp * 128 + n_;
  const float wB0 = cw[chB], wB1 = cw[1024 + chB], wB2 = cw[2048 + chB], bB = cbv[chB];
  const float wC0 = cw[chC], wC1 = cw[1024 + chC], wC2 = cw[2048 + chC], bC = cbv[chC];
  const int xj = tid >> 4, xp = tid & 15, chX = hd * 64 + pq * 16 + xp;
  const float wX0 = cw[chX], wX1 = cw[1024 + chX], wX2 = cw[2048 + chX], bX = cbv[chX];
  const float dtb = p.in[23][(l * 2 + dir) * 8 + hd];
  const float Aneg = -__expf(p.in[24][(l * 2 + dir) * 8 + hd]);
  const float Dsk = dir == 0 ? p.in[25][l * 8 + hd] : 0.f;
  bf16_t* yout = w.R2 + (size_t)(2 + dir) * T * 512;
  constexpr int BUF = 2 * 2048 + 256 + 256 + 64;
  const int ng = lane & 15, rs = lane >> 4, prow = wid * 4 + rs;
  f2v M0 = {0.f, 0.f}, M1 = {0.f, 0.f}, M2 = {0.f, 0.f}, M3 = {0.f, 0.f};
  struct MPre { uint4 pbq[2]; bf16_t px[3]; float pdt[3], pxm[2]; };
  MPre PA, PB;
  const bf16_t* mbc = w.W1;
  auto load = [&](int c, MPre& P) {
#pragma unroll
    for (int i = 0; i < 2; ++i) {
      int idx = tid + 256 * i, j = idx >> 5, q = idx & 31;
      int ii = pos2i(c * 16 + j, dir);
      P.pbq[i] = *(const uint4*)(mbc + ((size_t)b * TPB + ii) * 512 + (q < 16 ? 0 : 256) + gp * 128 + (q & 15) * 8);
    }
    {
      int pos = c * 16 + xj, ii = pos2i(pos, dir);
      size_t tok = (size_t)b * TPB + ii;
      const bf16_t* prw = w.pC + tok * SPC;
      bool hp = (ii != 0) && (ii != CTXL), hn = (ii != CTXL - 1) && (ii != TPB - 1);
      P.px[0] = prw[chX + (hp ? -SPC : 0)]; P.px[1] = prw[chX]; P.px[2] = prw[chX + (hn ? SPC : 0)];
      P.pxm[0] = hp ? 1.f : 0.f; P.pxm[1] = hn ? 1.f : 0.f;
      float2 dd = *(const float2*)(w.mdt + (tok * 16 + dir * 8 + hd) * 2);
      P.pdt[0] = dd.x; P.pdt[1] = dd.y; P.pdt[2] = w.mcb[tok * 2 + gp];
    }
  };
  auto stage = [&](const MPre& P, float* bufp) {
#pragma unroll
    for (int i = 0; i < 2; ++i) {
      int idx = tid + 256 * i, j = idx >> 5, q = idx & 31;
      float f[8];
      unpack8(P.pbq[i], f);
      float* d = bufp + (q < 16 ? 0 : 2048) + j * 128 + (q & 15) * 8;
      *(float4*)d = make_float4(f[0], f[1], f[2], f[3]);
      *(float4*)(d + 4) = make_float4(f[4], f[5], f[6], f[7]);
    }
    {
      float xs = siluf(wX0 * P.pxm[0] * bf2f(P.px[0]) + wX1 * bf2f(P.px[1]) + wX2 * P.pxm[1] * bf2f(P.px[2]) + bX);
      bufp[4096 + xj * 16 + xp] = xs * P.pdt[0];
      bufp[4096 + 256 + xj * 16 + xp] = Dsk * xs;
      if (xp == 0) *(float4*)(bufp + 4096 + 512 + xj * 4) = make_float4(P.pdt[1], P.pdt[2], 0.f, 0.f);
    }
  };
  float* sY = sm + 2 * BUF;
  const int ysel = (ng == 0) ? prow : (512 + tid);
  struct MStep { f4v B0, B1, C0, C1; float xq, ds; float4 sc; };
  auto lds_step = [&](const float* bf, int j) {
    MStep q;
    q.B0 = *(const f4v*)(bf + j * 128 + 8 * ng); q.B1 = *(const f4v*)(bf + j * 128 + 8 * ng + 4);
    q.C0 = *(const f4v*)(bf + 2048 + j * 128 + 8 * ng); q.C1 = *(const f4v*)(bf + 2048 + j * 128 + 8 * ng + 4);
    q.xq = bf[4096 + j * 16 + prow]; q.ds = bf[4096 + 256 + j * 16 + prow];
    q.sc = *(const float4*)(bf + 4096 + 512 + j * 4);
    return q;
  };
  auto flush = [&](int c) {
    if (l == 0 || c >= 16) {
      int j = tid >> 4, rr = tid & 15;
      int ii = pos2i(c * 16 + j, dir);
      yout[((size_t)b * TPB + ii) * 512 + hd * 64 + pq * 16 + rr] = f2bf(sY[(c & 1) * 256 + j * 16 + rr]);
    }
  };
  __syncthreads();
  load(0, PA);
  stage(PA, sm);
  load(1, PB);
  __syncthreads();
  const int NCH = TPB / 16;
  auto run_chunk = [&](int c, const float* bf, float* sy) {
    if (c > 0) flush(c - 1);
    MStep cur = lds_step(bf, 0);
#pragma unroll
    for (int j = 0; j < 16; ++j) {
      MStep nxt = cur;
      if (j + 1 < 16) nxt = lds_step(bf, j + 1);
      f2v ya = M0 * cur.C0.xy + M1 * cur.C0.zw, yb = M2 * cur.C1.xy + M3 * cur.C1.zw;
      ya += yb;
      float yp = row16_sum(ya.x + ya.y);
      float y = cur.sc.x * yp + cur.xq * cur.sc.y + cur.ds;
      const float dA = cur.sc.x, xq = cur.xq;
      M0 = M0 * dA + xq * cur.B0.xy; M1 = M1 * dA + xq * cur.B0.zw;
      M2 = M2 * dA + xq * cur.B1.xy; M3 = M3 * dA + xq * cur.B1.zw;
      sy[(ng == 0 ? j * 16 : 0) + ysel] = y;
      cur = nxt;
    }
  };
  for (int c = 0; c < NCH; c += 2) {
    if (c + 2 < NCH) load(c + 2, PA);
    run_chunk(c, sm, sY);
    stage(PB, sm + BUF);
    __syncthreads();
    if (c + 3 < NCH) load(c + 3, PB);
    run_chunk(c + 1, sm + BUF, sY + 256);
    if (c + 2 < NCH) stage(PA, sm);
    __syncthreads();
  }
  flush(NCH - 1);
}

DI void da_block(CP p, const Ptrs& w, int l, int b, int q0, int nkeys, int hd, bf16_t* sK, bf16_t* sV, float* smf, bf16_t* obase) {
  const int tid = TIDX, lane = tid & 63, wid = tid >> 6, r = lane & 31, h = lane >> 5;
  const int qb = wid >> 1, c = wid & 1;
  const size_t tokq = (size_t)b * TPB + q0 + qb * 32 + r;
  const bf16_t* qp = w.pD + tokq * SPD + hd * 128 + c * 64;
  bf16x8 Q0 = *(const bf16x8*)(qp + 0 * 16 + h * 8), Q1 = *(const bf16x8*)(qp + 1 * 16 + h * 8);
  bf16x8 Q2 = *(const bf16x8*)(qp + 2 * 16 + h * 8), Q3 = *(const bf16x8*)(qp + 3 * 16 + h * 8);
  const float mq = wave_max(fabsf(p.in[27][l * 64 + lane])), mk = wave_max(fabsf(p.in[28][l * 64 + lane]));
  const float Mb = 8.f * LOG2E * mq * mk + 0.5f;
  const float lam_init = 0.8f - 0.6f * __expf(-0.3f * (float)l);
  const float lam = __expf(wave_sum(p.in[29][l * 64 + lane] * p.in[30][l * 64 + lane])) - __expf(wave_sum(p.in[31][l * 64 + lane] * p.in[32][l * 64 + lane])) + lam_init;
  f32x16 O0, O1, O2, O3;
#pragma unroll
  for (int i = 0; i < 16; ++i) { O0[i] = 0.f; O1[i] = 0.f; O2[i] = 0.f; O3[i] = 0.f; }
  float ls = 0.f;
  const bf16_t* kbase = w.pD + (size_t)b * TPB * SPD + 512 + hd * 128;
  const bf16_t* vbase = w.VtD + (size_t)(b * 512 + hd * 128) * TPB;
  const int kkey = tid >> 4, kch = tid & 15, ve = tid >> 3, vch = tid & 7;
  const bf16_t* kg_ = kbase + (size_t)kkey * SPD + kch * 8;
  const bf16_t* vg_ = vbase + (size_t)ve * TPB + vch * 8;
  uint4 pk0, pk1, pk2, pk3, pv0, pv1, pv2, pv3;
#define DA_GLOAD(k0_) { const bf16_t* a_ = kg_ + (size_t)(k0_) * SPD; const bf16_t* b_ = vg_ + (k0_); \
    pk0 = *(const uint4*)(a_); pk1 = *(const uint4*)(a_ + (size_t)16 * SPD); pk2 = *(const uint4*)(a_ + (size_t)32 * SPD); pk3 = *(const uint4*)(a_ + (size_t)48 * SPD); \
    pv0 = *(const uint4*)(b_); pv1 = *(const uint4*)(b_ + (size_t)32 * TPB); pv2 = *(const uint4*)(b_ + (size_t)64 * TPB); pv3 = *(const uint4*)(b_ + (size_t)96 * TPB); }
  constexpr int DA_BUF = 64 * 136 + 128 * 72;
#define DA_STORE(bufi) { bf16_t* k_ = sK + (bufi) * DA_BUF; bf16_t* v_ = sV + (bufi) * DA_BUF; \
    *(uint4*)(k_ + (kkey) * 136 + kch * 8) = pk0; *(uint4*)(k_ + (kkey + 16) * 136 + kch * 8) = pk1; \
    *(uint4*)(k_ + (kkey + 32) * 136 + kch * 8) = pk2; *(uint4*)(k_ + (kkey + 48) * 136 + kch * 8) = pk3; \
    *(uint4*)(v_ + (ve) * 72 + vch * 8) = pv0; *(uint4*)(v_ + (ve + 32) * 72 + vch * 8) = pv1; \
    *(uint4*)(v_ + (ve + 64) * 72 + vch * 8) = pv2; *(uint4*)(v_ + (ve + 96) * 72 + vch * 8) = pv3; }
  DA_GLOAD(0)
  __syncthreads();
  DA_STORE(0)
  if (64 < nkeys) DA_GLOAD(64)
  __syncthreads();
  for (int k0 = 0; k0 < nkeys; k0 += 64) {
    const int cb_ = (k0 >> 6) & 1;
    const bf16_t* sKc = sK + cb_ * DA_BUF;
    const bf16_t* sVc = sV + cb_ * DA_BUF;
#pragma unroll
    for (int sub = 0; sub < 2; ++sub) {
      f32x16 S;
#pragma unroll
      for (int i = 0; i < 16; ++i) S[i] = -Mb;
      const bf16_t* kp = sKc + (sub * 32 + r) * 136 + c * 64 + h * 8;
      S = MFMA(*(const bf16x8*)(kp), Q0, S);
      S = MFMA(*(const bf16x8*)(kp + 16), Q1, S);
      S = MFMA(*(const bf16x8*)(kp + 32), Q2, S);
      S = MFMA(*(const bf16x8*)(kp + 48), Q3, S);
#pragma unroll
      for (int i = 0; i < 16; ++i) { S[i] = __builtin_amdgcn_exp2f(S[i]); ls += S[i]; }
      bf16x8 P0, P1;
      P0 = pack8_mfma(S[0], S[1], S[2], S[3], S[4], S[5], S[6], S[7]);
      P1 = pack8_mfma(S[8], S[9], S[10], S[11], S[12], S[13], S[14], S[15]);
#define DA_PV(OX, et)                                                                                   \
      {                                                                                                 \
        const bf16_t* vp = sVc + ((et) * 32 + r) * 72 + sub * 32 + 4 * h;                               \
        s16x4 lo = *(const s16x4*)vp, hi = *(const s16x4*)(vp + 8);                                     \
        s16x4 lo2 = *(const s16x4*)(vp + 16), hi2 = *(const s16x4*)(vp + 24);                           \
        OX = MFMA(__builtin_shufflevector(lo, hi, 0, 1, 2, 3, 4, 5, 6, 7), P0, OX);                     \
        OX = MFMA(__builtin_shufflevector(lo2, hi2, 0, 1, 2, 3, 4, 5, 6, 7), P1, OX);                   \
      }
      DA_PV(O0, 0) DA_PV(O1, 1) DA_PV(O2, 2) DA_PV(O3, 3)
#undef DA_PV
    }
    if (k0 + 64 < nkeys) {
      DA_STORE(cb_ ^ 1)
      if (k0 + 128 < nkeys) DA_GLOAD(k0 + 128)
    }
    __syncthreads();
  }
#undef DA_STORE
  ls += __shfl_xor(ls, 32);
  const float scl = c == 0 ? 1.f / ls : lam / ls;
#pragma unroll
  for (int i = 0; i < 16; ++i) { O0[i] *= scl; O1[i] *= scl; O2[i] *= scl; O3[i] *= scl; }
  __syncthreads();
  float* xb = smf + qb * 4096;
  if (c == 1) {
#pragma unroll
    for (int i = 0; i < 16; ++i) {
      int e = crow(i, h);
      xb[(e) * 32 + r] = O0[i]; xb[(32 + e) * 32 + r] = O1[i]; xb[(64 + e) * 32 + r] = O2[i]; xb[(96 + e) * 32 + r] = O3[i];
    }
  }
  __syncthreads();
  if (c == 0) {
    float ss = 0.f;
#pragma unroll
    for (int i = 0; i < 16; ++i) {
      int e = crow(i, h);
      O0[i] -= xb[(e) * 32 + r]; O1[i] -= xb[(32 + e) * 32 + r]; O2[i] -= xb[(64 + e) * 32 + r]; O3[i] -= xb[(96 + e) * 32 + r];
      ss += O0[i] * O0[i] + O1[i] * O1[i] + O2[i] * O2[i] + O3[i] * O3[i];
    }
    ss += __shfl_xor(ss, 32);
    const float inv = rsqrtf(ss * (1.f / 128.f) + 1e-6f) * (1.f - lam_init);
    const float* sub_w = p.in[33] + l * 128;
    const bf16_t* gp_ = w.pD + tokq * SPD + 1024 + hd * 128;
    bf16_t* op = obase + tokq * SPD + hd * 128;
#define DA_ST(OX, et)                                                                                   \
    _Pragma("unroll") for (int g = 0; g < 4; ++g) {                                                     \
      int e0 = (et) * 32 + 8 * g + 4 * h;                                                               \
      uint2 gg = *(const uint2*)(gp_ + e0);                                                             \
      float4 sw = *(const float4*)(sub_w + e0);                                                         \
      float g0 = bf2f((bf16_t)(gg.x & 0xffff)), g1 = bf2f((bf16_t)(gg.x >> 16)), g2 = bf2f((bf16_t)(gg.y & 0xffff)), g3 = bf2f((bf16_t)(gg.y >> 16)); \
      float o0 = OX[4 * g] * inv * sw.x * siluf(g0), o1 = OX[4 * g + 1] * inv * sw.y * siluf(g1);       \
      float o2 = OX[4 * g + 2] * inv * sw.z * siluf(g2), o3 = OX[4 * g + 3] * inv * sw.w * siluf(g3);   \
      *(uint2*)(op + e0) = make_uint2(pack2(o0, o1), pack2(o2, o3));                                    \
    }
    DA_ST(O0, 0) DA_ST(O1, 1) DA_ST(O2, 2) DA_ST(O3, 3)
#undef DA_ST
  }
}

DI void na_wave(CP p, const Ptrs& w, int l, int witem, bool ctxq, bf16_t* obase) {
  const int lane = TIDX & 63, r = lane & 31, h = lane >> 5;
  int b, hd, qi, gr0 = 0, cq = 0, qrow = 0, qcol = 0;
  if (!ctxq) {
    hd = witem & 7; cq = (witem >> 3) & 3; gr0 = ((witem >> 5) & 63) * 2; b = witem >> 11;
    qrow = gr0 + (r >> 4); qcol = cq * 16 + (r & 15); qi = CTXL + qrow * 64 + qcol;
  } else { hd = witem & 7; int qt = (witem >> 3) & 7; b = witem >> 6; qi = qt * 32 + r; }
  const size_t tokq = (size_t)b * TPB + qi;
  const bf16_t* qp = w.pA + tokq * SPA + hd * 64;
  bf16x8 Q[4];
#pragma unroll
  for (int s = 0; s < 4; ++s) Q[s] = *(const bf16x8*)(qp + s * 16 + h * 8);
  const float mq = wave_max(fabsf(p.in[8][l * 64 + lane])), mk = wave_max(fabsf(p.in[9][l * 64 + lane]));
  const float* rpb = p.in[10] + (size_t)(l * 8 + hd) * 15 * 31;
  float mb = 0.f;
  for (int e = lane; e < 465; e += 64) mb = fmaxf(mb, fabsf(rpb[e]));
  mb = wave_max(mb);
  const float Mb = 8.f * LOG2E * mq * mk + mb * LOG2E + 0.5f;
  f32x16 O[2];
#pragma unroll
  for (int e = 0; e < 2; ++e)
#pragma unroll
    for (int i = 0; i < 16; ++i) O[e][i] = 0.f;
  float ls = 0.f;
  const bf16_t* kbase = w.pA + (size_t)b * TPB * SPA + 512 + hd * 64;
  const bf16_t* vbase = w.VtA + (size_t)(b * 512 + hd * 64) * TPB;
  const int r0q = min(max(qrow - 4, 0), 120);
  const int c0 = min(max(qcol - 8, 0), 48);
  const int kr_lo = min(max(gr0 - 4, 0), 120), kr_hi = min(max(gr0 - 3, 0), 120) + 8;
  const int kc0 = min(max(cq * 16 - 8, 0), 32);
  const int ntile = ctxq ? 8 : 8 + (kr_hi - kr_lo);
  auto kidx = [&](int t) { return t < 8 ? t * 32 : CTXL + (kr_lo + (t - 8)) * 64 + kc0; };
  bf16x8 nK0, nK1, nK2, nK3;
  s16x4 nV[8];
#define NA_LOAD(t_) { const int ki_ = kidx(t_); const bf16_t* kp_ = kbase + (size_t)(ki_ + r) * SPA + h * 8; \
    nK0 = *(const bf16x8*)(kp_); nK1 = *(const bf16x8*)(kp_ + 16); nK2 = *(const bf16x8*)(kp_ + 32); nK3 = *(const bf16x8*)(kp_ + 48); \
    _Pragma("unroll") for (int et = 0; et < 2; ++et) _Pragma("unroll") for (int s2 = 0; s2 < 2; ++s2) { \
      const bf16_t* vp_ = vbase + (size_t)(et * 32 + r) * TPB + ki_ + s2 * 16 + 4 * h; \
      nV[(et * 2 + s2) * 2] = *(const s16x4*)vp_; nV[(et * 2 + s2) * 2 + 1] = *(const s16x4*)(vp_ + 8); } }
  NA_LOAD(0)
  for (int t = 0; t < ntile; ++t) {
    bool local = t >= 8;
    const int kr = kr_lo + (t - 8);
    bf16x8 cK0 = nK0, cK1 = nK1, cK2 = nK2, cK3 = nK3;
    s16x4 cV[8];
#pragma unroll
    for (int i = 0; i < 8; ++i) cV[i] = nV[i];
    if (t + 1 < ntile) NA_LOAD(t + 1)
    f32x16 S;
#pragma unroll
    for (int i = 0; i < 16; ++i) S[i] = -Mb;
    S = MFMA(cK0, Q[0], S); S = MFMA(cK1, Q[1], S); S = MFMA(cK2, Q[2], S); S = MFMA(cK3, Q[3], S);
    if (local) {
      const bool row_ok = (kr >= r0q) && (kr < r0q + 8);
      const float* rp = rpb + min(max(kr - qrow + 7, 0), 14) * 31;
#pragma unroll
      for (int i = 0; i < 16; ++i) {
        int kcol = kc0 + crow(i, h);
        bool ok = row_ok && (kcol >= c0) && (kcol < c0 + 16);
        int dc = min(max(kcol - qcol + 15, 0), 30);
        float bias = rp[dc] * LOG2E;
        S[i] = ok ? __builtin_amdgcn_exp2f(S[i] + bias) : 0.f;
      }
    } else {
#pragma unroll
      for (int i = 0; i < 16; ++i) S[i] = __builtin_amdgcn_exp2f(S[i]);
    }
    bf16x8 P[2];
#pragma unroll
    for (int i = 0; i < 16; ++i) ls += S[i];
#pragma unroll
    for (int s2 = 0; s2 < 2; ++s2) {
      P[s2] = pack8_mfma(S[8 * s2 + 0], S[8 * s2 + 1], S[8 * s2 + 2], S[8 * s2 + 3], S[8 * s2 + 4], S[8 * s2 + 5], S[8 * s2 + 6], S[8 * s2 + 7]);
    }
#pragma unroll
    for (int et = 0; et < 2; ++et)
#pragma unroll
      for (int s2 = 0; s2 < 2; ++s2) {
        bf16x8 vf = __builtin_shufflevector(cV[(et * 2 + s2) * 2], cV[(et * 2 + s2) * 2 + 1], 0, 1, 2, 3, 4, 5, 6, 7);
        O[et] = MFMA(vf, P[s2], O[et]);
      }
  }
#undef NA_LOAD
  ls += __shfl_xor(ls, 32);
  const float inv = 1.f / ls;
  const bf16_t* gp_ = w.pA + tokq * SPA + 1024 + hd * 64;
  bf16_t* op = obase + tokq * SPA + hd * 64;
#pragma unroll
  for (int et = 0; et < 2; ++et)
#pragma unroll
    for (int g = 0; g < 4; ++g) {
      int e0 = et * 32 + 8 * g + 4 * h;
      uint2 gg = *(const uint2*)(gp_ + e0);
      float g0 = bf2f((bf16_t)(gg.x & 0xffff)), g1 = bf2f((bf16_t)(gg.x >> 16)), g2 = bf2f((bf16_t)(gg.y & 0xffff)), g3 = bf2f((bf16_t)(gg.y >> 16));
      float o0 = O[et][4 * g] * inv * siluf(g0), o1 = O[et][4 * g + 1] * inv * siluf(g1);
      float o2 = O[et][4 * g + 2] * inv * siluf(g2), o3 = O[et][4 * g + 3] * inv * siluf(g3);
      *(uint2*)(op + e0) = make_uint2(pack2(o0, o1), pack2(o2, o3));
    }
}

template <int MM, int DUMMY = 0>
DI void phase_mixers(CP p, const Ptrs& w, int l, float* sm) {
  __shared__ int s_item;
  const bool ctxo = (l == 0);
  const int n_scan = (MM & 1) ? 256 : 0, n_da = (MM & 2) ? 1024 : 0, n_dac = ((MM & 2) && ctxo) ? 32 : 0;
  const int n_na = (MM & 4) ? 1024 : 0, n_nac = ((MM & 4) && ctxo) ? 32 : 0;
  const int total = n_scan + n_da + n_dac + n_na + n_nac;
  int* ctr = &w.ctr[l * 16 + MM + ((MM != 1) ? DUMMY * 8 : 0)];
  bf16_t* oD = DUMMY ? w.R1 : w.pD; bf16_t* oA = DUMMY ? w.R1 : w.pA;
  if constexpr (MM == 1 && DUMMY == 1) {
    __syncthreads();
    if (TIDX == 0) {
      unsigned hw = (unsigned)__builtin_amdgcn_s_getreg((31 << 11) | 4);
      unsigned key = ((hw >> 8) & 0xffu) | (xb_xcc_id() << 8);
      s_item = atomicAdd(&w.cuf[l * 4096 + key], 1);
    }
    __syncthreads();
    int first = s_item;
    if (first != 0) return;
  }
  for (;;) {
    __syncthreads();
    if (TIDX == 0) s_item = atomicAdd(ctr, 1);
    __syncthreads();
    int it = s_item;
    if (it >= total) break;
    if constexpr ((MM & 1) != 0) {
      if (it < 128) { __builtin_amdgcn_s_setprio(3); rwkv_scan(p, w, l, it, sm); __builtin_amdgcn_s_setprio(0); if (DUMMY) break; continue; }
      if (it < 256) { __builtin_amdgcn_s_setprio(3); mamba_scan(p, w, l, it - 128, sm); __builtin_amdgcn_s_setprio(0); if (DUMMY) break; continue; }
      it -= 256;
    }
    if constexpr ((MM & 2) != 0) {
      if (it < n_da) { int hd = it & 3, qt = (it >> 2) & 127, b = it >> 9; da_block(p, w, l, b, CTXL + qt * 64, TPB, hd, (bf16_t*)sm, (bf16_t*)sm + 64 * 136, sm, oD); continue; }
      it -= n_da;
      if (it < n_dac) { int hd = it & 3, qt = (it >> 2) & 3, b = it >> 4; da_block(p, w, l, b, qt * 64, CTXL, hd, (bf16_t*)sm, (bf16_t*)sm + 64 * 136, sm, oD); continue; }
      it -= n_dac;
    }
    if constexpr ((MM & 4) != 0) {
      if (it < n_na) { na_wave(p, w, l, it * 4 + (TIDX >> 6), false, oA); continue; }
      it -= n_na;
      na_wave(p, w, l, it * 4 + (TIDX >> 6), true, oA);
    }
  }
}

DI void phase_finish(CP p, const Ptrs& w, int l) {
  const int lane = TIDX & 63, gw = BIDX * 4 + (TIDX >> 6), nw = GDIM * 4;
  const int c0 = lane * 8, hd = lane >> 3;
  float lnw[8], lnb[8], muv[8], nrm[8];
#pragma unroll
  for (int j = 0; j < 8; ++j) { lnw[j] = p.in[19][l * 512 + c0 + j]; lnb[j] = p.in[20][l * 512 + c0 + j]; muv[j] = p.in[11][l * 1792 + 1024 + c0 + j]; nrm[j] = p.in[26][l * 512 + c0 + j]; }
  const bf16_t* yB0 = w.R2, *yB1 = w.R2 + (size_t)T * 512, *yM0 = w.R2 + (size_t)2 * T * 512, *yM1 = w.R2 + (size_t)3 * T * 512;
  for (int tok = gw; tok < T; tok += nw) {
    int b = tok / TPB, i = tok - b * TPB;
    if (l != 0 && i < CTXL) continue;
    bool hp = (i != 0) && (i != CTXL), hn = (i != CTXL - 1) && (i != TPB - 1);
    bf16_t* rb = w.pB + (size_t)tok * SPB;
    bf16_t* rc = w.pC + (size_t)tok * SPC + 1040;
    uint4 u0 = *(const uint4*)(yB0 + (size_t)tok * 512 + c0), u1 = *(const uint4*)(yB1 + (size_t)tok * 512 + c0);
    uint4 uv = *(const uint4*)(rb + 1024 + c0), up = make_uint4(0, 0, 0, 0), un = make_uint4(0, 0, 0, 0);
    if (hp) up = *(const uint4*)(rb + 1024 + c0 - SPB);
    if (hn) un = *(const uint4*)(rb + 1024 + c0 + SPB);
    uint4 ug = *(const uint4*)(rb + 1792 + c0);
    const float* bsc = w.bonus + ((size_t)tok * 8 + hd) * 8;
    float2 bon2 = make_float2(bsc[3], bsc[6]);
    uint4 m0 = *(const uint4*)(yM0 + (size_t)tok * 512 + c0), m1 = *(const uint4*)(yM1 + (size_t)tok * 512 + c0);
    uint4 uz = *(const uint4*)(rc + c0);
    float y[8], t[8], vv[8], vp[8], vn[8], g[8];
    unpack8(u0, y); unpack8(u1, t);
    float sm_ = 0.f;
#pragma unroll
    for (int j = 0; j < 8; ++j) { y[j] += t[j]; sm_ += y[j]; }
    float mean = row8_sum(sm_) * (1.f / 64.f);
    float vs = 0.f;
#pragma unroll
    for (int j = 0; j < 8; ++j) { y[j] -= mean; vs += y[j] * y[j]; }
    float rstd = rsqrtf(row8_sum(vs) * (1.f / 64.f) + 64e-5f);
    unpack8(uv, vv); unpack8(up, vp); unpack8(un, vn); unpack8(ug, g);
    float bon = bon2.x + bon2.y;
#pragma unroll
    for (int j = 0; j < 8; ++j) {
      float yn = y[j] * rstd * lnw[j] + lnb[j];
      float v_s = vv[j] + (0.5f * (vp[j] + vn[j]) - vv[j]) * muv[j];
      t[j] = (yn + bon * v_s) * siluf(g[j]);
    }
    *(uint4*)(rb + 1792 + c0) = pack8(t);
    unpack8(m0, y); unpack8(m1, t); unpack8(uz, g);
    float ss = 0.f;
#pragma unroll
    for (int j = 0; j < 8; ++j) { y[j] = (y[j] + t[j]) * siluf(g[j]); ss += y[j] * y[j]; }
    ss = row16_sum(ss); ss += __shfl_xor(ss, 16);
    float inv = rsqrtf(ss * (1.f / 256.f) + 1e-6f);
#pragma unroll
    for (int j = 0; j < 8; ++j) t[j] = y[j] * inv * nrm[j];
    *(uint4*)(rc + c0) = pack8(t);
  }
}

DI void phase_merge(CP p, const Ptrs& w, int l, bf16_t* sA, bf16_t* sB, unsigned* sU) {
  const int tid = TIDX, lane = tid & 63, wid = tid >> 6, wm = wid >> 1, wn = wid & 1, r = lane & 31, h = lane >> 5;
  const bf16_t* gate_t = (const bf16_t*)((const char*)w.R1 + R1_GATE);
  const bf16_t* up_t = (const bf16_t*)((const char*)w.R1 + R1_UP);
  const int nmt = l == 0 ? 132 : 128;
  const int nrounds = tile_rounds(nmt, 16);
  for (int kk = 0; kk < nrounds; ++kk) {
    int mt, nt;
    if (!tile_map(kk, nmt, 16, mt, nt)) continue;
    if (l != 0) mt += mt < 64 ? 2 : 4;
    int m0 = mt * 128, n0 = nt * 128;
    f32x16 tot[2][2];
    zero_acc(tot);
#pragma unroll 1
    for (int br = 0; br < 4; ++br) {
      const bf16_t* ys; int lds_;
      if (br == 0) { ys = w.pA; lds_ = SPA; } else if (br == 1) { ys = w.pB + 1792; lds_ = SPB; } else if (br == 2) { ys = w.pC + 1040; lds_ = SPC; } else { ys = w.pD; lds_ = SPD; }
      {
        f32x16 U[2][2];
        zero_acc(U);
        gemm_128(ys + (size_t)m0 * lds_, lds_, up_t + (size_t)(br * 2048 + n0) * 512, 512, 512, U, sA, sB);
#pragma unroll
        for (int a = 0; a < 2; ++a)
#pragma unroll
          for (int c = 0; c < 2; ++c)
#pragma unroll
            for (int i = 0; i < 8; ++i) sU[((a * 2 + c) * 8 + i) * 256 + tid] = pack2(U[a][c][2 * i], U[a][c][2 * i + 1]);
      }
      f32x16 G[2][2];
      zero_acc(G);
      gemm_128(w.H + (size_t)m0 * 2048, 2048, gate_t + (size_t)(br * 2048 + n0) * 2048, 2048, 2048, G, sA, sB);
#pragma unroll
      for (int a = 0; a < 2; ++a)
#pragma unroll
        for (int c = 0; c < 2; ++c)
#pragma unroll
          for (int i = 0; i < 8; ++i) {
            unsigned uv = sU[((a * 2 + c) * 8 + i) * 256 + tid];
            float u0 = __uint_as_float(uv << 16), u1 = __uint_as_float(uv & 0xffff0000u);
            tot[a][c][2 * i] += sigmf(G[a][c][2 * i]) * u0;
            tot[a][c][2 * i + 1] += sigmf(G[a][c][2 * i + 1]) * u1;
          }
    }
    bf16_t* dst = w.R2;
#pragma unroll
    for (int mi = 0; mi < 2; ++mi)
#pragma unroll
      for (int ni = 0; ni < 2; ++ni)
#pragma unroll
        for (int i = 0; i < 16; ++i) {
          int row = m0 + wm * 64 + mi * 32 + crow(i, h), col = n0 + wn * 64 + ni * 32 + r;
          dst[(size_t)row * 2048 + col] = f2bf(tot[mi][ni][i]);
        }
  }
}

DI void phase_out(CP p, const Ptrs& w, int l, bf16_t* sA, bf16_t* sB) {
  const int tid = TIDX, lane = tid & 63, wid = tid >> 6, wm = wid >> 1, wn = wid & 1, r = lane & 31, h = lane >> 5;
  const bf16_t* out_t = (const bf16_t*)((const char*)w.R1 + R1_OUT);
  const int nmt = l == 0 ? 132 : 128;
  const int nrounds = tile_rounds(nmt, 16);
  for (int kk = 0; kk < nrounds; ++kk) {
    int mt, nt;
    if (!tile_map(kk, nmt, 16, mt, nt)) continue;
    if (l != 0) mt += mt < 64 ? 2 : 4;
    int m0 = mt * 128, n0 = nt * 128;
    int b = m0 / TPB, ib = m0 - b * TPB;
    bool isctx = ib < CTXL;
    f32x16 acc[2][2];
    zero_acc(acc);
    gemm_128_deep(w.R2 + (size_t)m0 * 2048, 2048, out_t + (size_t)n0 * 2048, 2048, 2048, acc, sA, sB);
    const float* gate = w.mod + (l * 3 + (isctx ? 2 : b)) * 6144 + 4096;
#pragma unroll
    for (int mi = 0; mi < 2; ++mi)
#pragma unroll
      for (int ni = 0; ni < 2; ++ni) {
        int col = n0 + wn * 64 + ni * 32 + r;
        float gt = gate[col];
#pragma unroll
        for (int i = 0; i < 16; ++i) {
          int ii = ib + wm * 64 + mi * 32 + crow(i, h);
          float* dstp = isctx ? w.xc1 + (size_t)(b * CTXL + ii) * DM : p.out + (size_t)(b * 8192 + ii - CTXL) * DM;
          const float* src = l != 0 ? (const float*)dstp
                                    : (isctx ? p.in[2] + (size_t)(b * CTXL + ii) * DM : p.in[0] + (size_t)(b * 8192 + ii - CTXL) * DM);
          dstp[col] = src[col] + gt * acc[mi][ni][i];
        }
      }
  }
}

constexpr int SMEM_BYTES = 4 * 128 * 72 * 2;
constexpr int NPH = 18;
#ifndef ONE_LAUNCH
#define ONE_LAUNCH 1
#endif
#ifndef PHMASK
#define PHMASK 0x1ff
#endif

template <int SP>
DI void run_phase(int l, char* smem_raw) {
  CP p = launder_params();
  const Ptrs w = mkptrs(p.ws);
  float* smf = (float*)smem_raw;
  bf16_t* sA = (bf16_t*)smem_raw;
  bf16_t* sB = sA + 128 * 72;
  if constexpr (SP == 0) {
    if (l == 0) {
      if (BIDX == 0 && TIDX < 64) w.ctr[TIDX] = 0;
      if (BIDX >= 2 && BIDX < 34) w.cuf[(BIDX - 2) * 256 + TIDX] = 0;
      if (BIDX == 1) for (int e = TIDX; e < 2048; e += 256) { float ang = (float)(e >> 4) * exp2f(-(float)(e & 15) * (13.287712379549449f / 16.f)); w.rope[2 * e] = cosf(ang); w.rope[2 * e + 1] = sinf(ang); }
      for (int it = BIDX; it < 384; it += GDIM) phase_ada_item(p, w, 0, it, 4, smf);
      conv_w1(p, w, 0, smf);
    }
    conv_w3(p, w, l, smf);
  } else if constexpr (SP == 1) phase_norm(p, w, l);
  else if constexpr (SP == 2) phase_inproj(p, w, l, sA, sB);
  else if constexpr (SP == 3) {
    phase_prep(p, w, l);
  } else if constexpr (SP == 4) phase_lora(p, w, l, sA, sB);
  else if constexpr (SP == 5) phase_mixers<1>(p, w, l, smf);
  else if constexpr (SP == 9) phase_mixers<2>(p, w, l, smf);
  else if constexpr (SP == 10) phase_mixers<4>(p, w, l, smf);
  else if constexpr (SP == 13) phase_rwscal(p, w, l);
  else if constexpr (SP == 14) phase_mixers<1, 1>(p, w, l, smf);
  else if constexpr (SP == 11) phase_mixers<2, 1>(p, w, l, smf);
  else if constexpr (SP == 12) phase_mixers<4, 1>(p, w, l, smf);
  else if constexpr (SP == 6) {
    conv_w2(p, w, l, smf);
    if (l + 1 < 2) conv_w1(p, w, l + 1, smf);
    phase_finish(p, w, l);
  } else if constexpr (SP == 7) phase_merge(p, w, l, sA, sB, (unsigned*)(smem_raw + 2 * 128 * 72 * 2));
  else phase_out(p, w, l, sA, sB);
}

template <int SP>
__global__ void __launch_bounds__(256, 2) phase_kernel(Params p, int l) {
  __shared__ __attribute__((aligned(16))) char smem_raw[SMEM_BYTES];
  run_phase<SP>(l, smem_raw);
}

template <int SP>
__device__ __attribute__((noinline)) void run_phase_ni(int l, char* smem_raw) {
  run_phase<SP>(l, smem_raw);
}
#ifndef CMASK
#define CMASK 0x7fff
#endif
#ifndef DUPMASK
#define DUPMASK 0
#endif
#define RUNP(k) if ((CMASK & (1 << k)) && (pmask & (1 << k))) { run_phase<k>(RP_ARGS); if ((DUPMASK & (1 << k)) && (k != 8 || l == 0)) { xcd_barrier(xb); run_phase<k>(RP_ARGS); } }
#ifdef NOINL
#define run_phase run_phase_ni
#define RP_ARGS l, smem_raw
#else
#define RP_ARGS l, smem_raw
#endif
__global__ void __launch_bounds__(256, 2) fwd_kernel(Params p) {
  __shared__ __attribute__((aligned(16))) char smem_raw[SMEM_BYTES];
#if ONE_LAUNCH
  __shared__ uint4 xb_words;
  if (threadIdx.x == 0) xb_words = make_uint4(0u, 0u, 0u, 0u);
  __syncthreads();
  XcdBarrier xb = xcd_barrier_post((unsigned*)(launder_params().ws + OFF_BAR), (volatile LAS unsigned*)&xb_words);
  const int lmask = launder_params().ph_lo, pmask = launder_params().ph_hi;
#ifdef PROBE_SYNC
  for (int q = 0; q < 50; ++q) xcd_barrier(xb);
#endif
  for (int l = 0; l < 2; ++l) {
    if (!((lmask >> l) & 1)) continue;
    RUNP(0); xcd_barrier(xb);
    if (lmask == 0x7fffffff) cg::this_grid().sync();
    RUNP(1); xcd_barrier(xb);
    RUNP(2); xcd_barrier(xb);
    RUNP(3); xcd_barrier(xb);
    RUNP(4); xcd_barrier(xb);
    RUNP(13); xcd_barrier(xb);
#ifndef SEQMIX
#define SEQMIX 0
#endif
    RUNP(14); if (SEQMIX) xcd_barrier(xb);
#ifdef PROBE_DA
    RUNP(11); xcd_barrier(xb);
#endif
#ifdef PROBE_NA
    RUNP(12); xcd_barrier(xb);
#endif
    RUNP(9); if (SEQMIX) xcd_barrier(xb); RUNP(10); RUNP(5); xcd_barrier(xb);
    RUNP(6); xcd_barrier(xb);
    RUNP(7); xcd_barrier(xb);
    RUNP(8); xcd_barrier(xb);
  }
#endif
}


extern "C" void kernel_launch(void* const* d_in, const int* in_sizes, int n_in, void* d_out, int out_size, void* d_ws, size_t ws_size, hipStream_t stream) {
  static int grid_blocks = 0;
  if (!grid_blocks) {
    int dev = 0, cus = 0, per_cu = 0;
    (void)hipGetDevice(&dev);
    (void)hipDeviceGetAttribute(&cus, hipDeviceAttributeMultiprocessorCount, dev);
    (void)hipOccupancyMaxActiveBlocksPerMultiprocessor(&per_cu, fwd_kernel, 256, 0);
    if (per_cu > 2) per_cu = 2;
    if (per_cu < 1) per_cu = 1;
    grid_blocks = cus * per_cu;
  }
  if (n_in < 37 || ws_size < WS_NEED) { fprintf(stderr, "bad args: n_in=%d ws=%zu need=%zu\n", n_in, ws_size, (size_t)WS_NEED); return; }
  Params p;
  memset(&p, 0, sizeof(p));
  for (int i = 0; i < 37; ++i) p.in[i] = (const float*)d_in[i];
  p.out = (float*)d_out;
  p.ws = (char*)d_ws;
#if ONE_LAUNCH
  p.ph_lo = 3; p.ph_hi = 0x7fff;
  (void)hipMemsetAsync((char*)d_ws + OFF_BAR, 0, XCD_BAR_WORDS * 4, stream);
  (void)hipMemsetAsync((char*)d_ws + OFF_MOD, 0, 3 * 6144 * 4, stream);
  void* args[] = {&p};
  hipError_t e = hipLaunchCooperativeKernel((void*)fwd_kernel, dim3(grid_blocks), dim3(256), args, 0, stream);
  if (e != hipSuccess) fprintf(stderr, "cooperative launch failed: %s (grid %d)\n", hipGetErrorString(e), grid_blocks);
#ifdef PROBE_EXTRA
  {
    (void)hipMemsetAsync((char*)d_ws + OFF_BAR, 0, XCD_BAR_WORDS * 4, stream);
    Params p2 = p; p2.ph_lo = 1; p2.ph_hi = PROBE_EXTRA;
    void* args2[] = {&p2};
    (void)hipLaunchCooperativeKernel((void*)fwd_kernel, dim3(grid_blocks), dim3(256), args2, 0, stream);
  }
#endif
#else
  for (int l = 0; l < 2; ++l) {
    hipLaunchKernelGGL(phase_kernel<0>, dim3(grid_blocks), dim3(256), 0, stream, p, l);
    hipLaunchKernelGGL(phase_kernel<1>, dim3(grid_blocks), dim3(256), 0, stream, p, l);
    hipLaunchKernelGGL(phase_kernel<2>, dim3(grid_blocks), dim3(256), 0, stream, p, l);
    hipLaunchKernelGGL(phase_kernel<3>, dim3(grid_blocks), dim3(256), 0, stream, p, l);
    hipLaunchKernelGGL(phase_kernel<4>, dim3(grid_blocks), dim3(256), 0, stream, p, l);
    hipLaunchKernelGGL(phase_kernel<5>, dim3(grid_blocks), dim3(256), 0, stream, p, l);
    hipLaunchKernelGGL(phase_kernel<9>, dim3(grid_blocks), dim3(256), 0, stream, p, l);
    hipLaunchKernelGGL(phase_kernel<10>, dim3(grid_blocks), dim3(256), 0, stream, p, l);
    hipLaunchKernelGGL(phase_kernel<6>, dim3(grid_blocks), dim3(256), 0, stream, p, l);
    hipLaunchKernelGGL(phase_kernel<7>, dim3(grid_blocks), dim3(256), 0, stream, p, l);
    hipLaunchKernelGGL(phase_kernel<8>, dim3(grid_blocks), dim3(256), 0, stream, p, l);
  }
#endif
}
```

```cpp
#include <hip/hip_runtime.h>
#include <hip/hip_cooperative_groups.h>
#include <stdint.h>
#include <cstdio>
#include <cstring>
namespace cg = cooperative_groups;

typedef unsigned short bf16_t;
typedef __attribute__((ext_vector_type(8))) short bf16x8;
typedef __attribute__((ext_vector_type(4))) short s16x4;
typedef __attribute__((ext_vector_type(16))) float f32x16;
typedef __attribute__((ext_vector_type(2))) float f2v;
typedef __attribute__((ext_vector_type(4))) float f4v;
#define DI __device__ __forceinline__
#define MFMA(a, b, c) __builtin_amdgcn_mfma_f32_32x32x16_bf16((a), (b), (c), 0, 0, 0)

constexpr int DM = 2048, TPB = 8448, T = 16896, CTXL = 256;
constexpr int SPA = 1536, SPB = 2304, SPC = 1664, SPD = 1536;
constexpr int NPAD = 8064;
constexpr float LOG2E = 1.4426950408889634f;
constexpr float QS = 0.125f * LOG2E;

constexpr size_t al256(size_t x) { return (x + 255) & ~(size_t)255; }
constexpr size_t OFF_MOD = 0;
constexpr size_t OFF_CTR = al256(OFF_MOD + 2 * 3 * 6144 * 4);
constexpr size_t OFF_BAR = al256(OFF_CTR + 256);
constexpr size_t OFF_CUF = al256(OFF_BAR + 3456 * 4);
constexpr size_t OFF_ROPE = al256(OFF_CUF + 2 * 4096 * 4);
constexpr size_t OFF_BONUS = al256(OFF_ROPE + 128 * 16 * 8);
constexpr size_t OFF_MDT = al256(OFF_BONUS + (size_t)T * 64 * 4);
constexpr size_t OFF_MCB = al256(OFF_MDT + (size_t)T * 32 * 4);
constexpr size_t OFF_W3 = al256(OFF_MCB + (size_t)T * 2 * 4);
constexpr size_t OFF_LA = al256(OFF_W3 + 4 * 512 * 64 * 2);
constexpr size_t OFF_XC1 = al256(OFF_LA + (size_t)T * 256 * 2);
constexpr size_t OFF_W1 = al256(OFF_XC1 + (size_t)2 * 256 * 2048 * 4);
constexpr size_t OFF_H = al256(OFF_W1 + (size_t)NPAD * 2048 * 2);
constexpr size_t OFF_PA = al256(OFF_H + (size_t)T * 2048 * 2);
constexpr size_t OFF_PB = al256(OFF_PA + (size_t)T * SPA * 2);
constexpr size_t OFF_PC = al256(OFF_PB + (size_t)T * SPB * 2);
constexpr size_t OFF_PD = al256(OFF_PC + (size_t)T * SPC * 2);
constexpr size_t OFF_VTA = al256(OFF_PD + (size_t)T * SPD * 2);
constexpr size_t OFF_VTD = al256(OFF_VTA + (size_t)2 * 512 * TPB * 2);
constexpr size_t OFF_R1 = al256(OFF_VTD + (size_t)2 * 512 * TPB * 2);
constexpr size_t OFF_R2 = al256(OFF_R1 + (size_t)4 * T * 512 * 2);
constexpr size_t WS_NEED = al256(OFF_R2 + (size_t)4 * T * 512 * 2);
constexpr size_t R1_GATE = 0, R1_UP = (size_t)4 * 2048 * 2048 * 2, R1_OUT = R1_UP + (size_t)4 * 2048 * 512 * 2;

struct Params {
  const float* in[37];
  float* out;
  char* ws;
  int ph_lo, ph_hi;
};


typedef const __attribute__((address_space(4))) Params& CP;
DI int ltid() { int t = threadIdx.x; asm volatile("" : "+v"(t)); return t; }
DI int lbid() { int t = blockIdx.x; asm volatile("" : "+s"(t)); return t; }
DI int lgdim() { int t = gridDim.x; asm volatile("" : "+s"(t)); return t; }
#define TIDX ltid()
#define BIDX lbid()
#define GDIM lgdim()
DI CP launder_params() {
  auto kp = __builtin_amdgcn_kernarg_segment_ptr();
  asm volatile("" : "+s"(kp));
  return *(const __attribute__((address_space(4))) Params*)kp;
}


#define XB_TMO      128
#define XB_XCNT(j)  (256  + 64 * (j))
#define XB_XSUB(j)  (1280 + 64 * (j))
#define XB_XGEN(j)  (2304 + 64 * (j))
#define XB_TOP      3328
#define XB_TOPGEN   3392
#define XCD_BAR_WORDS 3456
#define XB_SPIN_CAP (1u << 22)
#define LAS __attribute__((address_space(3)))
DI unsigned xb_ld(unsigned* p) { return __hip_atomic_load(p, __ATOMIC_RELAXED, __HIP_MEMORY_SCOPE_AGENT); }
DI unsigned xb_add(unsigned* p, unsigned v) { return __hip_atomic_fetch_add(p, v, __ATOMIC_RELAXED, __HIP_MEMORY_SCOPE_AGENT); }
DI unsigned xb_xcc_id() { return (unsigned)__builtin_amdgcn_s_getreg((3 << 11) | 20) & 0xFu; }
#define XB_SPIN(cond, bar) do { unsigned _sp = 0; while (cond) { __builtin_amdgcn_s_sleep(1); \
    if ((++_sp & 255u) == 0u) { if (xb_ld(&(bar)[XB_TMO])) break; if (_sp > XB_SPIN_CAP) { atomicAdd(&(bar)[XB_TMO], 1u); break; } } } } while (0)
struct XcdBarrier { unsigned* bar; unsigned x; volatile LAS unsigned* st; };
DI XcdBarrier xcd_barrier_post(unsigned* bar, volatile LAS unsigned* st) {
  XcdBarrier b; b.bar = bar; b.x = xb_xcc_id(); b.st = st;
  if (threadIdx.x == 0) (void)xb_add(&bar[XB_XCNT(b.x)], 1u);
  return b;
}
DI void xcd_barrier_complete(unsigned* bar, unsigned x, unsigned& nloc, unsigned& nx) {
  const unsigned G = gridDim.x * gridDim.y * gridDim.z;
  unsigned sum, cnt, mine, sp = 0u;
  for (;;) {
    sum = 0u; cnt = 0u; mine = 0u;
#pragma unroll
    for (unsigned j = 0; j < 16; ++j) { const unsigned c = xb_ld(&bar[XB_XCNT(j)]); sum += c; cnt += (c > 0u) ? 1u : 0u; mine = (j == x) ? c : mine; }
    if (sum == G) break;
    __builtin_amdgcn_s_sleep(1);
    if ((++sp & 255u) == 0u) { if (xb_ld(&bar[XB_TMO])) break; if (sp > XB_SPIN_CAP) { atomicAdd(&bar[XB_TMO], 1u); break; } }
  }
  nloc = mine > 0u ? mine : 1u; nx = cnt > 0u ? cnt : 1u;
}
DI void xcd_barrier(const XcdBarrier& b) {
  asm volatile("s_waitcnt vmcnt(0)" ::: "memory");
  __syncthreads();
  if (threadIdx.x == 0) {
    unsigned* bar = b.bar;
    __builtin_amdgcn_s_waitcnt(0);
    unsigned nloc = b.st[0], nx = b.st[1];
    if (nloc == 0u) { xcd_barrier_complete(bar, b.x, nloc, nx); b.st[0] = nloc; b.st[1] = nx; }
    const unsigned old = xb_add(&bar[XB_XSUB(b.x)], 1u);
    const unsigned gen = old / nloc;
    if (old + 1u == (gen + 1u) * nloc) {
      __builtin_amdgcn_fence(__ATOMIC_RELEASE, "agent");
      asm volatile("s_waitcnt vmcnt(0)" ::: "memory");
      const unsigned og = xb_add(&bar[XB_TOP], 1u);
      const unsigned tg = og / nx;
      if (og + 1u == (tg + 1u) * nx) xb_add(&bar[XB_TOPGEN], 1u);
      else XB_SPIN(xb_ld(&bar[XB_TOPGEN]) == tg, bar);
      __builtin_amdgcn_fence(__ATOMIC_ACQUIRE, "agent");
      xb_add(&bar[XB_XGEN(b.x)], 1u);
      asm volatile("s_waitcnt vmcnt(0)" ::: "memory");
    } else {
      XB_SPIN(xb_ld(&bar[XB_XGEN(b.x)]) == gen, bar);
      __builtin_amdgcn_fence(__ATOMIC_ACQUIRE, "agent");
      asm volatile("s_waitcnt vmcnt(0)" ::: "memory");
    }
  }
  __syncthreads();
}

DI bf16_t f2bf(float x) { return __builtin_bit_cast(bf16_t, (__bf16)x); }
DI float bf2f(bf16_t h) { return __uint_as_float(((unsigned)h) << 16); }
typedef __attribute__((ext_vector_type(2))) __bf16 bf16x2_t;
DI unsigned pack2(float a, float b) { bf16x2_t v; v.x = (__bf16)a; v.y = (__bf16)b; return __builtin_bit_cast(unsigned, v); }
DI bf16x8 pack8_mfma(float a0, float a1, float a2, float a3, float a4, float a5, float a6, float a7) {
  uint4 u = make_uint4(pack2(a0, a1), pack2(a2, a3), pack2(a4, a5), pack2(a6, a7));
  return __builtin_bit_cast(bf16x8, u);
}
DI float sigmf(float x) { return __builtin_amdgcn_rcpf(1.f + __expf(-x)); }
DI float siluf(float x) { return x * sigmf(x); }
DI float dppf(float v, const int ctrl_sel) {
  int iv = __float_as_int(v), r;
  switch (ctrl_sel) {
    case 0: r = __builtin_amdgcn_update_dpp(0, iv, 0xB1, 0xf, 0xf, false); break;
    case 1: r = __builtin_amdgcn_update_dpp(0, iv, 0x4E, 0xf, 0xf, false); break;
    case 2: r = __builtin_amdgcn_update_dpp(0, iv, 0x141, 0xf, 0xf, false); break;
    default: r = __builtin_amdgcn_update_dpp(0, iv, 0x140, 0xf, 0xf, false); break;
  }
  return __int_as_float(r);
}
DI float row16_sum(float v) { v += dppf(v, 0); v += dppf(v, 1); v += dppf(v, 2); v += dppf(v, 3); return v; }
DI float wave_sum(float v) { v = row16_sum(v); v += __shfl_xor(v, 16); v += __shfl_xor(v, 32); return v; }
DI float wave_max(float v) {
  for (int o = 1; o < 64; o <<= 1) v = fmaxf(v, __shfl_xor(v, o));
  return v;
}
DI int crow(int i, int h) { return (i & 3) + 8 * (i >> 2) + 4 * h; }

struct Ptrs {
  float* mod; int* ctr; int* cuf; float* rope; float* bonus; float* mdt; float* mcb; bf16_t* W3; bf16_t* LA; float* xc1; bf16_t* W1; bf16_t* H;
  bf16_t *pA, *pB, *pC, *pD, *VtA, *VtD; bf16_t* R1; bf16_t* R2;
};
DI Ptrs mkptrs(char* ws) {
  Ptrs q;
  q.mod = (float*)(ws + OFF_MOD); q.ctr = (int*)(ws + OFF_CTR); q.rope = (float*)(ws + OFF_ROPE); q.cuf = (int*)(ws + OFF_CUF); q.bonus = (float*)(ws + OFF_BONUS); q.mdt = (float*)(ws + OFF_MDT); q.mcb = (float*)(ws + OFF_MCB);
  q.W3 = (bf16_t*)(ws + OFF_W3); q.LA = (bf16_t*)(ws + OFF_LA); q.xc1 = (float*)(ws + OFF_XC1);
  q.W1 = (bf16_t*)(ws + OFF_W1); q.H = (bf16_t*)(ws + OFF_H);
  q.pA = (bf16_t*)(ws + OFF_PA); q.pB = (bf16_t*)(ws + OFF_PB); q.pC = (bf16_t*)(ws + OFF_PC); q.pD = (bf16_t*)(ws + OFF_PD);
  q.VtA = (bf16_t*)(ws + OFF_VTA); q.VtD = (bf16_t*)(ws + OFF_VTD);
  q.R1 = (bf16_t*)(ws + OFF_R1); q.R2 = (bf16_t*)(ws + OFF_R2);
  return q;
}

DI const float* xrow(CP p, const Ptrs& w, int l, int tok) {
  int b = tok / TPB, i = tok - b * TPB;
  if (l == 0) return i < CTXL ? p.in[2] + (size_t)(b * CTXL + i) * DM : p.in[0] + (size_t)(b * 8192 + i - CTXL) * DM;
  return i < CTXL ? w.xc1 + (size_t)(b * CTXL + i) * DM : p.out + (size_t)(b * 8192 + i - CTXL) * DM;
}

DI void transpose_tile(const float* __restrict__ src, int ld_src, int k0, int n0, bool win_map, bf16_t* __restrict__ dst, int ld_dst, float* sm) {
  const int tid = TIDX;
  __syncthreads();
  {
    int cgp = (tid & 15) * 4, n = n0 + cgp;
    int ns = n;
    if (win_map) ns = n < 5904 ? n : (n < 6016 ? -1 : n - 112);
#pragma unroll
    for (int i = 0; i < 4; ++i) {
      int kk = (tid >> 4) + 16 * i;
      float4 v = make_float4(0.f, 0.f, 0.f, 0.f);
      if (ns >= 0) v = *(const float4*)(src + (size_t)(k0 + kk) * ld_src + ns);
      float* d = sm + kk * 65 + cgp;
      d[0] = v.x; d[1] = v.y; d[2] = v.z; d[3] = v.w;
    }
  }
  __syncthreads();
  {
    int n = tid >> 2, kq = (tid & 3) * 16;
    unsigned o[8];
#pragma unroll
    for (int j = 0; j < 8; ++j) o[j] = pack2(sm[(kq + 2 * j) * 65 + n], sm[(kq + 2 * j + 1) * 65 + n]);
    uint4* dp = (uint4*)(dst + (size_t)(n0 + n) * ld_dst + k0 + kq);
    dp[0] = make_uint4(o[0], o[1], o[2], o[3]);
    dp[1] = make_uint4(o[4], o[5], o[6], o[7]);
  }
}

DI void gemm_128(const bf16_t* __restrict__ A, int lda, const bf16_t* __restrict__ B, int ldb, int K, f32x16 (&acc)[2][2], bf16_t* sA, bf16_t* sB) {
  const int tid = TIDX, lane = tid & 63, wid = tid >> 6, wm = wid >> 1, wn = wid & 1, r = lane & 31, h = lane >> 5;
  const int lrow = tid >> 3, lkc = (tid & 7) * 8;
  const bf16_t* ga = A + (size_t)lrow * lda + lkc;
  const bf16_t* gb = B + (size_t)lrow * ldb + lkc;
  uint4 ra0, ra1, ra2, ra3, rb0, rb1, rb2, rb3;
  ra0 = *(const uint4*)(ga); ra1 = *(const uint4*)(ga + (size_t)32 * lda); ra2 = *(const uint4*)(ga + (size_t)64 * lda); ra3 = *(const uint4*)(ga + (size_t)96 * lda);
  rb0 = *(const uint4*)(gb); rb1 = *(const uint4*)(gb + (size_t)32 * ldb); rb2 = *(const uint4*)(gb + (size_t)64 * ldb); rb3 = *(const uint4*)(gb + (size_t)96 * ldb);
  for (int k0 = 0; k0 < K; k0 += 64) {
    __syncthreads();
    *(uint4*)(sA + (lrow) * 72 + lkc) = ra0; *(uint4*)(sA + (lrow + 32) * 72 + lkc) = ra1; *(uint4*)(sA + (lrow + 64) * 72 + lkc) = ra2; *(uint4*)(sA + (lrow + 96) * 72 + lkc) = ra3;
    *(uint4*)(sB + (lrow) * 72 + lkc) = rb0; *(uint4*)(sB + (lrow + 32) * 72 + lkc) = rb1; *(uint4*)(sB + (lrow + 64) * 72 + lkc) = rb2; *(uint4*)(sB + (lrow + 96) * 72 + lkc) = rb3;
    __syncthreads();
    if (k0 + 64 < K) {
      const bf16_t* ga2 = ga + k0 + 64; const bf16_t* gb2 = gb + k0 + 64;
      ra0 = *(const uint4*)(ga2); ra1 = *(const uint4*)(ga2 + (size_t)32 * lda); ra2 = *(const uint4*)(ga2 + (size_t)64 * lda); ra3 = *(const uint4*)(ga2 + (size_t)96 * lda);
      rb0 = *(const uint4*)(gb2); rb1 = *(const uint4*)(gb2 + (size_t)32 * ldb); rb2 = *(const uint4*)(gb2 + (size_t)64 * ldb); rb3 = *(const uint4*)(gb2 + (size_t)96 * ldb);
    }
#pragma unroll
    for (int s = 0; s < 4; ++s) {
      bf16x8 a0 = *(const bf16x8*)(sA + (wm * 64 + r) * 72 + s * 16 + h * 8);
      bf16x8 a1 = *(const bf16x8*)(sA + (wm * 64 + 32 + r) * 72 + s * 16 + h * 8);
      bf16x8 b0 = *(const bf16x8*)(sB + (wn * 64 + r) * 72 + s * 16 + h * 8);
      bf16x8 b1 = *(const bf16x8*)(sB + (wn * 64 + 32 + r) * 72 + s * 16 + h * 8);
      acc[0][0] = MFMA(a0, b0, acc[0][0]); acc[0][1] = MFMA(a0, b1, acc[0][1]);
      acc[1][0] = MFMA(a1, b0, acc[1][0]); acc[1][1] = MFMA(a1, b1, acc[1][1]);
    }
  }
}
DI void gemm_128_deep(const bf16_t* __restrict__ A, int lda, const bf16_t* __restrict__ B, int ldb, int K, f32x16 (&acc)[2][2], bf16_t* sA, bf16_t* sBunused) {
  (void)sBunused;
  const int tid = TIDX, lane = tid & 63, wid = tid >> 6, wm = wid >> 1, wn = wid & 1, r = lane & 31, h = lane >> 5;
  const int lrow = tid >> 3, lkc = (tid & 7) * 8;
  const bf16_t* ga = A + (size_t)lrow * lda + lkc;
  const bf16_t* gb = B + (size_t)lrow * ldb + lkc;
  uint4 pa0, pa1, pa2, pa3, pb0, pb1, pb2, pb3, qa0, qa1, qa2, qa3, qb0, qb1, qb2, qb3;
#define GL_P(off) { const bf16_t* x = ga + (off); const bf16_t* y = gb + (off); \
    pa0 = *(const uint4*)(x); pa1 = *(const uint4*)(x + (size_t)32 * lda); pa2 = *(const uint4*)(x + (size_t)64 * lda); pa3 = *(const uint4*)(x + (size_t)96 * lda); \
    pb0 = *(const uint4*)(y); pb1 = *(const uint4*)(y + (size_t)32 * ldb); pb2 = *(const uint4*)(y + (size_t)64 * ldb); pb3 = *(const uint4*)(y + (size_t)96 * ldb); }
#define GL_Q(off) { const bf16_t* x = ga + (off); const bf16_t* y = gb + (off); \
    qa0 = *(const uint4*)(x); qa1 = *(const uint4*)(x + (size_t)32 * lda); qa2 = *(const uint4*)(x + (size_t)64 * lda); qa3 = *(const uint4*)(x + (size_t)96 * lda); \
    qb0 = *(const uint4*)(y); qb1 = *(const uint4*)(y + (size_t)32 * ldb); qb2 = *(const uint4*)(y + (size_t)64 * ldb); qb3 = *(const uint4*)(y + (size_t)96 * ldb); }
#define ST_LDS(buf, a0, a1, a2, a3, b0, b1, b2, b3) { bf16_t* da = sA + (buf) * (2 * 128 * 72); bf16_t* db = da + 128 * 72; \
    *(uint4*)(da + (lrow) * 72 + lkc) = a0; *(uint4*)(da + (lrow + 32) * 72 + lkc) = a1; *(uint4*)(da + (lrow + 64) * 72 + lkc) = a2; *(uint4*)(da + (lrow + 96) * 72 + lkc) = a3; \
    *(uint4*)(db + (lrow) * 72 + lkc) = b0; *(uint4*)(db + (lrow + 32) * 72 + lkc) = b1; *(uint4*)(db + (lrow + 64) * 72 + lkc) = b2; *(uint4*)(db + (lrow + 96) * 72 + lkc) = b3; }
#define MMA_TILE(buf) { const bf16_t* ca = sA + (buf) * (2 * 128 * 72); const bf16_t* cb = ca + 128 * 72; \
    _Pragma("unroll") for (int s = 0; s < 4; ++s) { \
      bf16x8 a0 = *(const bf16x8*)(ca + (wm * 64 + r) * 72 + s * 16 + h * 8); \
      bf16x8 a1 = *(const bf16x8*)(ca + (wm * 64 + 32 + r) * 72 + s * 16 + h * 8); \
      bf16x8 b0 = *(const bf16x8*)(cb + (wn * 64 + r) * 72 + s * 16 + h * 8); \
      bf16x8 b1 = *(const bf16x8*)(cb + (wn * 64 + 32 + r) * 72 + s * 16 + h * 8); \
      acc[0][0] = MFMA(a0, b0, acc[0][0]); acc[0][1] = MFMA(a0, b1, acc[0][1]); \
      acc[1][0] = MFMA(a1, b0, acc[1][0]); acc[1][1] = MFMA(a1, b1, acc[1][1]); } }
  GL_P(0)
  GL_Q(64)
  __syncthreads();
  ST_LDS(0, pa0, pa1, pa2, pa3, pb0, pb1, pb2, pb3)
  GL_P(128)
  __syncthreads();
  for (int k0 = 0; k0 < K; k0 += 128) {
    MMA_TILE(0)
    ST_LDS(1, qa0, qa1, qa2, qa3, qb0, qb1, qb2, qb3)
    GL_Q(min(k0 + 192, K - 64))
    __syncthreads();
    MMA_TILE(1)
    ST_LDS(0, pa0, pa1, pa2, pa3, pb0, pb1, pb2, pb3)
    GL_P(min(k0 + 256, K - 64))
    __syncthreads();
  }
#undef GL_P
#undef GL_Q
#undef ST_LDS
#undef MMA_TILE
}
DI bool tile_map(int k, int MT, int NT, int& mt, int& nt) {
  const int gd = GDIM, b = BIDX;
  if (gd & 63) { int it = b + k * gd; if (it >= MT * NT) return false; mt = it / NT; nt = it - mt * NT; return true; }
  const int gsm = gd >> 6, x = b & 7, j = b >> 3;
  const int ngn = (NT + 7) >> 3, ngm = (MT + gsm - 1) / gsm;
  const int g = k * 8 + x;
  if (g >= ngm * ngn) return false;
  const int gm = g / ngn, gn = g - gm * ngn;
  mt = gm * gsm + (j >> 3); nt = gn * 8 + (j & 7);
  return mt < MT && nt < NT;
}
DI int tile_rounds(int MT, int NT) {
  const int gd = GDIM;
  if (gd & 63) return (MT * NT + gd - 1) / gd;
  const int gsm = gd >> 6;
  return (((NT + 7) >> 3) * ((MT + gsm - 1) / gsm) + 7) >> 3;
}
DI void zero_acc(f32x16 (&acc)[2][2]) {
#pragma unroll
  for (int a = 0; a < 2; ++a)
#pragma unroll
    for (int b = 0; b < 2; ++b)
#pragma unroll
      for (int i = 0; i < 16; ++i) acc[a][b][i] = 0.f;
}

DI void phase_ada_item(CP p, const Ptrs& w, int l, int item, int ksplit, float* sm) {
  const int tid = TIDX, lane = tid & 63, wid = tid >> 6;
  const int cgp = item % 96, kq = item / 96, j = cgp * 64 + lane;
  const int rows_w = 512 / ksplit;
  float* act = sm;
  float* red = sm + 3 * 2048;
  __syncthreads();
  for (int e = tid; e < 3 * 2048; e += 256) {
    int v = e >> 11, k = e & 2047;
    float x = v < 2 ? p.in[1][v * 2048 + k] : p.in[3][k];
    act[e] = siluf(x);
  }
  __syncthreads();
  const float* wa = p.in[5] + (size_t)l * 2048 * 6144 + j;
  float a0 = 0.f, a1 = 0.f, a2 = 0.f;
  const int kb = kq * (2048 / ksplit) + wid * rows_w;
#pragma unroll 32
  for (int k = 0; k < rows_w; ++k) {
    float wv = wa[(size_t)(kb + k) * 6144];
    a0 += act[kb + k] * wv; a1 += act[2048 + kb + k] * wv; a2 += act[4096 + kb + k] * wv;
  }
  red[(wid * 3 + 0) * 64 + lane] = a0; red[(wid * 3 + 1) * 64 + lane] = a1; red[(wid * 3 + 2) * 64 + lane] = a2;
  __syncthreads();
  if (tid < 192) {
    int v = tid >> 6, ll = tid & 63, jj = cgp * 64 + ll;
    float s = red[(0 * 3 + v) * 64 + ll] + red[(1 * 3 + v) * 64 + ll] + red[(2 * 3 + v) * 64 + ll] + red[(3 * 3 + v) * 64 + ll];
    if (ksplit == 1) w.mod[(l * 3 + v) * 6144 + jj] = s + p.in[6][l * 6144 + jj];
    else atomicAdd(&w.mod[(l * 3 + v) * 6144 + jj], kq == 0 ? s + p.in[6][l * 6144 + jj] : s);
  }
}
DI void conv_w1(CP p, const Ptrs& w, int l, float* sm) {
  const float* src = p.in[7] + (size_t)l * 2048 * 7952;
  for (int it = BIDX; it < 126 * 32; it += GDIM) {
    int nt = it >> 5, kt = it & 31;
    transpose_tile(src, 7952, kt * 64, nt * 64, true, w.W1, 2048, sm);
  }
}
DI void conv_w3(CP p, const Ptrs& w, int l, float* sm) {
  for (int it = BIDX; it < 32; it += GDIM) {
    int m = it >> 3, nt = it & 7, type = m >> 1, dir = m & 1;
    const float* src = p.in[type == 0 ? 13 : 15] + (size_t)((l * 2 + dir) * 64) * 512;
    transpose_tile(src, 512, 0, nt * 64, false, w.W3 + (size_t)m * 512 * 64, 64, sm);
  }
}
DI void conv_w2(CP p, const Ptrs& w, int l, float* sm) {
  bf16_t* gate_t = (bf16_t*)((char*)w.R1 + R1_GATE);
  bf16_t* up_t = (bf16_t*)((char*)w.R1 + R1_UP);
  bf16_t* out_t = (bf16_t*)((char*)w.R1 + R1_OUT);
  for (int it = BIDX; it < 6144; it += GDIM) {
    if (it < 4096) {
      int i = it >> 10, r = it & 1023, nt = r >> 5, kt = r & 31;
      transpose_tile(p.in[34] + (size_t)(l * 4 + i) * 2048 * 2048, 2048, kt * 64, nt * 64, false, gate_t + (size_t)i * 2048 * 2048, 2048, sm);
    } else if (it < 5120) {
      int q = it - 4096, i = q >> 8, r = q & 255, nt = r >> 3, kt = r & 7;
      transpose_tile(p.in[35] + (size_t)(l * 4 + i) * 512 * 2048, 2048, kt * 64, nt * 64, false, up_t + (size_t)i * 2048 * 512, 512, sm);
    } else {
      int r = it - 5120, nt = r >> 5, kt = r & 31;
      transpose_tile(p.in[36] + (size_t)l * 2048 * 2048, 2048, kt * 64, nt * 64, false, out_t, 2048, sm);
    }
  }
}

DI void phase_norm(CP p, const Ptrs& w, int l) {
  const int lane = TIDX & 63, gw = BIDX * 4 + (TIDX >> 6), nw = GDIM * 4;
  const float* nwt = p.in[4] + l * 2048;
  for (int tok = gw; tok < T; tok += nw) {
    int b = tok / TPB, i = tok - b * TPB, v = i < CTXL ? 2 : b;
    const float* xr = xrow(p, w, l, tok);
    const float* md = w.mod + (l * 3 + v) * 6144;
    float4 xv[8];
    float ss = 0.f;
#pragma unroll
    for (int j = 0; j < 8; ++j) { xv[j] = *(const float4*)(xr + (j * 64 + lane) * 4); ss += xv[j].x * xv[j].x + xv[j].y * xv[j].y + xv[j].z * xv[j].z + xv[j].w * xv[j].w; }
    ss = wave_sum(ss);
    float inv = rsqrtf(ss * (1.f / 2048.f) + 1e-6f);
#pragma unroll
    for (int j = 0; j < 8; ++j) {
      int c = (j * 64 + lane) * 4;
      float4 nw4 = *(const float4*)(nwt + c), sh = *(const float4*)(md + c), sc = *(const float4*)(md + 2048 + c);
      float y0 = xv[j].x * inv * nw4.x * (1.f + sc.x) + sh.x, y1 = xv[j].y * inv * nw4.y * (1.f + sc.y) + sh.y;
      float y2 = xv[j].z * inv * nw4.z * (1.f + sc.z) + sh.z, y3 = xv[j].w * inv * nw4.w * (1.f + sc.w) + sh.w;
      *(uint2*)(w.H + (size_t)tok * 2048 + c) = make_uint2(pack2(y0, y1), pack2(y2, y3));
    }
  }
}

DI void phase_inproj(CP p, const Ptrs& w, int l, bf16_t* sA, bf16_t* sB) {
  const int tid = TIDX, lane = tid & 63, wid = tid >> 6, wm = wid >> 1, wn = wid & 1, r = lane & 31, h = lane >> 5;
  const int nrounds = tile_rounds(132, 63);
  for (int kk = 0; kk < nrounds; ++kk) {
    int mt, nt;
    if (!tile_map(kk, 132, 63, mt, nt)) continue;
    int m0 = mt * 128, n0 = nt * 128;
    f32x16 acc[2][2];
    zero_acc(acc);
    gemm_128_deep(w.H + (size_t)m0 * 2048, 2048, w.W1 + (size_t)n0 * 2048, 2048, 2048, acc, sA, sB);
    bf16_t* dst = nullptr; int stride = 0, cbase = 0; bf16_t* vt = nullptr; int vbase = 0;
    if (n0 < 2048) { int sub = n0 >> 9; if (sub == 2) { vt = w.VtA; vbase = n0 - 1024; } else { dst = w.pA; stride = SPA; cbase = sub == 3 ? n0 - 512 : n0; } }
    else if (n0 < 4352) { dst = w.pB; stride = SPB; cbase = n0 - 2048; }
    else if (n0 < 6016) { dst = w.pC; stride = SPC; cbase = n0 - 4352; }
    else { int cd = n0 - 6016, sub = cd >> 9; if (sub == 2) { vt = w.VtD; vbase = cd - 1024; } else { dst = w.pD; stride = SPD; cbase = sub == 3 ? cd - 512 : cd; } }
    if (dst) {
#pragma unroll
      for (int mi = 0; mi < 2; ++mi)
#pragma unroll
        for (int ni = 0; ni < 2; ++ni)
#pragma unroll
          for (int i = 0; i < 16; ++i) {
            int row = m0 + wm * 64 + mi * 32 + crow(i, h), col = cbase + wn * 64 + ni * 32 + r;
            dst[(size_t)row * stride + col] = f2bf(acc[mi][ni][i]);
          }
    } else {
      int b = m0 / TPB, ib = m0 - b * TPB;
#pragma unroll
      for (int mi = 0; mi < 2; ++mi)
#pragma unroll
        for (int ni = 0; ni < 2; ++ni)
#pragma unroll
          for (int g = 0; g < 4; ++g) {
            int i0 = ib + wm * 64 + mi * 32 + 8 * g + 4 * h, vcol = vbase + wn * 64 + ni * 32 + r;
            *(uint2*)(vt + (size_t)(b * 512 + vcol) * TPB + i0) =
                make_uint2(pack2(acc[mi][ni][4 * g], acc[mi][ni][4 * g + 1]), pack2(acc[mi][ni][4 * g + 2], acc[mi][ni][4 * g + 3]));
          }
    }
  }
  if (l == 0) {
    __shared__ int s_ada;
    for (;;) {
      __syncthreads();
      if (TIDX == 0) s_ada = atomicAdd(&w.ctr[40], 1);
      __syncthreads();
      const int it = s_ada;
      if (it >= 96) break;
      phase_ada_item(p, w, 1, it, 1, (float*)sA);
    }
  }
}

DI float quad_sum(float v) { v += dppf(v, 0); v += dppf(v, 1); return v; }
DI float row8_sum(float v) { v += dppf(v, 0); v += dppf(v, 1); v += dppf(v, 2); return v; }
DI void unpack8(uint4 u, float* f) {
  f[0] = __uint_as_float(u.x << 16); f[1] = __uint_as_float(u.x & 0xffff0000u); f[2] = __uint_as_float(u.y << 16); f[3] = __uint_as_float(u.y & 0xffff0000u);
  f[4] = __uint_as_float(u.z << 16); f[5] = __uint_as_float(u.z & 0xffff0000u); f[6] = __uint_as_float(u.w << 16); f[7] = __uint_as_float(u.w & 0xffff0000u);
}
DI uint4 pack8(const float* f) { return make_uint4(pack2(f[0], f[1]), pack2(f[2], f[3]), pack2(f[4], f[5]), pack2(f[6], f[7])); }
DI void phase_prep(CP p, const Ptrs& w, int l) {
  const int lane = TIDX & 63, gw = BIDX * 4 + (TIDX >> 6), nw = GDIM * 4;
  const int qd = lane & 3, vec = lane >> 2;
  float wa[16], wd[16];
  {
    const float* sa = (vec < 8 ? p.in[8] : p.in[9]) + l * 64 + qd * 16;
    const float* sd = (vec < 8 ? p.in[27] : p.in[28]) + l * 64 + qd * 16;
    const float qs = vec < 8 ? QS : 1.f;
#pragma unroll
    for (int j = 0; j < 16; ++j) { wa[j] = sa[j] * qs; wd[j] = sd[j] * qs; }
  }
  float mu4[4];
#pragma unroll
  for (int j = 0; j < 4; ++j) mu4[j] = p.in[11][l * 1792 + 1536 + lane * 4 + j];
  float cwB[4][4], cwC[4][4];
#pragma unroll
  for (int j = 0; j < 4; ++j) {
#pragma unroll
    for (int q = 0; q < 3; ++q) { cwB[q][j] = p.in[21][(l * 3 + q) * 1024 + 512 + lane * 4 + j]; cwC[q][j] = p.in[21][(l * 3 + q) * 1024 + 768 + lane * 4 + j]; }
    cwB[3][j] = p.in[22][l * 1024 + 512 + lane * 4 + j]; cwC[3][j] = p.in[22][l * 1024 + 768 + lane * 4 + j];
  }
  const float dtb_l = lane < 16 ? p.in[23][l * 16 + lane] : 0.f;
  const float Aneg_l = lane < 16 ? -__expf(p.in[24][l * 16 + lane]) : 0.f;
  for (int tok = gw; tok < T; tok += nw) {
    int b = tok / TPB, i = tok - b * TPB;
    bool isx = i >= CTXL;
    int ti = i - CTXL;
    uint4* pa = (uint4*)(w.pA + (size_t)tok * SPA) + lane * 2;
    uint4* pd = (uint4*)(w.pD + (size_t)tok * SPD) + lane * 2;
    const bf16_t* rb = w.pB + (size_t)tok * SPB + 1536 + lane * 4;
    bool hp = (i != 0) && (i != CTXL), hn = (i != CTXL - 1) && (i != TPB - 1);
    uint4 a0 = pa[0], a1 = pa[1], d0 = pd[0], d1 = pd[1];
    uint2 lc = *(const uint2*)rb, lp = make_uint2(0, 0), ln = make_uint2(0, 0);
    if (hp) lp = *(const uint2*)(rb - SPB);
    if (hn) ln = *(const uint2*)(rb + SPB);
    float4 rt[8];
    if (isx) {
      const float4* tp = (const float4*)(w.rope + (size_t)((qd < 2 ? (ti >> 6) : (ti & 63)) * 32));
#pragma unroll
      for (int j = 0; j < 8; ++j) rt[j] = tp[j];
    }
    float e[16];
    unpack8(a0, e); unpack8(a1, e + 8);
    {
      float ss = 0.f;
#pragma unroll
      for (int j = 0; j < 16; ++j) ss += e[j] * e[j];
      ss = quad_sum(ss);
      float sc = rsqrtf(ss * (1.f / 64.f) + 1e-6f);
#pragma unroll
      for (int j = 0; j < 16; ++j) e[j] = e[j] * sc * wa[j];
      pa[0] = pack8(e); pa[1] = pack8(e + 8);
    }
    unpack8(d0, e); unpack8(d1, e + 8);
    {
      float ss = 0.f;
#pragma unroll
      for (int j = 0; j < 16; ++j) ss += e[j] * e[j];
      ss = quad_sum(ss);
      float sc = rsqrtf(ss * (1.f / 64.f) + 1e-6f);
#pragma unroll
      for (int j = 0; j < 16; ++j) e[j] = e[j] * sc * wd[j];
      if (isx) {
#pragma unroll
        for (int j = 0; j < 16; ++j) {
          float pr = dppf(e[j], 0);
          float cs = (j & 1) ? rt[j >> 1].z : rt[j >> 1].x, sn = (j & 1) ? rt[j >> 1].w : rt[j >> 1].y;
          e[j] = e[j] * cs + ((qd & 1) ? pr : -pr) * sn;
        }
      }
      pd[0] = pack8(e); pd[1] = pack8(e + 8);
    }
    {
      const bf16_t* rc = w.pC + (size_t)tok * SPC;
      uint2 bc = *(const uint2*)(rc + 512 + lane * 4), cc = *(const uint2*)(rc + 768 + lane * 4);
      uint2 bp = make_uint2(0, 0), bn = make_uint2(0, 0), cp = make_uint2(0, 0), cn = make_uint2(0, 0);
      if (hp) { bp = *(const uint2*)(rc + 512 + lane * 4 - SPC); cp = *(const uint2*)(rc + 768 + lane * 4 - SPC); }
      if (hn) { bn = *(const uint2*)(rc + 512 + lane * 4 + SPC); cn = *(const uint2*)(rc + 768 + lane * 4 + SPC); }
      float dtraw = lane < 16 ? bf2f(rc[1024 + lane]) : 0.f;
      float Bc[4] = {__uint_as_float(bc.x << 16), __uint_as_float(bc.x & 0xffff0000u), __uint_as_float(bc.y << 16), __uint_as_float(bc.y & 0xffff0000u)};
      float Bp[4] = {__uint_as_float(bp.x << 16), __uint_as_float(bp.x & 0xffff0000u), __uint_as_float(bp.y << 16), __uint_as_float(bp.y & 0xffff0000u)};
      float Bn[4] = {__uint_as_float(bn.x << 16), __uint_as_float(bn.x & 0xffff0000u), __uint_as_float(bn.y << 16), __uint_as_float(bn.y & 0xffff0000u)};
      float Cc[4] = {__uint_as_float(cc.x << 16), __uint_as_float(cc.x & 0xffff0000u), __uint_as_float(cc.y << 16), __uint_as_float(cc.y & 0xffff0000u)};
      float Cp[4] = {__uint_as_float(cp.x << 16), __uint_as_float(cp.x & 0xffff0000u), __uint_as_float(cp.y << 16), __uint_as_float(cp.y & 0xffff0000u)};
      float Cn[4] = {__uint_as_float(cn.x << 16), __uint_as_float(cn.x & 0xffff0000u), __uint_as_float(cn.y << 16), __uint_as_float(cn.y & 0xffff0000u)};
      float ob[4], oc[4], prod = 0.f;
#pragma unroll
      for (int j = 0; j < 4; ++j) {
        ob[j] = bf2f(f2bf(siluf(cwB[0][j] * Bp[j] + cwB[1][j] * Bc[j] + cwB[2][j] * Bn[j] + cwB[3][j])));
        oc[j] = bf2f(f2bf(siluf(cwC[0][j] * Cp[j] + cwC[1][j] * Cc[j] + cwC[2][j] * Cn[j] + cwC[3][j])));
        prod += ob[j] * oc[j];
      }
      prod = row16_sum(prod); prod += __shfl_xor(prod, 16);
      bf16_t* mb = w.W1 + (size_t)tok * 512;
      *(uint2*)(mb + lane * 4) = make_uint2(pack2(ob[0], ob[1]), pack2(ob[2], ob[3]));
      *(uint2*)(mb + 256 + lane * 4) = make_uint2(pack2(oc[0], oc[1]), pack2(oc[2], oc[3]));
      if ((lane & 31) == 0) w.mcb[(size_t)tok * 2 + (lane >> 5)] = prod;
      if (lane < 16) {
        float dr = dtraw + dtb_l;
        float dt = dr > 20.f ? dr : log1pf(__expf(dr));
        *(float2*)(w.mdt + ((size_t)tok * 16 + lane) * 2) = make_float2(dt, __expf(dt * Aneg_l));
      }
    }
    {
      float c4[4] = {__uint_as_float(lc.x << 16), __uint_as_float(lc.x & 0xffff0000u), __uint_as_float(lc.y << 16), __uint_as_float(lc.y & 0xffff0000u)};
      float p4[4] = {__uint_as_float(lp.x << 16), __uint_as_float(lp.x & 0xffff0000u), __uint_as_float(lp.y << 16), __uint_as_float(lp.y & 0xffff0000u)};
      float n4[4] = {__uint_as_float(ln.x << 16), __uint_as_float(ln.x & 0xffff0000u), __uint_as_float(ln.y << 16), __uint_as_float(ln.y & 0xffff0000u)};
      float o[4];
#pragma unroll
      for (int j = 0; j < 4; ++j) { float sft = c4[j] + (0.5f * (p4[j] + n4[j]) - c4[j]) * mu4[j]; o[j] = lane < 32 ? tanhf(sft) : sft; }
      *(uint2*)(w.LA + (size_t)tok * 256 + lane * 4) = make_uint2(pack2(o[0], o[1]), pack2(o[2], o[3]));
    }
  }
}

DI void phase_lora(CP p, const Ptrs& w, int l, bf16_t* sA, bf16_t* sB) {
  const int tid = TIDX, lane = tid & 63, wid = tid >> 6, wm = wid >> 1, wn = wid & 1, r = lane & 31, h = lane >> 5;
  for (int it = BIDX; it < 132 * 16; it += GDIM) {
    int mt = it >> 4, q = it & 15, m = q >> 2, nt = q & 3, type = m >> 1, dir = m & 1, m0 = mt * 128, n0 = nt * 128;
    f32x16 acc[2][2];
    zero_acc(acc);
    gemm_128(w.LA + (size_t)m0 * 256 + m * 64, 256, w.W3 + (size_t)(m * 512 + n0) * 64, 64, 64, acc, sA, sB);
    const float* bias = p.in[type == 0 ? 12 : 14] + (l * 2 + dir) * 512;
    bf16_t* dst = w.R1 + (size_t)m * T * 512;
#pragma unroll
    for (int mi = 0; mi < 2; ++mi)
#pragma unroll
      for (int ni = 0; ni < 2; ++ni) {
        int col = n0 + wn * 64 + ni * 32 + r;
        float bc = bias[col];
#pragma unroll
        for (int i = 0; i < 16; ++i) {
          int row = m0 + wm * 64 + mi * 32 + crow(i, h);
          float x = acc[mi][ni][i] + bc, o;
          if (type == 0) o = 1.f - __expf(-0.6065306597126334f * sigmf(x));
          else o = sigmf(x);
          dst[(size_t)row * 512 + col] = f2bf(o);
        }
      }
  }
}

DI void phase_rwscal(CP p, const Ptrs& w, int l) {
  const int lane = TIDX & 63, gw = BIDX * 4 + (TIDX >> 6), nw = GDIM * 4;
  const int c0 = lane * 8, hd = lane >> 3;
  float mur[8], muk[8], kkc[8], kac[8], rkc[8];
#pragma unroll
  for (int j = 0; j < 8; ++j) {
    mur[j] = p.in[11][l * 1792 + c0 + j]; muk[j] = p.in[11][l * 1792 + 512 + c0 + j];
    kkc[j] = p.in[16][l * 512 + c0 + j]; kac[j] = p.in[17][l * 512 + c0 + j]; rkc[j] = p.in[18][l * 512 + c0 + j];
  }
  const bf16_t* Ad0 = w.R1 + (size_t)2 * T * 512, *Ad1 = w.R1 + (size_t)3 * T * 512;
  for (int tok = gw; tok < T; tok += nw) {
    int b = tok / TPB, i = tok - b * TPB;
    bool hp = (i != 0) && (i != CTXL), hn = (i != CTXL - 1) && (i != TPB - 1);
    const bf16_t* rb = w.pB + (size_t)tok * SPB + c0;
    uint4 ur = *(const uint4*)rb, uk = *(const uint4*)(rb + 512);
    uint4 urp = make_uint4(0, 0, 0, 0), urn = urp, ukp = urp, ukn = urp;
    if (hp) { urp = *(const uint4*)(rb - SPB); ukp = *(const uint4*)(rb + 512 - SPB); }
    if (hn) { urn = *(const uint4*)(rb + SPB); ukn = *(const uint4*)(rb + 512 + SPB); }
    uint4 ua0 = *(const uint4*)(Ad0 + (size_t)tok * 512 + c0), ua1 = *(const uint4*)(Ad1 + (size_t)tok * 512 + c0);
    float r[8], k[8], t0[8], t1[8];
    unpack8(ur, r); unpack8(urp, t0); unpack8(urn, t1);
#pragma unroll
    for (int j = 0; j < 8; ++j) r[j] = r[j] + (0.5f * (t0[j] + t1[j]) - r[j]) * mur[j];
    unpack8(uk, k); unpack8(ukp, t0); unpack8(ukn, t1);
    float ss = 0.f;
#pragma unroll
    for (int j = 0; j < 8; ++j) { k[j] = k[j] + (0.5f * (t0[j] + t1[j]) - k[j]) * muk[j]; float kv = k[j] * kkc[j]; ss += kv * kv; }
    ss = row8_sum(ss);
    float inv = 1.f / fmaxf(sqrtf(ss), 1e-12f);
    unpack8(ua0, t0); unpack8(ua1, t1);
    float br0 = 0.f, kr0 = 0.f, bo0 = 0.f, br1 = 0.f, kr1 = 0.f, bo1 = 0.f;
#pragma unroll
    for (int j = 0; j < 8; ++j) {
      float kk = k[j] * kkc[j] * inv;
      float kd0 = k[j] * (1.f + (t0[j] - 1.f) * kac[j]), kd1 = k[j] * (1.f + (t1[j] - 1.f) * kac[j]);
      br0 += kk * t0[j] * r[j]; br1 += kk * t1[j] * r[j];
      kr0 += kd0 * r[j]; kr1 += kd1 * r[j];
      bo0 += r[j] * kd0 * rkc[j]; bo1 += r[j] * kd1 * rkc[j];
    }
    br0 = row8_sum(br0); br1 = row8_sum(br1); kr0 = row8_sum(kr0); kr1 = row8_sum(kr1); bo0 = row8_sum(bo0); bo1 = row8_sum(bo1);
    if ((lane & 7) == 0) {
      float4* dst = (float4*)(w.bonus + ((size_t)tok * 8 + hd) * 8);
      dst[0] = make_float4(inv, br0, kr0, bo0);
      dst[1] = make_float4(br1, kr1, bo1, 0.f);
    }
  }
}

DI int pos2i(int pos, int dir) { return dir == 0 ? pos : (pos < CTXL ? CTXL - 1 - pos : (TPB + CTXL - 1) - pos); }

DI void rwkv_scan(CP p, const Ptrs& w, int l, int item, float* sm) {
  const int tid = TIDX, lane = tid & 63, wid = tid >> 6;
  const int chain = item >> 2, rq = item & 3, b = chain >> 4, hd = (chain >> 1) & 7, dir = chain & 1;
  const int sj = tid >> 4, skq = (tid & 15) * 4, sc_ = hd * 64 + skq;
  float mu_r[4], mu_k[4], mu_v[4], kk_c[4], ka_c[4];
#pragma unroll
  for (int j = 0; j < 4; ++j) {
    mu_r[j] = p.in[11][l * 1792 + sc_ + j]; mu_k[j] = p.in[11][l * 1792 + 512 + sc_ + j]; mu_v[j] = p.in[11][l * 1792 + 1024 + sc_ + j];
    kk_c[j] = p.in[16][l * 512 + sc_ + j]; ka_c[j] = p.in[17][l * 512 + sc_ + j];
  }
  const bf16_t* Wd = w.R1 + (size_t)(0 * 2 + dir) * T * 512;
  const bf16_t* Ad = w.R1 + (size_t)(1 * 2 + dir) * T * 512;
  bf16_t* yout = w.R2 + (size_t)dir * T * 512;
  constexpr int BUF = 6 * 1024 + 32;
  const int kg = lane & 15, rs = lane >> 4, row = rq * 16 + wid * 4 + rs;
  f2v SA = {0.f, 0.f}, SB = {0.f, 0.f};
  struct RPre { uint2 pq[3][3], pwd, pad_; float psc[3], pmk[2]; };
  RPre PA, PB;
  auto load = [&](int c, RPre& P) {
    int ii = pos2i(c * 16 + sj, dir);
    size_t tok = (size_t)b * TPB + ii;
    const bf16_t* prow = w.pB + tok * SPB + sc_;
    bool hp = (ii != 0) && (ii != CTXL), hn = (ii != CTXL - 1) && (ii != TPB - 1);
    const int op = hp ? -SPB : 0, on = hn ? SPB : 0;
    P.pmk[0] = hp ? 0.5f : 0.f; P.pmk[1] = hn ? 0.5f : 0.f;
#pragma unroll
    for (int q = 0; q < 3; ++q) {
      P.pq[q][0] = *(const uint2*)(prow + q * 512);
      P.pq[q][1] = *(const uint2*)(prow + q * 512 + op);
      P.pq[q][2] = *(const uint2*)(prow + q * 512 + on);
    }
    P.pwd = *(const uint2*)(Wd + tok * 512 + sc_);
    P.pad_ = *(const uint2*)(Ad + tok * 512 + sc_);
    const float* sc = w.bonus + (tok * 8 + hd) * 8;
    P.psc[0] = sc[0]; P.psc[1] = sc[1 + 3 * dir]; P.psc[2] = sc[2 + 3 * dir];
  };
  auto up4 = [](uint2 u, float* f) { f[0] = __uint_as_float(u.x << 16); f[1] = __uint_as_float(u.x & 0xffff0000u); f[2] = __uint_as_float(u.y << 16); f[3] = __uint_as_float(u.y & 0xffff0000u); };
  auto stage = [&](const RPre& P, float* bufp) {
    float rc[4], rp[4], rn[4], kc[4], kp[4], kn[4], vc[4], vp[4], vn[4], wd4[4], ad4[4];
    up4(P.pq[0][0], rc); up4(P.pq[0][1], rp); up4(P.pq[0][2], rn);
    up4(P.pq[1][0], kc); up4(P.pq[1][1], kp); up4(P.pq[1][2], kn);
    up4(P.pq[2][0], vc); up4(P.pq[2][1], vp); up4(P.pq[2][2], vn);
    up4(P.pwd, wd4); up4(P.pad_, ad4);
    float o0[4], o1[4], o2[4], o3[4], o4[4], o5[4];
#pragma unroll
    for (int j = 0; j < 4; ++j) {
      float r_s = rc[j] + ((P.pmk[0] * rp[j] + P.pmk[1] * rn[j]) - rc[j]) * mu_r[j];
      float k_s = kc[j] + ((P.pmk[0] * kp[j] + P.pmk[1] * kn[j]) - kc[j]) * mu_k[j];
      float v_s = vc[j] + ((P.pmk[0] * vp[j] + P.pmk[1] * vn[j]) - vc[j]) * mu_v[j];
      float kk = k_s * kk_c[j] * P.psc[0];
      float a = ad4[j], wv = 1.f - wd4[j];
      o0[j] = -kk; o1[j] = wv * r_s; o2[j] = wv; o3[j] = kk * a; o4[j] = k_s * (1.f + (a - 1.f) * ka_c[j]); o5[j] = v_s;
    }
    float* d = bufp + sj * 64 + skq;
    *(float4*)(d + 0 * 1024) = make_float4(o0[0], o0[1], o0[2], o0[3]);
    *(float4*)(d + 1 * 1024) = make_float4(o1[0], o1[1], o1[2], o1[3]);
    *(float4*)(d + 2 * 1024) = make_float4(o2[0], o2[1], o2[2], o2[3]);
    *(float4*)(d + 3 * 1024) = make_float4(o3[0], o3[1], o3[2], o3[3]);
    *(float4*)(d + 4 * 1024) = make_float4(o4[0], o4[1], o4[2], o4[3]);
    *(float4*)(d + 5 * 1024) = make_float4(o5[0], o5[1], o5[2], o5[3]);
    if (skq == 0) *(float2*)(bufp + 6 * 1024 + sj * 2) = make_float2(P.psc[1], P.psc[2]);
  };
  float* sY = sm + 2 * BUF;
  const int prow16 = wid * 4 + rs;
  const int ysel = (kg == 0) ? prow16 : (512 + tid);
  struct RStep { f4v a4, wr4, w4, b4, k4; float vv; float2 sc; };
  auto lds_step = [&](const float* bf, int j) {
    RStep q;
    q.a4 = *(const f4v*)(bf + 0 * 1024 + j * 64 + 4 * kg);
    q.wr4 = *(const f4v*)(bf + 1 * 1024 + j * 64 + 4 * kg);
    q.w4 = *(const f4v*)(bf + 2 * 1024 + j * 64 + 4 * kg);
    q.b4 = *(const f4v*)(bf + 3 * 1024 + j * 64 + 4 * kg);
    q.k4 = *(const f4v*)(bf + 4 * 1024 + j * 64 + 4 * kg);
    q.vv = bf[5 * 1024 + j * 64 + row];
    q.sc = *(const float2*)(bf + 6 * 1024 + j * 2);
    return q;
  };
  auto flush = [&](int c) {
    {
      int j = tid >> 4, rr = tid & 15;
      int ii = pos2i(c * 16 + j, dir);
      yout[((size_t)b * TPB + ii) * 512 + hd * 64 + rq * 16 + rr] = f2bf(sY[(c & 1) * 256 + j * 16 + rr]);
    }
  };
  __syncthreads();
  load(0, PA);
  stage(PA, sm);
  load(1, PB);
  __syncthreads();
  const int NCH = TPB / 16;
  auto run_chunk = [&](int c, const float* bf, float* sy) {
    flush(max(c - 1, 0));
    RStep cur = lds_step(bf, 0);
#pragma unroll
    for (int j = 0; j < 16; ++j) {
      RStep nxt = cur;
      if (j + 1 < 16) nxt = lds_step(bf, j + 1);
      f2v sa2 = SA * cur.a4.xy + SB * cur.a4.zw;
      f2v yp2 = SA * cur.wr4.xy + SB * cur.wr4.zw;
      float sa = sa2.x + sa2.y, yp = yp2.x + yp2.y;
      sa = row16_sum(sa); yp = row16_sum(yp);
      float y = yp + sa * cur.sc.x + cur.vv * cur.sc.y;
      SA = SA * cur.w4.xy + (sa * cur.b4.xy + cur.vv * cur.k4.xy);
      SB = SB * cur.w4.zw + (sa * cur.b4.zw + cur.vv * cur.k4.zw);
      sy[(kg == 0 ? j * 16 : 0) + ysel - (c & 1) * 0] = y;
      cur = nxt;
    }
  };
  for (int c = 0; c < NCH; c += 2) {
    load(min(c + 2, NCH - 1), PA);
    run_chunk(c, sm, sY);
    stage(PB, sm + BUF);
    __syncthreads();
    load(min(c + 3, NCH - 1), PB);
    run_chunk(c + 1, sm + BUF, sY + 256);
    stage(PA, sm);
    __syncthreads();
  }
  flush(NCH - 1);
}

DI void mamba_scan(CP p, const Ptrs& w, int l, int item, float* sm) {
  const int tid = TIDX, lane = tid & 63, wid = tid >> 6;
  const int chain = item >> 2, pq = item & 3, b = chain >> 4, hd = (chain >> 1) & 7, dir = chain & 1, gp = hd >> 2;
  const float* cw = p.in[21] + l * 3 * 1024;
  const float* cbv = p.in[22] + l * 1024;
  const int n_ = tid & 127, jh = tid >> 7;
  const int chB = 512 + gp * 128 + n_, chC = 768 + gp * 128 + n_;
  const float wB0 = cw[chB], wB1 = cw[1024 + chB], wB2 = cw[2048 + chB], bB = cbv[chB];
  const float wC0 = cw[chC], wC1 = cw[1024 + chC], wC2 = cw[2048 + chC], bC = cbv[chC];
  const int xj = tid >> 4, xp = tid & 15, chX = hd * 64 + pq * 16 + xp;
  const float wX0 = cw[chX], wX1 = cw[1024 + chX], wX2 = cw[2048 + chX], bX = cbv[chX];
  const float dtb = p.in[23][(l * 2 + dir) * 8 + hd];
  const float Aneg = -__expf(p.in[24][(l * 2 + dir) * 8 + hd]);
  const float Dsk = dir == 0 ? p.in[25][l * 8 + hd] : 0.f;
  bf16_t* yout = w.R2 + (size_t)(2 + dir) * T * 512;
  constexpr int BUF = 2 * 2048 + 256 + 256 + 64;
  const int ng = lane & 15, rs = lane >> 4, prow = wid * 4 + rs;
  f2v M0 = {0.f, 0.f}, M1 = {0.f, 0.f}, M2 = {0.f, 0.f}, M3 = {0.f, 0.f};
  struct MPre { uint4 pbq[2]; bf16_t px[3]; float pdt[3], pxm[2]; };
  MPre PA, PB;
  const bf16_t* mbc = w.W1;
  auto load = [&](int c, MPre& P) {
#pragma unroll
    for (int i = 0; i < 2; ++i) {
      int idx = tid + 256 * i, j = idx >> 5, q = idx & 31;
      int ii = pos2i(c * 16 + j, dir);
      P.pbq[i] = *(const uint4*)(mbc + ((size_t)b * TPB + ii) * 512 + (q < 16 ? 0 : 256) + gp * 128 + (q & 15) * 8);
    }
    {
      int pos = c * 16 + xj, ii = pos2i(pos, dir);
      size_t tok = (size_t)b * TPB + ii;
      const bf16_t* prw = w.pC + tok * SPC;
      bool hp = (ii != 0) && (ii != CTXL), hn = (ii != CTXL - 1) && (ii != TPB - 1);
      P.px[0] = prw[chX + (hp ? -SPC : 0)]; P.px[1] = prw[chX]; P.px[2] = prw[chX + (hn ? SPC : 0)];
      P.pxm[0] = hp ? 1.f : 0.f; P.pxm[1] = hn ? 1.f : 0.f;
      float2 dd = *(const float2*)(w.mdt + (tok * 16 + dir * 8 + hd) * 2);
      P.pdt[0] = dd.x; P.pdt[1] = dd.y; P.pdt[2] = w.mcb[tok * 2 + gp];
    }
  };
  auto stage = [&](const MPre& P, float* bufp) {
#pragma unroll
    for (int i = 0; i < 2; ++i) {
      int idx = tid + 256 * i, j = idx >> 5, q = idx & 31;
      float f[8];
      unpack8(P.pbq[i], f);
      float* d = bufp + (q < 16 ? 0 : 2048) + j * 128 + (q & 15) * 8;
      *(float4*)d = make_float4(f[0], f[1], f[2], f[3]);
      *(float4*)(d + 4) = make_float4(f[4], f[5], f[6], f[7]);
    }
    {
      float xs = siluf(wX0 * P.pxm[0] * bf2f(P.px[0]) + wX1 * bf2f(P.px[1]) + wX2 * P.pxm[1] * bf2f(P.px[2]) + bX);
      bufp[4096 + xj * 16 + xp] = xs * P.pdt[0];
      bufp[4096 + 256 + xj * 16 + xp] = Dsk * xs;
      if (xp == 0) *(float4*)(bufp + 4096 + 512 + xj * 4) = make_float4(P.pdt[1], P.pdt[2], 0.f, 0.f);
    }
  };
  float* sY = sm + 2 * BUF;
  const int ysel = (ng == 0) ? prow : (512 + tid);
  struct MStep { f4v B0, B1, C0, C1; float xq, ds; float4 sc; };
  auto lds_step = [&](const float* bf, int j) {
    MStep q;
    q.B0 = *(const f4v*)(bf + j * 128 + 8 * ng); q.B1 = *(const f4v*)(bf + j * 128 + 8 * ng + 4);
    q.C0 = *(const f4v*)(bf + 2048 + j * 128 + 8 * ng); q.C1 = *(const f4v*)(bf + 2048 + j * 128 + 8 * ng + 4);
    q.xq = bf[4096 + j * 16 + prow]; q.ds = bf[4096 + 256 + j * 16 + prow];
    q.sc = *(const float4*)(bf + 4096 + 512 + j * 4);
    return q;
  };
  auto flush = [&](int c) {
    {
      int j = tid >> 4, rr = tid & 15;
      int ii = pos2i(c * 16 + j, dir);
      yout[((size_t)b * TPB + ii) * 512 + hd * 64 + pq * 16 + rr] = f2bf(sY[(c & 1) * 256 + j * 16 + rr]);
    }
  };
  __syncthreads();
  load(0, PA);
  stage(PA, sm);
  load(1, PB);
  __syncthreads();
  const int NCH = TPB / 16;
  auto run_chunk = [&](int c, const float* bf, float* sy) {
    flush(max(c - 1, 0));
    MStep cur = lds_step(bf, 0);
#pragma unroll
    for (int j = 0; j < 16; ++j) {
      MStep nxt = cur;
      if (j + 1 < 16) nxt = lds_step(bf, j + 1);
      f2v ya = M0 * cur.C0.xy + M1 * cur.C0.zw, yb = M2 * cur.C1.xy + M3 * cur.C1.zw;
      ya += yb;
      float yp = row16_sum(ya.x + ya.y);
      float y = cur.sc.x * yp + cur.xq * cur.sc.y + cur.ds;
      const float dA = cur.sc.x, xq = cur.xq;
      M0 = M0 * dA + xq * cur.B0.xy; M1 = M1 * dA + xq * cur.B0.zw;
      M2 = M2 * dA + xq * cur.B1.xy; M3 = M3 * dA + xq * cur.B1.zw;
      sy[(ng == 0 ? j * 16 : 0) + ysel] = y;
      cur = nxt;
    }
  };
  for (int c = 0; c < NCH; c += 2) {
    load(min(c + 2, NCH - 1), PA);
    run_chunk(c, sm, sY);
    stage(PB, sm + BUF);
    __syncthreads();
    load(min(c + 3, NCH - 1), PB);
    run_chunk(c + 1, sm + BUF, sY + 256);
    stage(PA, sm);
    __syncthreads();
  }
  flush(NCH - 1);
}

DI void da_block(CP p, const Ptrs& w, int l, int b, int q0, int nkeys, int hd, bf16_t* sK, bf16_t* sV, float* smf, bf16_t* obase) {
  const int tid = TIDX, lane = tid & 63, wid = tid >> 6, r = lane & 31, h = lane >> 5;
  const int qb = wid >> 1, c = wid & 1;
  const size_t tokq = (size_t)b * TPB + q0 + qb * 32 + r;
  const bf16_t* qp = w.pD + tokq * SPD + hd * 128 + c * 64;
  bf16x8 Q0 = *(const bf16x8*)(qp + 0 * 16 + h * 8), Q1 = *(const bf16x8*)(qp + 1 * 16 + h * 8);
  bf16x8 Q2 = *(const bf16x8*)(qp + 2 * 16 + h * 8), Q3 = *(const bf16x8*)(qp + 3 * 16 + h * 8);
  const float mq = wave_max(fabsf(p.in[27][l * 64 + lane])), mk = wave_max(fabsf(p.in[28][l * 64 + lane]));
  const float Mb = 8.f * LOG2E * mq * mk + 0.5f;
  const float lam_init = 0.8f - 0.6f * __expf(-0.3f * (float)l);
  const float lam = __expf(wave_sum(p.in[29][l * 64 + lane] * p.in[30][l * 64 + lane])) - __expf(wave_sum(p.in[31][l * 64 + lane] * p.in[32][l * 64 + lane])) + lam_init;
  f32x16 O0, O1, O2, O3;
#pragma unroll
  for (int i = 0; i < 16; ++i) { O0[i] = 0.f; O1[i] = 0.f; O2[i] = 0.f; O3[i] = 0.f; }
  float ls = 0.f;
  const bf16_t* kbase = w.pD + (size_t)b * TPB * SPD + 512 + hd * 128;
  const bf16_t* vbase = w.VtD + (size_t)(b * 512 + hd * 128) * TPB;
  const int kkey = tid >> 4, kch = tid & 15, ve = tid >> 3, vch = tid & 7;
  const bf16_t* kg_ = kbase + (size_t)kkey * SPD + kch * 8;
  const bf16_t* vg_ = vbase + (size_t)ve * TPB + vch * 8;
  uint4 pk0, pk1, pk2, pk3, pv0, pv1, pv2, pv3;
#define DA_GLOAD(k0_) { const bf16_t* a_ = kg_ + (size_t)(k0_) * SPD; const bf16_t* b_ = vg_ + (k0_); \
    pk0 = *(const uint4*)(a_); pk1 = *(const uint4*)(a_ + (size_t)16 * SPD); pk2 = *(const uint4*)(a_ + (size_t)32 * SPD); pk3 = *(const uint4*)(a_ + (size_t)48 * SPD); \
    pv0 = *(const uint4*)(b_); pv1 = *(const uint4*)(b_ + (size_t)32 * TPB); pv2 = *(const uint4*)(b_ + (size_t)64 * TPB); pv3 = *(const uint4*)(b_ + (size_t)96 * TPB); }
  constexpr int DA_BUF = 64 * 136 + 128 * 72;
#define DA_STORE(bufi) { bf16_t* k_ = sK + (bufi) * DA_BUF; bf16_t* v_ = sV + (bufi) * DA_BUF; \
    *(uint4*)(k_ + (kkey) * 136 + kch * 8) = pk0; *(uint4*)(k_ + (kkey + 16) * 136 + kch * 8) = pk1; \
    *(uint4*)(k_ + (kkey + 32) * 136 + kch * 8) = pk2; *(uint4*)(k_ + (kkey + 48) * 136 + kch * 8) = pk3; \
    *(uint4*)(v_ + (ve) * 72 + vch * 8) = pv0; *(uint4*)(v_ + (ve + 32) * 72 + vch * 8) = pv1; \
    *(uint4*)(v_ + (ve + 64) * 72 + vch * 8) = pv2; *(uint4*)(v_ + (ve + 96) * 72 + vch * 8) = pv3; }
  DA_GLOAD(0)
  __syncthreads();
  DA_STORE(0)
  if (64 < nkeys) DA_GLOAD(64)
  __syncthreads();
  for (int k0 = 0; k0 < nkeys; k0 += 64) {
    const int cb_ = (k0 >> 6) & 1;
    const bf16_t* sKc = sK + cb_ * DA_BUF;
    const bf16_t* sVc = sV + cb_ * DA_BUF;
#pragma unroll
    for (int sub = 0; sub < 2; ++sub) {
      f32x16 S;
#pragma unroll
      for (int i = 0; i < 16; ++i) S[i] = -Mb;
      const bf16_t* kp = sKc + (sub * 32 + r) * 136 + c * 64 + h * 8;
      S = MFMA(*(const bf16x8*)(kp), Q0, S);
      S = MFMA(*(const bf16x8*)(kp + 16), Q1, S);
      S = MFMA(*(const bf16x8*)(kp + 32), Q2, S);
      S = MFMA(*(const bf16x8*)(kp + 48), Q3, S);
#pragma unroll
      for (int i = 0; i < 16; ++i) { S[i] = __builtin_amdgcn_exp2f(S[i]); ls += S[i]; }
      bf16x8 P0, P1;
      P0 = pack8_mfma(S[0], S[1], S[2], S[3], S[4], S[5], S[6], S[7]);
      P1 = pack8_mfma(S[8], S[9], S[10], S[11], S[12], S[13], S[14], S[15]);
#define DA_PV(OX, et)                                                                                   \
      {                                                                                                 \
        const bf16_t* vp = sVc + ((et) * 32 + r) * 72 + sub * 32 + 4 * h;                               \
        s16x4 lo = *(const s16x4*)vp, hi = *(const s16x4*)(vp + 8);                                     \
        s16x4 lo2 = *(const s16x4*)(vp + 16), hi2 = *(const s16x4*)(vp + 24);                           \
        OX = MFMA(__builtin_shufflevector(lo, hi, 0, 1, 2, 3, 4, 5, 6, 7), P0, OX);                     \
        OX = MFMA(__builtin_shufflevector(lo2, hi2, 0, 1, 2, 3, 4, 5, 6, 7), P1, OX);                   \
      }
      DA_PV(O0, 0) DA_PV(O1, 1) DA_PV(O2, 2) DA_PV(O3, 3)
#undef DA_PV
    }
    if (k0 + 64 < nkeys) {
      DA_STORE(cb_ ^ 1)
      if (k0 + 128 < nkeys) DA_GLOAD(k0 + 128)
    }
    __syncthreads();
  }
#undef DA_STORE
  ls += __shfl_xor(ls, 32);
  const float scl = c == 0 ? 1.f / ls : lam / ls;
#pragma unroll
  for (int i = 0; i < 16; ++i) { O0[i] *= scl; O1[i] *= scl; O2[i] *= scl; O3[i] *= scl; }
  __syncthreads();
  float* xb = smf + qb * 4096;
  if (c == 1) {
#pragma unroll
    for (int i = 0; i < 16; ++i) {
      int e = crow(i, h);
      xb[(e) * 32 + r] = O0[i]; xb[(32 + e) * 32 + r] = O1[i]; xb[(64 + e) * 32 + r] = O2[i]; xb[(96 + e) * 32 + r] = O3[i];
    }
  }
  __syncthreads();
  if (c == 0) {
    float ss = 0.f;
#pragma unroll
    for (int i = 0; i < 16; ++i) {
      int e = crow(i, h);
      O0[i] -= xb[(e) * 32 + r]; O1[i] -= xb[(32 + e) * 32 + r]; O2[i] -= xb[(64 + e) * 32 + r]; O3[i] -= xb[(96 + e) * 32 + r];
      ss += O0[i] * O0[i] + O1[i] * O1[i] + O2[i] * O2[i] + O3[i] * O3[i];
    }
    ss += __shfl_xor(ss, 32);
    const float inv = rsqrtf(ss * (1.f / 128.f) + 1e-6f) * (1.f - lam_init);
    const float* sub_w = p.in[33] + l * 128;
    const bf16_t* gp_ = w.pD + tokq * SPD + 1024 + hd * 128;
    bf16_t* op = obase + tokq * SPD + hd * 128;
#define DA_ST(OX, et)                                                                                   \
    _Pragma("unroll") for (int g = 0; g < 4; ++g) {                                                     \
      int e0 = (et) * 32 + 8 * g + 4 * h;                                                               \
      uint2 gg = *(const uint2*)(gp_ + e0);                                                             \
      float4 sw = *(const float4*)(sub_w + e0);                                                         \
      float g0 = bf2f((bf16_t)(gg.x & 0xffff)), g1 = bf2f((bf16_t)(gg.x >> 16)), g2 = bf2f((bf16_t)(gg.y & 0xffff)), g3 = bf2f((bf16_t)(gg.y >> 16)); \
      float o0 = OX[4 * g] * inv * sw.x * siluf(g0), o1 = OX[4 * g + 1] * inv * sw.y * siluf(g1);       \
      float o2 = OX[4 * g + 2] * inv * sw.z * siluf(g2), o3 = OX[4 * g + 3] * inv * sw.w * siluf(g3);   \
      *(uint2*)(op + e0) = make_uint2(pack2(o0, o1), pack2(o2, o3));                                    \
    }
    DA_ST(O0, 0) DA_ST(O1, 1) DA_ST(O2, 2) DA_ST(O3, 3)
#undef DA_ST
  }
}

DI void na_wave(CP p, const Ptrs& w, int l, int witem, bool ctxq, bf16_t* obase) {
  const int lane = TIDX & 63, r = lane & 31, h = lane >> 5;
  int b, hd, qi, gr0 = 0, cq = 0, qrow = 0, qcol = 0;
  if (!ctxq) {
    hd = witem & 7; cq = (witem >> 3) & 3; gr0 = ((witem >> 5) & 63) * 2; b = witem >> 11;
    qrow = gr0 + (r >> 4); qcol = cq * 16 + (r & 15); qi = CTXL + qrow * 64 + qcol;
  } else { hd = witem & 7; int qt = (witem >> 3) & 7; b = witem >> 6; qi = qt * 32 + r; }
  const size_t tokq = (size_t)b * TPB + qi;
  const bf16_t* qp = w.pA + tokq * SPA + hd * 64;
  bf16x8 Q[4];
#pragma unroll
  for (int s = 0; s < 4; ++s) Q[s] = *(const bf16x8*)(qp + s * 16 + h * 8);
  const float mq = wave_max(fabsf(p.in[8][l * 64 + lane])), mk = wave_max(fabsf(p.in[9][l * 64 + lane]));
  const float* rpb = p.in[10] + (size_t)(l * 8 + hd) * 15 * 31;
  float mb = 0.f;
  for (int e = lane; e < 465; e += 64) mb = fmaxf(mb, fabsf(rpb[e]));
  mb = wave_max(mb);
  const float Mb = 8.f * LOG2E * mq * mk + mb * LOG2E + 0.5f;
  f32x16 O[2];
#pragma unroll
  for (int e = 0; e < 2; ++e)
#pragma unroll
    for (int i = 0; i < 16; ++i) O[e][i] = 0.f;
  float ls = 0.f;
  const bf16_t* kbase = w.pA + (size_t)b * TPB * SPA + 512 + hd * 64;
  const bf16_t* vbase = w.VtA + (size_t)(b * 512 + hd * 64) * TPB;
  const int r0q = min(max(qrow - 4, 0), 120);
  const int c0 = min(max(qcol - 8, 0), 48);
  const int kr_lo = min(max(gr0 - 4, 0), 120), kr_hi = min(max(gr0 - 3, 0), 120) + 8;
  const int kc0 = min(max(cq * 16 - 8, 0), 32);
  const int ntile = ctxq ? 8 : 8 + (kr_hi - kr_lo);
  auto kidx = [&](int t) { return t < 8 ? t * 32 : CTXL + (kr_lo + (t - 8)) * 64 + kc0; };
  bf16x8 nK0, nK1, nK2, nK3;
  s16x4 nV[8];
#define NA_LOAD(t_) { const int ki_ = kidx(t_); const bf16_t* kp_ = kbase + (size_t)(ki_ + r) * SPA + h * 8; \
    nK0 = *(const bf16x8*)(kp_); nK1 = *(const bf16x8*)(kp_ + 16); nK2 = *(const bf16x8*)(kp_ + 32); nK3 = *(const bf16x8*)(kp_ + 48); \
    _Pragma("unroll") for (int et = 0; et < 2; ++et) _Pragma("unroll") for (int s2 = 0; s2 < 2; ++s2) { \
      const bf16_t* vp_ = vbase + (size_t)(et * 32 + r) * TPB + ki_ + s2 * 16 + 4 * h; \
      nV[(et * 2 + s2) * 2] = *(const s16x4*)vp_; nV[(et * 2 + s2) * 2 + 1] = *(const s16x4*)(vp_ + 8); } }
  NA_LOAD(0)
  for (int t = 0; t < ntile; ++t) {
    bool local = t >= 8;
    const int kr = kr_lo + (t - 8);
    bf16x8 cK0 = nK0, cK1 = nK1, cK2 = nK2, cK3 = nK3;
    s16x4 cV[8];
#pragma unroll
    for (int i = 0; i < 8; ++i) cV[i] = nV[i];
    if (t + 1 < ntile) NA_LOAD(t + 1)
    f32x16 S;
#pragma unroll
    for (int i = 0; i < 16; ++i) S[i] = -Mb;
    S = MFMA(cK0, Q[0], S); S = MFMA(cK1, Q[1], S); S = MFMA(cK2, Q[2], S); S = MFMA(cK3, Q[3], S);
    if (local) {
      const bool row_ok = (kr >= r0q) && (kr < r0q + 8);
      const float* rp = rpb + min(max(kr - qrow + 7, 0), 14) * 31;
#pragma unroll
      for (int i = 0; i < 16; ++i) {
        int kcol = kc0 + crow(i, h);
        bool ok = row_ok && (kcol >= c0) && (kcol < c0 + 16);
        int dc = min(max(kcol - qcol + 15, 0), 30);
        float bias = rp[dc] * LOG2E;
        S[i] = ok ? __builtin_amdgcn_exp2f(S[i] + bias) : 0.f;
      }
    } else {
#pragma unroll
      for (int i = 0; i < 16; ++i) S[i] = __builtin_amdgcn_exp2f(S[i]);
    }
    bf16x8 P[2];
#pragma unroll
    for (int i = 0; i < 16; ++i) ls += S[i];
#pragma unroll
    for (int s2 = 0; s2 < 2; ++s2) {
      P[s2] = pack8_mfma(S[8 * s2 + 0], S[8 * s2 + 1], S[8 * s2 + 2], S[8 * s2 + 3], S[8 * s2 + 4], S[8 * s2 + 5], S[8 * s2 + 6], S[8 * s2 + 7]);
    }
#pragma unroll
    for (int et = 0; et < 2; ++et)
#pragma unroll
      for (int s2 = 0; s2 < 2; ++s2) {
        bf16x8 vf = __builtin_shufflevector(cV[(et * 2 + s2) * 2], cV[(et * 2 + s2) * 2 + 1], 0, 1, 2, 3, 4, 5, 6, 7);
        O[et] = MFMA(vf, P[s2], O[et]);
      }
  }
#undef NA_LOAD
  ls += __shfl_xor(ls, 32);
  const float inv = 1.f / ls;
  const bf16_t* gp_ = w.pA + tokq * SPA + 1024 + hd * 64;
  bf16_t* op = obase + tokq * SPA + hd * 64;
#pragma unroll
  for (int et = 0; et < 2; ++et)
#pragma unroll
    for (int g = 0; g < 4; ++g) {
      int e0 = et * 32 + 8 * g + 4 * h;
      uint2 gg = *(const uint2*)(gp_ + e0);
      float g0 = bf2f((bf16_t)(gg.x & 0xffff)), g1 = bf2f((bf16_t)(gg.x >> 16)), g2 = bf2f((bf16_t)(gg.y & 0xffff)), g3 = bf2f((bf16_t)(gg.y >> 16));
      float o0 = O[et][4 * g] * inv * siluf(g0), o1 = O[et][4 * g + 1] * inv * siluf(g1);
      float o2 = O[et][4 * g + 2] * inv * siluf(g2), o3 = O[et][4 * g + 3] * inv * siluf(g3);
      *(uint2*)(op + e0) = make_uint2(pack2(o0, o1), pack2(o2, o3));
    }
}

template <int MM, int DUMMY = 0>
DI void phase_mixers(CP p, const Ptrs& w, int l, float* sm) {
  __shared__ int s_item;
  const bool ctxo = (l == 0);
  const int n_scan = (MM & 1) ? 256 : 0, n_da = (MM & 2) ? 1024 : 0, n_dac = ((MM & 2) && ctxo) ? 32 : 0;
  const int n_na = (MM & 4) ? 1024 : 0, n_nac = ((MM & 4) && ctxo) ? 32 : 0;
  const int total = n_scan + n_da + n_dac + n_na + n_nac;
  int* ctr = &w.ctr[l * 16 + MM + ((MM != 1) ? DUMMY * 8 : 0)];
  bf16_t* oD = DUMMY ? w.R1 : w.pD; bf16_t* oA = DUMMY ? w.R1 : w.pA;
  if constexpr (MM == 1 && DUMMY == 1) {
    __syncthreads();
    if (TIDX == 0) {
      unsigned hw = (unsigned)__builtin_amdgcn_s_getreg((31 << 11) | 4);
      unsigned key = ((hw >> 8) & 0xffu) | (xb_xcc_id() << 8);
      s_item = atomicAdd(&w.cuf[l * 4096 + key], 1);
    }
    __syncthreads();
    int first = s_item;
    if (first != 0) return;
  }
  for (;;) {
    __syncthreads();
    if (TIDX == 0) s_item = atomicAdd(ctr, 1);
    __syncthreads();
    int it = s_item;
    if (it >= total) break;
    if constexpr ((MM & 1) != 0) {
      if (it < 128) { __builtin_amdgcn_s_setprio(3); rwkv_scan(p, w, l, it, sm); __builtin_amdgcn_s_setprio(0); if (DUMMY) break; continue; }
      if (it < 256) { __builtin_amdgcn_s_setprio(3); mamba_scan(p, w, l, it - 128, sm); __builtin_amdgcn_s_setprio(0); if (DUMMY) break; continue; }
      it -= 256;
    }
    if constexpr ((MM & 2) != 0) {
      if (it < n_da) { int hd = it & 3, qt = (it >> 2) & 127, b = it >> 9; da_block(p, w, l, b, CTXL + qt * 64, TPB, hd, (bf16_t*)sm, (bf16_t*)sm + 64 * 136, sm, oD); continue; }
      it -= n_da;
      if (it < n_dac) { int hd = it & 3, qt = (it >> 2) & 3, b = it >> 4; da_block(p, w, l, b, qt * 64, CTXL, hd, (bf16_t*)sm, (bf16_t*)sm + 64 * 136, sm, oD); continue; }
      it -= n_dac;
    }
    if constexpr ((MM & 4) != 0) {
      if (it < n_na) { na_wave(p, w, l, it * 4 + (TIDX >> 6), false, oA); continue; }
      it -= n_na;
      na_wave(p, w, l, it * 4 + (TIDX >> 6), true, oA);
    }
  }
}

DI void phase_finish(CP p, const Ptrs& w, int l) {
  const int lane = TIDX & 63, gw = BIDX * 4 + (TIDX >> 6), nw = GDIM * 4;
  const int c0 = lane * 8, hd = lane >> 3;
  float lnw[8], lnb[8], muv[8], nrm[8];
#pragma unroll
  for (int j = 0; j < 8; ++j) { lnw[j] = p.in[19][l * 512 + c0 + j]; lnb[j] = p.in[20][l * 512 + c0 + j]; muv[j] = p.in[11][l * 1792 + 1024 + c0 + j]; nrm[j] = p.in[26][l * 512 + c0 + j]; }
  const bf16_t* yB0 = w.R2, *yB1 = w.R2 + (size_t)T * 512, *yM0 = w.R2 + (size_t)2 * T * 512, *yM1 = w.R2 + (size_t)3 * T * 512;
  for (int tok = gw; tok < T; tok += nw) {
    int b = tok / TPB, i = tok - b * TPB;
    if (l != 0 && i < CTXL) continue;
    bool hp = (i != 0) && (i != CTXL), hn = (i != CTXL - 1) && (i != TPB - 1);
    bf16_t* rb = w.pB + (size_t)tok * SPB;
    bf16_t* rc = w.pC + (size_t)tok * SPC + 1040;
    uint4 u0 = *(const uint4*)(yB0 + (size_t)tok * 512 + c0), u1 = *(const uint4*)(yB1 + (size_t)tok * 512 + c0);
    uint4 uv = *(const uint4*)(rb + 1024 + c0), up = make_uint4(0, 0, 0, 0), un = make_uint4(0, 0, 0, 0);
    if (hp) up = *(const uint4*)(rb + 1024 + c0 - SPB);
    if (hn) un = *(const uint4*)(rb + 1024 + c0 + SPB);
    uint4 ug = *(const uint4*)(rb + 1792 + c0);
    const float* bsc = w.bonus + ((size_t)tok * 8 + hd) * 8;
    float2 bon2 = make_float2(bsc[3], bsc[6]);
    uint4 m0 = *(const uint4*)(yM0 + (size_t)tok * 512 + c0), m1 = *(const uint4*)(yM1 + (size_t)tok * 512 + c0);
    uint4 uz = *(const uint4*)(rc + c0);
    float y[8], t[8], vv[8], vp[8], vn[8], g[8];
    unpack8(u0, y); unpack8(u1, t);
    float sm_ = 0.f;
#pragma unroll
    for (int j = 0; j < 8; ++j) { y[j] += t[j]; sm_ += y[j]; }
    float mean = row8_sum(sm_) * (1.f / 64.f);
    float vs = 0.f;
#pragma unroll
    for (int j = 0; j < 8; ++j) { y[j] -= mean; vs += y[j] * y[j]; }
    float rstd = rsqrtf(row8_sum(vs) * (1.f / 64.f) + 64e-5f);
    unpack8(uv, vv); unpack8(up, vp); unpack8(un, vn); unpack8(ug, g);
    float bon = bon2.x + bon2.y;
#pragma unroll
    for (int j = 0; j < 8; ++j) {
      float yn = y[j] * rstd * lnw[j] + lnb[j];
      float v_s = vv[j] + (0.5f * (vp[j] + vn[j]) - vv[j]) * muv[j];
      t[j] = (yn + bon * v_s) * siluf(g[j]);
    }
    *(uint4*)(rb + 1792 + c0) = pack8(t);
    unpack8(m0, y); unpack8(m1, t); unpack8(uz, g);
    float ss = 0.f;
#pragma unroll
    for (int j = 0; j < 8; ++j) { y[j] = (y[j] + t[j]) * siluf(g[j]); ss += y[j] * y[j]; }
    ss = row16_sum(ss); ss += __shfl_xor(ss, 16);
    float inv = rsqrtf(ss * (1.f / 256.f) + 1e-6f);
#pragma unroll
    for (int j = 0; j < 8; ++j) t[j] = y[j] * inv * nrm[j];
    *(uint4*)(rc + c0) = pack8(t);
  }
}

DI void phase_merge(CP p, const Ptrs& w, int l, bf16_t* sA, bf16_t* sB, unsigned* sU) {
  const int tid = TIDX, lane = tid & 63, wid = tid >> 6, wm = wid >> 1, wn = wid & 1, r = lane & 31, h = lane >> 5;
  const bf16_t* gate_t = (const bf16_t*)((const char*)w.R1 + R1_GATE);
  const bf16_t* up_t = (const bf16_t*)((const char*)w.R1 + R1_UP);
  const int nmt = l == 0 ? 132 : 128;
  const int nrounds = tile_rounds(nmt, 16);
  for (int kk = 0; kk < nrounds; ++kk) {
    int mt, nt;
    if (!tile_map(kk, nmt, 16, mt, nt)) continue;
    if (l != 0) mt += mt < 64 ? 2 : 4;
    int m0 = mt * 128, n0 = nt * 128;
    f32x16 tot[2][2];
    zero_acc(tot);
#pragma unroll 1
    for (int br = 0; br < 4; ++br) {
      const bf16_t* ys; int lds_;
      if (br == 0) { ys = w.pA; lds_ = SPA; } else if (br == 1) { ys = w.pB + 1792; lds_ = SPB; } else if (br == 2) { ys = w.pC + 1040; lds_ = SPC; } else { ys = w.pD; lds_ = SPD; }
      {
        f32x16 U[2][2];
        zero_acc(U);
        gemm_128(ys + (size_t)m0 * lds_, lds_, up_t + (size_t)(br * 2048 + n0) * 512, 512, 512, U, sA, sB);
#pragma unroll
        for (int a = 0; a < 2; ++a)
#pragma unroll
          for (int c = 0; c < 2; ++c)
#pragma unroll
            for (int i = 0; i < 8; ++i) sU[((a * 2 + c) * 8 + i) * 256 + tid] = pack2(U[a][c][2 * i], U[a][c][2 * i + 1]);
      }
      f32x16 G[2][2];
      zero_acc(G);
      gemm_128(w.H + (size_t)m0 * 2048, 2048, gate_t + (size_t)(br * 2048 + n0) * 2048, 2048, 2048, G, sA, sB);
#pragma unroll
      for (int a = 0; a < 2; ++a)
#pragma unroll
        for (int c = 0; c < 2; ++c)
#pragma unroll
          for (int i = 0; i < 8; ++i) {
            unsigned uv = sU[((a * 2 + c) * 8 + i) * 256 + tid];
            float u0 = __uint_as_float(uv << 16), u1 = __uint_as_float(uv & 0xffff0000u);
            tot[a][c][2 * i] += sigmf(G[a][c][2 * i]) * u0;
            tot[a][c][2 * i + 1] += sigmf(G[a][c][2 * i + 1]) * u1;
          }
    }
    bf16_t* dst = w.R2;
#pragma unroll
    for (int mi = 0; mi < 2; ++mi)
#pragma unroll
      for (int ni = 0; ni < 2; ++ni)
#pragma unroll
        for (int i = 0; i < 16; ++i) {
          int row = m0 + wm * 64 + mi * 32 + crow(i, h), col = n0 + wn * 64 + ni * 32 + r;
          dst[(size_t)row * 2048 + col] = f2bf(tot[mi][ni][i]);
        }
  }
}

DI void phase_out(CP p, const Ptrs& w, int l, bf16_t* sA, bf16_t* sB) {
  const int tid = TIDX, lane = tid & 63, wid = tid >> 6, wm = wid >> 1, wn = wid & 1, r = lane & 31, h = lane >> 5;
  const bf16_t* out_t = (const bf16_t*)((const char*)w.R1 + R1_OUT);
  const int nmt = l == 0 ? 132 : 128;
  const int nrounds = tile_rounds(nmt, 16);
  for (int kk = 0; kk < nrounds; ++kk) {
    int mt, nt;
    if (!tile_map(kk, nmt, 16, mt, nt)) continue;
    if (l != 0) mt += mt < 64 ? 2 : 4;
    int m0 = mt * 128, n0 = nt * 128;
    int b = m0 / TPB, ib = m0 - b * TPB;
    bool isctx = ib < CTXL;
    f32x16 acc[2][2];
    zero_acc(acc);
    gemm_128_deep(w.R2 + (size_t)m0 * 2048, 2048, out_t + (size_t)n0 * 2048, 2048, 2048, acc, sA, sB);
    const float* gate = w.mod + (l * 3 + (isctx ? 2 : b)) * 6144 + 4096;
#pragma unroll
    for (int mi = 0; mi < 2; ++mi)
#pragma unroll
      for (int ni = 0; ni < 2; ++ni) {
        int col = n0 + wn * 64 + ni * 32 + r;
        float gt = gate[col];
#pragma unroll
        for (int i = 0; i < 16; ++i) {
          int ii = ib + wm * 64 + mi * 32 + crow(i, h);
          const float* src = xrow(p, w, l, b * TPB + ii);
          float* dstp = isctx ? w.xc1 + (size_t)(b * CTXL + ii) * DM : p.out + (size_t)(b * 8192 + ii - CTXL) * DM;
          dstp[col] = src[col] + gt * acc[mi][ni][i];
        }
      }
  }
}

constexpr int SMEM_BYTES = 4 * 128 * 72 * 2;
constexpr int NPH = 18;
#ifndef ONE_LAUNCH
#define ONE_LAUNCH 1
#endif
#ifndef PHMASK
#define PHMASK 0x1ff
#endif

template <int SP>
DI void run_phase(int l, char* smem_raw) {
  CP p = launder_params();
  const Ptrs w = mkptrs(p.ws);
  float* smf = (float*)smem_raw;
  bf16_t* sA = (bf16_t*)smem_raw;
  bf16_t* sB = sA + 128 * 72;
  if constexpr (SP == 0) {
    if (l == 0) {
      if (BIDX == 0 && TIDX < 64) w.ctr[TIDX] = 0;
      if (BIDX >= 2 && BIDX < 34) w.cuf[(BIDX - 2) * 256 + TIDX] = 0;
      if (BIDX == 1) for (int e = TIDX; e < 2048; e += 256) { float ang = (float)(e >> 4) * exp2f(-(float)(e & 15) * (13.287712379549449f / 16.f)); w.rope[2 * e] = cosf(ang); w.rope[2 * e + 1] = sinf(ang); }
      for (int it = BIDX; it < 384; it += GDIM) phase_ada_item(p, w, 0, it, 4, smf);
      conv_w1(p, w, 0, smf);
    }
    conv_w3(p, w, l, smf);
  } else if constexpr (SP == 1) phase_norm(p, w, l);
  else if constexpr (SP == 2) phase_inproj(p, w, l, sA, sB);
  else if constexpr (SP == 3) {
    phase_prep(p, w, l);
  } else if constexpr (SP == 4) phase_lora(p, w, l, sA, sB);
  else if constexpr (SP == 5) phase_mixers<1>(p, w, l, smf);
  else if constexpr (SP == 9) phase_mixers<2>(p, w, l, smf);
  else if constexpr (SP == 10) phase_mixers<4>(p, w, l, smf);
  else if constexpr (SP == 13) phase_rwscal(p, w, l);
  else if constexpr (SP == 14) phase_mixers<1, 1>(p, w, l, smf);
  else if constexpr (SP == 11) phase_mixers<2, 1>(p, w, l, smf);
  else if constexpr (SP == 12) phase_mixers<4, 1>(p, w, l, smf);
  else if constexpr (SP == 6) {
    conv_w2(p, w, l, smf);
    if (l + 1 < 2) conv_w1(p, w, l + 1, smf);
    phase_finish(p, w, l);
  } else if constexpr (SP == 7) phase_merge(p, w, l, sA, sB, (unsigned*)(smem_raw + 2 * 128 * 72 * 2));
  else phase_out(p, w, l, sA, sB);
}

template <int SP>
__global__ void __launch_bounds__(256, 2) phase_kernel(Params p, int l) {
  __shared__ __attribute__((aligned(16))) char smem_raw[SMEM_BYTES];
  run_phase<SP>(l, smem_raw);
}

template <int SP>
__device__ __attribute__((noinline)) void run_phase_ni(int l, char* smem_raw) {
  run_phase<SP>(l, smem_raw);
}
#ifndef CMASK
#define CMASK 0x7fff
#endif
#ifndef DUPMASK
#define DUPMASK 0
#endif
#define RUNP(k) if ((CMASK & (1 << k)) && (pmask & (1 << k))) { run_phase<k>(RP_ARGS); if ((DUPMASK & (1 << k)) && (k != 8 || l == 0)) { xcd_barrier(xb); run_phase<k>(RP_ARGS); } }
#ifdef NOINL
#define run_phase run_phase_ni
#define RP_ARGS l, smem_raw
#else
#define RP_ARGS l, smem_raw
#endif
__global__ void __launch_bounds__(256, 2) fwd_kernel(Params p) {
  __shared__ __attribute__((aligned(16))) char smem_raw[SMEM_BYTES];
#if ONE_LAUNCH
  __shared__ uint4 xb_words;
  if (threadIdx.x == 0) xb_words = make_uint4(0u, 0u, 0u, 0u);
  __syncthreads();
  XcdBarrier xb = xcd_barrier_post((unsigned*)(launder_params().ws + OFF_BAR), (volatile LAS unsigned*)&xb_words);
  const int lmask = launder_params().ph_lo, pmask = launder_params().ph_hi;
#ifdef PROBE_SYNC
  for (int q = 0; q < 50; ++q) xcd_barrier(xb);
#endif
  for (int l = 0; l < 2; ++l) {
    if (!((lmask >> l) & 1)) continue;
    RUNP(0); xcd_barrier(xb);
    if (lmask == 0x7fffffff) cg::this_grid().sync();
    RUNP(1); xcd_barrier(xb);
    RUNP(2); xcd_barrier(xb);
    RUNP(3); xcd_barrier(xb);
    RUNP(4); xcd_barrier(xb);
    RUNP(13); xcd_barrier(xb);
#ifndef SEQMIX
#define SEQMIX 0
#endif
    RUNP(14); if (SEQMIX) xcd_barrier(xb);
#ifdef PROBE_DA
    RUNP(11); xcd_barrier(xb);
#endif
#ifdef PROBE_NA
    RUNP(12); xcd_barrier(xb);
#endif
    RUNP(9); if (SEQMIX) xcd_barrier(xb); RUNP(10); RUNP(5); xcd_barrier(xb);
    RUNP(6); xcd_barrier(xb);
    RUNP(7); xcd_barrier(xb);
    RUNP(8); xcd_barrier(xb);
  }
#endif
}


extern "C" void kernel_launch(void* const* d_in, const int* in_sizes, int n_in, void* d_out, int out_size, void* d_ws, size_t ws_size, hipStream_t stream) {
  static int grid_blocks = 0;
  if (!grid_blocks) {
    int dev = 0, cus = 0, per_cu = 0;
    (void)hipGetDevice(&dev);
    (void)hipDeviceGetAttribute(&cus, hipDeviceAttributeMultiprocessorCount, dev);
    (void)hipOccupancyMaxActiveBlocksPerMultiprocessor(&per_cu, fwd_kernel, 256, 0);
    if (per_cu > 2) per_cu = 2;
    if (per_cu < 1) per_cu = 1;
    grid_blocks = cus * per_cu;
  }
  if (n_in < 37 || ws_size < WS_NEED) { fprintf(stderr, "bad args: n_in=%d ws=%zu need=%zu\n", n_in, ws_size, (size_t)WS_NEED); return; }
  Params p;
  memset(&p, 0, sizeof(p));
  for (int i = 0; i < 37; ++i) p.in[i] = (const float*)d_in[i];
  p.out = (float*)d_out;
  p.ws = (char*)d_ws;
#if ONE_LAUNCH
  p.ph_lo = 3; p.ph_hi = 0x7fff;
  (void)hipMemsetAsync((char*)d_ws + OFF_BAR, 0, XCD_BAR_WORDS * 4, stream);
  (void)hipMemsetAsync((char*)d_ws + OFF_MOD, 0, 3 * 6144 * 4, stream);
  void* args[] = {&p};
  hipError_t e = hipLaunchCooperativeKernel((void*)fwd_kernel, dim3(grid_blocks), dim3(256), args, 0, stream);
  if (e != hipSuccess) fprintf(stderr, "cooperative launch failed: %s (grid %d)\n", hipGetErrorString(e), grid_blocks);
#ifdef PROBE_EXTRA
  {
    (void)hipMemsetAsync((char*)d_ws + OFF_BAR, 0, XCD_BAR_WORDS * 4, stream);
    Params p2 = p; p2.ph_lo = 1; p2.ph_hi = PROBE_EXTRA;
    void* args2[] = {&p2};
    (void)hipLaunchCooperativeKernel((void*)fwd_kernel, dim3(grid_blocks), dim3(256), args2, 0, stream);
  }
#endif
#else
  for (int l = 0; l < 2; ++l) {
    hipLaunchKernelGGL(phase_kernel<0>, dim3(grid_blocks), dim3(256), 0, stream, p, l);
    hipLaunchKernelGGL(phase_kernel<1>, dim3(grid_blocks), dim3(256), 0, stream, p, l);
    hipLaunchKernelGGL(phase_kernel<2>, dim3(grid_blocks), dim3(256), 0, stream, p, l);
    hipLaunchKernelGGL(phase_kernel<3>, dim3(grid_blocks), dim3(256), 0, stream, p, l);
    hipLaunchKernelGGL(phase_kernel<4>, dim3(grid_blocks), dim3(256), 0, stream, p, l);
    hipLaunchKernelGGL(phase_kernel<5>, dim3(grid_blocks), dim3(256), 0, stream, p, l);
    hipLaunchKernelGGL(phase_kernel<9>, dim3(grid_blocks), dim3(256), 0, stream, p, l);
    hipLaunchKernelGGL(phase_kernel<10>, dim3(grid_blocks), dim3(256), 0, stream, p, l);
    hipLaunchKernelGGL(phase_kernel<6>, dim3(grid_blocks), dim3(256), 0, stream, p, l);
    hipLaunchKernelGGL(phase_kernel<7>, dim3(grid_blocks), dim3(256), 0, stream, p, l);
    hipLaunchKernelGGL(phase_kernel<8>, dim3(grid_blocks), dim3(256), 0, stream, p, l);
  }
#endif
}
```

```cpp
#include <hip/hip_runtime.h>
#include <hip/hip_cooperative_groups.h>
#include <stdint.h>
#include <cstdio>
#include <cstring>
namespace cg = cooperative_groups;

typedef unsigned short bf16_t;
typedef __attribute__((ext_vector_type(8))) short bf16x8;
typedef __attribute__((ext_vector_type(4))) short s16x4;
typedef __attribute__((ext_vector_type(16))) float f32x16;
typedef __attribute__((ext_vector_type(2))) float f2v;
typedef __attribute__((ext_vector_type(4))) float f4v;
#define DI __device__ __forceinline__
#define MFMA(a, b, c) __builtin_amdgcn_mfma_f32_32x32x16_bf16((a), (b), (c), 0, 0, 0)

constexpr int DM = 2048, TPB = 8448, T = 16896, CTXL = 256;
constexpr int SPA = 1536, SPB = 2304, SPC = 1664, SPD = 1536;
constexpr int NPAD = 8064;
constexpr float LOG2E = 1.4426950408889634f;
constexpr float QS = 0.125f * LOG2E;

constexpr size_t al256(size_t x) { return (x + 255) & ~(size_t)255; }
constexpr size_t OFF_MOD = 0;
constexpr size_t OFF_CTR = al256(OFF_MOD + 2 * 3 * 6144 * 4);
constexpr size_t OFF_BAR = al256(OFF_CTR + 256);
constexpr size_t OFF_CUF = al256(OFF_BAR + 3456 * 4);
constexpr size_t OFF_ROPE = al256(OFF_CUF + 2 * 4096 * 4);
constexpr size_t OFF_BONUS = al256(OFF_ROPE + 128 * 16 * 8);
constexpr size_t OFF_MDT = al256(OFF_BONUS + (size_t)T * 64 * 4);
constexpr size_t OFF_MCB = al256(OFF_MDT + (size_t)T * 32 * 4);
constexpr size_t OFF_W3 = al256(OFF_MCB + (size_t)T * 2 * 4);
constexpr size_t OFF_LA = al256(OFF_W3 + 4 * 512 * 64 * 2);
constexpr size_t OFF_XC1 = al256(OFF_LA + (size_t)T * 256 * 2);
constexpr size_t OFF_W1 = al256(OFF_XC1 + (size_t)2 * 256 * 2048 * 4);
constexpr size_t OFF_H = al256(OFF_W1 + (size_t)NPAD * 2048 * 2);
constexpr size_t OFF_PA = al256(OFF_H + (size_t)T * 2048 * 2);
constexpr size_t OFF_PB = al256(OFF_PA + (size_t)T * SPA * 2);
constexpr size_t OFF_PC = al256(OFF_PB + (size_t)T * SPB * 2);
constexpr size_t OFF_PD = al256(OFF_PC + (size_t)T * SPC * 2);
constexpr size_t OFF_VTA = al256(OFF_PD + (size_t)T * SPD * 2);
constexpr size_t OFF_VTD = al256(OFF_VTA + (size_t)2 * 512 * TPB * 2);
constexpr size_t OFF_R1 = al256(OFF_VTD + (size_t)2 * 512 * TPB * 2);
constexpr size_t OFF_R2 = al256(OFF_R1 + (size_t)4 * T * 512 * 2);
constexpr size_t WS_NEED = al256(OFF_R2 + (size_t)4 * T * 512 * 2);
constexpr size_t R1_GATE = 0, R1_UP = (size_t)4 * 2048 * 2048 * 2, R1_OUT = R1_UP + (size_t)4 * 2048 * 512 * 2;

struct Params {
  const float* in[37];
  float* out;
  char* ws;
  int ph_lo, ph_hi;
};


typedef const __attribute__((address_space(4))) Params& CP;
DI int ltid() { int t = threadIdx.x; asm volatile("" : "+v"(t)); return t; }
DI int lbid() { int t = blockIdx.x; asm volatile("" : "+s"(t)); return t; }
DI int lgdim() { int t = gridDim.x; asm volatile("" : "+s"(t)); return t; }
#define TIDX ltid()
#define BIDX lbid()
#define GDIM lgdim()
DI CP launder_params() {
  auto kp = __builtin_amdgcn_kernarg_segment_ptr();
  asm volatile("" : "+s"(kp));
  return *(const __attribute__((address_space(4))) Params*)kp;
}


#define XB_TMO      128
#define XB_XCNT(j)  (256  + 64 * (j))
#define XB_XSUB(j)  (1280 + 64 * (j))
#define XB_XGEN(j)  (2304 + 64 * (j))
#define XB_TOP      3328
#define XB_TOPGEN   3392
#define XCD_BAR_WORDS 3456
#define XB_SPIN_CAP (1u << 22)
#define LAS __attribute__((address_space(3)))
DI unsigned xb_ld(unsigned* p) { return __hip_atomic_load(p, __ATOMIC_RELAXED, __HIP_MEMORY_SCOPE_AGENT); }
DI unsigned xb_add(unsigned* p, unsigned v) { return __hip_atomic_fetch_add(p, v, __ATOMIC_RELAXED, __HIP_MEMORY_SCOPE_AGENT); }
DI unsigned xb_xcc_id() { return (unsigned)__builtin_amdgcn_s_getreg((3 << 11) | 20) & 0xFu; }
#define XB_SPIN(cond, bar) do { unsigned _sp = 0; while (cond) { __builtin_amdgcn_s_sleep(1); \
    if ((++_sp & 255u) == 0u) { if (xb_ld(&(bar)[XB_TMO])) break; if (_sp > XB_SPIN_CAP) { atomicAdd(&(bar)[XB_TMO], 1u); break; } } } } while (0)
struct XcdBarrier { unsigned* bar; unsigned x; volatile LAS unsigned* st; };
DI XcdBarrier xcd_barrier_post(unsigned* bar, volatile LAS unsigned* st) {
  XcdBarrier b; b.bar = bar; b.x = xb_xcc_id(); b.st = st;
  if (threadIdx.x == 0) (void)xb_add(&bar[XB_XCNT(b.x)], 1u);
  return b;
}
DI void xcd_barrier_complete(unsigned* bar, unsigned x, unsigned& nloc, unsigned& nx) {
  const unsigned G = gridDim.x * gridDim.y * gridDim.z;
  unsigned sum, cnt, mine, sp = 0u;
  for (;;) {
    sum = 0u; cnt = 0u; mine = 0u;
#pragma unroll
    for (unsigned j = 0; j < 16; ++j) { const unsigned c = xb_ld(&bar[XB_XCNT(j)]); sum += c; cnt += (c > 0u) ? 1u : 0u; mine = (j == x) ? c : mine; }
    if (sum == G) break;
    __builtin_amdgcn_s_sleep(1);
    if ((++sp & 255u) == 0u) { if (xb_ld(&bar[XB_TMO])) break; if (sp > XB_SPIN_CAP) { atomicAdd(&bar[XB_TMO], 1u); break; } }
  }
  nloc = mine > 0u ? mine : 1u; nx = cnt > 0u ? cnt : 1u;
}
DI void xcd_barrier(const XcdBarrier& b) {
  asm volatile("s_waitcnt vmcnt(0)" ::: "memory");
  __syncthreads();
  if (threadIdx.x == 0) {
    unsigned* bar = b.bar;
    __builtin_amdgcn_s_waitcnt(0);
    unsigned nloc = b.st[0], nx = b.st[1];
    if (nloc == 0u) { xcd_barrier_complete(bar, b.x, nloc, nx); b.st[0] = nloc; b.st[1] = nx; }
    const unsigned old = xb_add(&bar[XB_XSUB(b.x)], 1u);
    const unsigned gen = old / nloc;
    if (old + 1u == (gen + 1u) * nloc) {
      __builtin_amdgcn_fence(__ATOMIC_RELEASE, "agent");
      asm volatile("s_waitcnt vmcnt(0)" ::: "memory");
      const unsigned og = xb_add(&bar[XB_TOP], 1u);
      const unsigned tg = og / nx;
      if (og + 1u == (tg + 1u) * nx) xb_add(&bar[XB_TOPGEN], 1u);
      else XB_SPIN(xb_ld(&bar[XB_TOPGEN]) == tg, bar);
      __builtin_amdgcn_fence(__ATOMIC_ACQUIRE, "agent");
      xb_add(&bar[XB_XGEN(b.x)], 1u);
      asm volatile("s_waitcnt vmcnt(0)" ::: "memory");
    } else {
      XB_SPIN(xb_ld(&bar[XB_XGEN(b.x)]) == gen, bar);
      __builtin_amdgcn_fence(__ATOMIC_ACQUIRE, "agent");
      asm volatile("s_waitcnt vmcnt(0)" ::: "memory");
    }
  }
  __syncthreads();
}

DI bf16_t f2bf(float x) { return __builtin_bit_cast(bf16_t, (__bf16)x); }
DI float bf2f(bf16_t h) { return __uint_as_float(((unsigned)h) << 16); }
typedef __attribute__((ext_vector_type(2))) __bf16 bf16x2_t;
DI unsigned pack2(float a, float b) { bf16x2_t v; v.x = (__bf16)a; v.y = (__bf16)b; return __builtin_bit_cast(unsigned, v); }
DI bf16x8 pack8_mfma(float a0, float a1, float a2, float a3, float a4, float a5, float a6, float a7) {
  uint4 u = make_uint4(pack2(a0, a1), pack2(a2, a3), pack2(a4, a5), pack2(a6, a7));
  return __builtin_bit_cast(bf16x8, u);
}
DI float sigmf(float x) { return __builtin_amdgcn_rcpf(1.f + __expf(-x)); }
DI float siluf(float x) { return x * sigmf(x); }
DI float dppf(float v, const int ctrl_sel) {
  int iv = __float_as_int(v), r;
  switch (ctrl_sel) {
    case 0: r = __builtin_amdgcn_update_dpp(0, iv, 0xB1, 0xf, 0xf, false); break;
    case 1: r = __builtin_amdgcn_update_dpp(0, iv, 0x4E, 0xf, 0xf, false); break;
    case 2: r = __builtin_amdgcn_update_dpp(0, iv, 0x141, 0xf, 0xf, false); break;
    default: r = __builtin_amdgcn_update_dpp(0, iv, 0x140, 0xf, 0xf, false); break;
  }
  return __int_as_float(r);
}
DI float row16_sum(float v) { v += dppf(v, 0); v += dppf(v, 1); v += dppf(v, 2); v += dppf(v, 3); return v; }
DI float wave_sum(float v) { v = row16_sum(v); v += __shfl_xor(v, 16); v += __shfl_xor(v, 32); return v; }
DI float wave_max(float v) {
  for (int o = 1; o < 64; o <<= 1) v = fmaxf(v, __shfl_xor(v, o));
  return v;
}
DI int crow(int i, int h) { return (i & 3) + 8 * (i >> 2) + 4 * h; }

struct Ptrs {
  float* mod; int* ctr; int* cuf; float* rope; float* bonus; float* mdt; float* mcb; bf16_t* W3; bf16_t* LA; float* xc1; bf16_t* W1; bf16_t* H;
  bf16_t *pA, *pB, *pC, *pD, *VtA, *VtD; bf16_t* R1; bf16_t* R2;
};
DI Ptrs mkptrs(char* ws) {
  Ptrs q;
  q.mod = (float*)(ws + OFF_MOD); q.ctr = (int*)(ws + OFF_CTR); q.rope = (float*)(ws + OFF_ROPE); q.cuf = (int*)(ws + OFF_CUF); q.bonus = (float*)(ws + OFF_BONUS); q.mdt = (float*)(ws + OFF_MDT); q.mcb = (float*)(ws + OFF_MCB);
  q.W3 = (bf16_t*)(ws + OFF_W3); q.LA = (bf16_t*)(ws + OFF_LA); q.xc1 = (float*)(ws + OFF_XC1);
  q.W1 = (bf16_t*)(ws + OFF_W1); q.H = (bf16_t*)(ws + OFF_H);
  q.pA = (bf16_t*)(ws + OFF_PA); q.pB = (bf16_t*)(ws + OFF_PB); q.pC = (bf16_t*)(ws + OFF_PC); q.pD = (bf16_t*)(ws + OFF_PD);
  q.VtA = (bf16_t*)(ws + OFF_VTA); q.VtD = (bf16_t*)(ws + OFF_VTD);
  q.R1 = (bf16_t*)(ws + OFF_R1); q.R2 = (bf16_t*)(ws + OFF_R2);
  return q;
}

DI const float* xrow(CP p, const Ptrs& w, int l, int tok) {
  int b = tok / TPB, i = tok - b * TPB;
  if (l == 0) return i < CTXL ? p.in[2] + (size_t)(b * CTXL + i) * DM : p.in[0] + (size_t)(b * 8192 + i - CTXL) * DM;
  return i < CTXL ? w.xc1 + (size_t)(b * CTXL + i) * DM : p.out + (size_t)(b * 8192 + i - CTXL) * DM;
}

DI void transpose_tile(const float* __restrict__ src, int ld_src, int k0, int n0, bool win_map, bf16_t* __restrict__ dst, int ld_dst, float* sm) {
  const int tid = TIDX;
  __syncthreads();
  {
    int cgp = (tid & 15) * 4, n = n0 + cgp;
    int ns = n;
    if (win_map) ns = n < 5904 ? n : (n < 6016 ? -1 : n - 112);
#pragma unroll
    for (int i = 0; i < 4; ++i) {
      int kk = (tid >> 4) + 16 * i;
      float4 v = make_float4(0.f, 0.f, 0.f, 0.f);
      if (ns >= 0) v = *(const float4*)(src + (size_t)(k0 + kk) * ld_src + ns);
      float* d = sm + kk * 65 + cgp;
      d[0] = v.x; d[1] = v.y; d[2] = v.z; d[3] = v.w;
    }
  }
  __syncthreads();
  {
    int n = tid >> 2, kq = (tid & 3) * 16;
    unsigned o[8];
#pragma unroll
    for (int j = 0; j < 8; ++j) o[j] = pack2(sm[(kq + 2 * j) * 65 + n], sm[(kq + 2 * j + 1) * 65 + n]);
    uint4* dp = (uint4*)(dst + (size_t)(n0 + n) * ld_dst + k0 + kq);
    dp[0] = make_uint4(o[0], o[1], o[2], o[3]);
    dp[1] = make_uint4(o[4], o[5], o[6], o[7]);
  }
}

DI void gemm_128(const bf16_t* __restrict__ A, int lda, const bf16_t* __restrict__ B, int ldb, int K, f32x16 (&acc)[2][2], bf16_t* sA, bf16_t* sB) {
  const int tid = TIDX, lane = tid & 63, wid = tid >> 6, wm = wid >> 1, wn = wid & 1, r = lane & 31, h = lane >> 5;
  const int lrow = tid >> 3, lkc = (tid & 7) * 8;
  const bf16_t* ga = A + (size_t)lrow * lda + lkc;
  const bf16_t* gb = B + (size_t)lrow * ldb + lkc;
  uint4 ra0, ra1, ra2, ra3, rb0, rb1, rb2, rb3;
  ra0 = *(const uint4*)(ga); ra1 = *(const uint4*)(ga + (size_t)32 * lda); ra2 = *(const uint4*)(ga + (size_t)64 * lda); ra3 = *(const uint4*)(ga + (size_t)96 * lda);
  rb0 = *(const uint4*)(gb); rb1 = *(const uint4*)(gb + (size_t)32 * ldb); rb2 = *(const uint4*)(gb + (size_t)64 * ldb); rb3 = *(const uint4*)(gb + (size_t)96 * ldb);
  for (int k0 = 0; k0 < K; k0 += 64) {
    __syncthreads();
    *(uint4*)(sA + (lrow) * 72 + lkc) = ra0; *(uint4*)(sA + (lrow + 32) * 72 + lkc) = ra1; *(uint4*)(sA + (lrow + 64) * 72 + lkc) = ra2; *(uint4*)(sA + (lrow + 96) * 72 + lkc) = ra3;
    *(uint4*)(sB + (lrow) * 72 + lkc) = rb0; *(uint4*)(sB + (lrow + 32) * 72 + lkc) = rb1; *(uint4*)(sB + (lrow + 64) * 72 + lkc) = rb2; *(uint4*)(sB + (lrow + 96) * 72 + lkc) = rb3;
    __syncthreads();
    if (k0 + 64 < K) {
      const bf16_t* ga2 = ga + k0 + 64; const bf16_t* gb2 = gb + k0 + 64;
      ra0 = *(const uint4*)(ga2); ra1 = *(const uint4*)(ga2 + (size_t)32 * lda); ra2 = *(const uint4*)(ga2 + (size_t)64 * lda); ra3 = *(const uint4*)(ga2 + (size_t)96 * lda);
      rb0 = *(const uint4*)(gb2); rb1 = *(const uint4*)(gb2 + (size_t)32 * ldb); rb2 = *(const uint4*)(gb2 + (size_t)64 * ldb); rb3 = *(const uint4*)(gb2 + (size_t)96 * ldb);
    }
#pragma unroll
    for (int s = 0; s < 4; ++s) {
      bf16x8 a0 = *(const bf16x8*)(sA + (wm * 64 + r) * 72 + s * 16 + h * 8);
      bf16x8 a1 = *(const bf16x8*)(sA + (wm * 64 + 32 + r) * 72 + s * 16 + h * 8);
      bf16x8 b0 = *(const bf16x8*)(sB + (wn * 64 + r) * 72 + s * 16 + h * 8);
      bf16x8 b1 = *(const bf16x8*)(sB + (wn * 64 + 32 + r) * 72 + s * 16 + h * 8);
      acc[0][0] = MFMA(a0, b0, acc[0][0]); acc[0][1] = MFMA(a0, b1, acc[0][1]);
      acc[1][0] = MFMA(a1, b0, acc[1][0]); acc[1][1] = MFMA(a1, b1, acc[1][1]);
    }
  }
}
DI void gemm_128_2set(const bf16_t* __restrict__ A, int lda, const bf16_t* __restrict__ B, int ldb, int K, f32x16 (&acc)[2][2], bf16_t* sA, bf16_t* sB) {
  const int tid = TIDX, lane = tid & 63, wid = tid >> 6, wm = wid >> 1, wn = wid & 1, r = lane & 31, h = lane >> 5;
  const int lrow = tid >> 3, lkc = (tid & 7) * 8;
  const bf16_t* ga = A + (size_t)lrow * lda + lkc;
  const bf16_t* gb = B + (size_t)lrow * ldb + lkc;
  uint4 pa0, pa1, pa2, pa3, pb0, pb1, pb2, pb3, qa0, qa1, qa2, qa3, qb0, qb1, qb2, qb3;
#define GL2_P(off) { const bf16_t* x = ga + (off); const bf16_t* y = gb + (off); \
    pa0 = *(const uint4*)(x); pa1 = *(const uint4*)(x + (size_t)32 * lda); pa2 = *(const uint4*)(x + (size_t)64 * lda); pa3 = *(const uint4*)(x + (size_t)96 * lda); \
    pb0 = *(const uint4*)(y); pb1 = *(const uint4*)(y + (size_t)32 * ldb); pb2 = *(const uint4*)(y + (size_t)64 * ldb); pb3 = *(const uint4*)(y + (size_t)96 * ldb); }
#define GL2_Q(off) { const bf16_t* x = ga + (off); const bf16_t* y = gb + (off); \
    qa0 = *(const uint4*)(x); qa1 = *(const uint4*)(x + (size_t)32 * lda); qa2 = *(const uint4*)(x + (size_t)64 * lda); qa3 = *(const uint4*)(x + (size_t)96 * lda); \
    qb0 = *(const uint4*)(y); qb1 = *(const uint4*)(y + (size_t)32 * ldb); qb2 = *(const uint4*)(y + (size_t)64 * ldb); qb3 = *(const uint4*)(y + (size_t)96 * ldb); }
#define ST2(a0, a1, a2, a3, b0, b1, b2, b3) { \
    *(uint4*)(sA + (lrow) * 72 + lkc) = a0; *(uint4*)(sA + (lrow + 32) * 72 + lkc) = a1; *(uint4*)(sA + (lrow + 64) * 72 + lkc) = a2; *(uint4*)(sA + (lrow + 96) * 72 + lkc) = a3; \
    *(uint4*)(sB + (lrow) * 72 + lkc) = b0; *(uint4*)(sB + (lrow + 32) * 72 + lkc) = b1; *(uint4*)(sB + (lrow + 64) * 72 + lkc) = b2; *(uint4*)(sB + (lrow + 96) * 72 + lkc) = b3; }
#define MMA2() _Pragma("unroll") for (int s = 0; s < 4; ++s) { \
      bf16x8 a0 = *(const bf16x8*)(sA + (wm * 64 + r) * 72 + s * 16 + h * 8); \
      bf16x8 a1 = *(const bf16x8*)(sA + (wm * 64 + 32 + r) * 72 + s * 16 + h * 8); \
      bf16x8 b0 = *(const bf16x8*)(sB + (wn * 64 + r) * 72 + s * 16 + h * 8); \
      bf16x8 b1 = *(const bf16x8*)(sB + (wn * 64 + 32 + r) * 72 + s * 16 + h * 8); \
      acc[0][0] = MFMA(a0, b0, acc[0][0]); acc[0][1] = MFMA(a0, b1, acc[0][1]); \
      acc[1][0] = MFMA(a1, b0, acc[1][0]); acc[1][1] = MFMA(a1, b1, acc[1][1]); }
  GL2_P(0)
  GL2_Q(64)
  for (int k0 = 0; k0 < K; k0 += 128) {
    __syncthreads();
    ST2(pa0, pa1, pa2, pa3, pb0, pb1, pb2, pb3)
    __syncthreads();
    GL2_P(min(k0 + 128, K - 64))
    MMA2()
    __syncthreads();
    ST2(qa0, qa1, qa2, qa3, qb0, qb1, qb2, qb3)
    __syncthreads();
    GL2_Q(min(k0 + 192, K - 64))
    MMA2()
  }
#undef GL2_P
#undef GL2_Q
#undef ST2
#undef MMA2
}
DI void gemm_128_deep(const bf16_t* __restrict__ A, int lda, const bf16_t* __restrict__ B, int ldb, int K, f32x16 (&acc)[2][2], bf16_t* sA, bf16_t* sBunused) {
  (void)sBunused;
  const int tid = TIDX, lane = tid & 63, wid = tid >> 6, wm = wid >> 1, wn = wid & 1, r = lane & 31, h = lane >> 5;
  const int lrow = tid >> 3, lkc = (tid & 7) * 8;
  const bf16_t* ga = A + (size_t)lrow * lda + lkc;
  const bf16_t* gb = B + (size_t)lrow * ldb + lkc;
  uint4 pa0, pa1, pa2, pa3, pb0, pb1, pb2, pb3, qa0, qa1, qa2, qa3, qb0, qb1, qb2, qb3;
#define GL_P(off) { const bf16_t* x = ga + (off); const bf16_t* y = gb + (off); \
    pa0 = *(const uint4*)(x); pa1 = *(const uint4*)(x + (size_t)32 * lda); pa2 = *(const uint4*)(x + (size_t)64 * lda); pa3 = *(const uint4*)(x + (size_t)96 * lda); \
    pb0 = *(const uint4*)(y); pb1 = *(const uint4*)(y + (size_t)32 * ldb); pb2 = *(const uint4*)(y + (size_t)64 * ldb); pb3 = *(const uint4*)(y + (size_t)96 * ldb); }
#define GL_Q(off) { const bf16_t* x = ga + (off); const bf16_t* y = gb + (off); \
    qa0 = *(const uint4*)(x); qa1 = *(const uint4*)(x + (size_t)32 * lda); qa2 = *(const uint4*)(x + (size_t)64 * lda); qa3 = *(const uint4*)(x + (size_t)96 * lda); \
    qb0 = *(const uint4*)(y); qb1 = *(const uint4*)(y + (size_t)32 * ldb); qb2 = *(const uint4*)(y + (size_t)64 * ldb); qb3 = *(const uint4*)(y + (size_t)96 * ldb); }
#define ST_LDS(buf, a0, a1, a2, a3, b0, b1, b2, b3) { bf16_t* da = sA + (buf) * (2 * 128 * 72); bf16_t* db = da + 128 * 72; \
    *(uint4*)(da + (lrow) * 72 + lkc) = a0; *(uint4*)(da + (lrow + 32) * 72 + lkc) = a1; *(uint4*)(da + (lrow + 64) * 72 + lkc) = a2; *(uint4*)(da + (lrow + 96) * 72 + lkc) = a3; \
    *(uint4*)(db + (lrow) * 72 + lkc) = b0; *(uint4*)(db + (lrow + 32) * 72 + lkc) = b1; *(uint4*)(db + (lrow + 64) * 72 + lkc) = b2; *(uint4*)(db + (lrow + 96) * 72 + lkc) = b3; }
#define MMA_TILE(buf) { const bf16_t* ca = sA + (buf) * (2 * 128 * 72); const bf16_t* cb = ca + 128 * 72; \
    _Pragma("unroll") for (int s = 0; s < 4; ++s) { \
      bf16x8 a0 = *(const bf16x8*)(ca + (wm * 64 + r) * 72 + s * 16 + h * 8); \
      bf16x8 a1 = *(const bf16x8*)(ca + (wm * 64 + 32 + r) * 72 + s * 16 + h * 8); \
      bf16x8 b0 = *(const bf16x8*)(cb + (wn * 64 + r) * 72 + s * 16 + h * 8); \
      bf16x8 b1 = *(const bf16x8*)(cb + (wn * 64 + 32 + r) * 72 + s * 16 + h * 8); \
      acc[0][0] = MFMA(a0, b0, acc[0][0]); acc[0][1] = MFMA(a0, b1, acc[0][1]); \
      acc[1][0] = MFMA(a1, b0, acc[1][0]); acc[1][1] = MFMA(a1, b1, acc[1][1]); } }
  GL_P(0)
  GL_Q(64)
  __syncthreads();
  ST_LDS(0, pa0, pa1, pa2, pa3, pb0, pb1, pb2, pb3)
  GL_P(128)
  __syncthreads();
  for (int k0 = 0; k0 < K; k0 += 128) {
    MMA_TILE(0)
    ST_LDS(1, qa0, qa1, qa2, qa3, qb0, qb1, qb2, qb3)
    GL_Q(min(k0 + 192, K - 64))
    __syncthreads();
    MMA_TILE(1)
    ST_LDS(0, pa0, pa1, pa2, pa3, pb0, pb1, pb2, pb3)
    GL_P(min(k0 + 256, K - 64))
    __syncthreads();
  }
#undef GL_P
#undef GL_Q
#undef ST_LDS
#undef MMA_TILE
}
DI bool tile_map(int k, int MT, int NT, int& mt, int& nt) {
  const int gd = GDIM, b = BIDX;
  if (gd & 63) { int it = b + k * gd; if (it >= MT * NT) return false; mt = it / NT; nt = it - mt * NT; return true; }
  const int gsm = gd >> 6, x = b & 7, j = b >> 3;
  const int ngn = (NT + 7) >> 3, ngm = (MT + gsm - 1) / gsm;
  const int g = k * 8 + x;
  if (g >= ngm * ngn) return false;
  const int gm = g / ngn, gn = g - gm * ngn;
  mt = gm * gsm + (j >> 3); nt = gn * 8 + (j & 7);
  return mt < MT && nt < NT;
}
DI int tile_rounds(int MT, int NT) {
  const int gd = GDIM;
  if (gd & 63) return (MT * NT + gd - 1) / gd;
  const int gsm = gd >> 6;
  return (((NT + 7) >> 3) * ((MT + gsm - 1) / gsm) + 7) >> 3;
}
DI void zero_acc(f32x16 (&acc)[2][2]) {
#pragma unroll
  for (int a = 0; a < 2; ++a)
#pragma unroll
    for (int b = 0; b < 2; ++b)
#pragma unroll
      for (int i = 0; i < 16; ++i) acc[a][b][i] = 0.f;
}

DI void phase_ada_item(CP p, const Ptrs& w, int l, int item, int ksplit, float* sm) {
  const int tid = TIDX, lane = tid & 63, wid = tid >> 6;
  const int cgp = item % 96, kq = item / 96, j = cgp * 64 + lane;
  const int rows_w = 512 / ksplit;
  float* act = sm;
  float* red = sm + 3 * 2048;
  __syncthreads();
  for (int e = tid; e < 3 * 2048; e += 256) {
    int v = e >> 11, k = e & 2047;
    float x = v < 2 ? p.in[1][v * 2048 + k] : p.in[3][k];
    act[e] = siluf(x);
  }
  __syncthreads();
  const float* wa = p.in[5] + (size_t)l * 2048 * 6144 + j;
  float a0 = 0.f, a1 = 0.f, a2 = 0.f;
  const int kb = kq * (2048 / ksplit) + wid * rows_w;
#pragma unroll 32
  for (int k = 0; k < rows_w; ++k) {
    float wv = wa[(size_t)(kb + k) * 6144];
    a0 += act[kb + k] * wv; a1 += act[2048 + kb + k] * wv; a2 += act[4096 + kb + k] * wv;
  }
  red[(wid * 3 + 0) * 64 + lane] = a0; red[(wid * 3 + 1) * 64 + lane] = a1; red[(wid * 3 + 2) * 64 + lane] = a2;
  __syncthreads();
  if (tid < 192) {
    int v = tid >> 6, ll = tid & 63, jj = cgp * 64 + ll;
    float s = red[(0 * 3 + v) * 64 + ll] + red[(1 * 3 + v) * 64 + ll] + red[(2 * 3 + v) * 64 + ll] + red[(3 * 3 + v) * 64 + ll];
    if (ksplit == 1) w.mod[(l * 3 + v) * 6144 + jj] = s + p.in[6][l * 6144 + jj];
    else atomicAdd(&w.mod[(l * 3 + v) * 6144 + jj], kq == 0 ? s + p.in[6][l * 6144 + jj] : s);
  }
}
DI void conv_w1(CP p, const Ptrs& w, int l, float* sm) {
  const float* src = p.in[7] + (size_t)l * 2048 * 7952;
  for (int it = BIDX; it < 126 * 32; it += GDIM) {
    int nt = it >> 5, kt = it & 31;
    transpose_tile(src, 7952, kt * 64, nt * 64, true, w.W1, 2048, sm);
  }
}
DI void conv_w3(CP p, const Ptrs& w, int l, float* sm) {
  for (int it = BIDX; it < 32; it += GDIM) {
    int m = it >> 3, nt = it & 7, type = m >> 1, dir = m & 1;
    const float* src = p.in[type == 0 ? 13 : 15] + (size_t)((l * 2 + dir) * 64) * 512;
    transpose_tile(src, 512, 0, nt * 64, false, w.W3 + (size_t)m * 512 * 64, 64, sm);
  }
}
DI void conv_w2(CP p, const Ptrs& w, int l, float* sm) {
  bf16_t* gate_t = (bf16_t*)((char*)w.R1 + R1_GATE);
  bf16_t* up_t = (bf16_t*)((char*)w.R1 + R1_UP);
  bf16_t* out_t = (bf16_t*)((char*)w.R1 + R1_OUT);
  for (int it = BIDX; it < 6144; it += GDIM) {
    if (it < 4096) {
      int i = it >> 10, r = it & 1023, nt = r >> 5, kt = r & 31;
      transpose_tile(p.in[34] + (size_t)(l * 4 + i) * 2048 * 2048, 2048, kt * 64, nt * 64, false, gate_t + (size_t)i * 2048 * 2048, 2048, sm);
    } else if (it < 5120) {
      int q = it - 4096, i = q >> 8, r = q & 255, nt = r >> 3, kt = r & 7;
      transpose_tile(p.in[35] + (size_t)(l * 4 + i) * 512 * 2048, 2048, kt * 64, nt * 64, false, up_t + (size_t)i * 2048 * 512, 512, sm);
    } else {
      int r = it - 5120, nt = r >> 5, kt = r & 31;
      transpose_tile(p.in[36] + (size_t)l * 2048 * 2048, 2048, kt * 64, nt * 64, false, out_t, 2048, sm);
    }
  }
}

DI void phase_norm(CP p, const Ptrs& w, int l) {
  const int lane = TIDX & 63, gw = BIDX * 4 + (TIDX >> 6), nw = GDIM * 4;
  const float* nwt = p.in[4] + l * 2048;
  for (int tok = gw; tok < T; tok += nw) {
    int b = tok / TPB, i = tok - b * TPB, v = i < CTXL ? 2 : b;
    const float* xr = xrow(p, w, l, tok);
    const float* md = w.mod + (l * 3 + v) * 6144;
    float4 xv[8];
    float ss = 0.f;
#pragma unroll
    for (int j = 0; j < 8; ++j) { xv[j] = *(const float4*)(xr + (j * 64 + lane) * 4); ss += xv[j].x * xv[j].x + xv[j].y * xv[j].y + xv[j].z * xv[j].z + xv[j].w * xv[j].w; }
    ss = wave_sum(ss);
    float inv = rsqrtf(ss * (1.f / 2048.f) + 1e-6f);
#pragma unroll
    for (int j = 0; j < 8; ++j) {
      int c = (j * 64 + lane) * 4;
      float4 nw4 = *(const float4*)(nwt + c), sh = *(const float4*)(md + c), sc = *(const float4*)(md + 2048 + c);
      float y0 = xv[j].x * inv * nw4.x * (1.f + sc.x) + sh.x, y1 = xv[j].y * inv * nw4.y * (1.f + sc.y) + sh.y;
      float y2 = xv[j].z * inv * nw4.z * (1.f + sc.z) + sh.z, y3 = xv[j].w * inv * nw4.w * (1.f + sc.w) + sh.w;
      *(uint2*)(w.H + (size_t)tok * 2048 + c) = make_uint2(pack2(y0, y1), pack2(y2, y3));
    }
  }
}

DI void phase_inproj(CP p, const Ptrs& w, int l, bf16_t* sA, bf16_t* sB) {
  const int tid = TIDX, lane = tid & 63, wid = tid >> 6, wm = wid >> 1, wn = wid & 1, r = lane & 31, h = lane >> 5;
  const int nrounds = tile_rounds(132, 63);
  for (int kk = 0; kk < nrounds; ++kk) {
    int mt, nt;
    if (!tile_map(kk, 132, 63, mt, nt)) continue;
    int m0 = mt * 128, n0 = nt * 128;
    f32x16 acc[2][2];
    zero_acc(acc);
    gemm_128_deep(w.H + (size_t)m0 * 2048, 2048, w.W1 + (size_t)n0 * 2048, 2048, 2048, acc, sA, sB);
    bf16_t* dst = nullptr; int stride = 0, cbase = 0; bf16_t* vt = nullptr; int vbase = 0;
    if (n0 < 2048) { int sub = n0 >> 9; if (sub == 2) { vt = w.VtA; vbase = n0 - 1024; } else { dst = w.pA; stride = SPA; cbase = sub == 3 ? n0 - 512 : n0; } }
    else if (n0 < 4352) { dst = w.pB; stride = SPB; cbase = n0 - 2048; }
    else if (n0 < 6016) { dst = w.pC; stride = SPC; cbase = n0 - 4352; }
    else { int cd = n0 - 6016, sub = cd >> 9; if (sub == 2) { vt = w.VtD; vbase = cd - 1024; } else { dst = w.pD; stride = SPD; cbase = sub == 3 ? cd - 512 : cd; } }
    if (dst) {
#pragma unroll
      for (int mi = 0; mi < 2; ++mi)
#pragma unroll
        for (int ni = 0; ni < 2; ++ni)
#pragma unroll
          for (int i = 0; i < 16; ++i) {
            int row = m0 + wm * 64 + mi * 32 + crow(i, h), col = cbase + wn * 64 + ni * 32 + r;
            dst[(size_t)row * stride + col] = f2bf(acc[mi][ni][i]);
          }
    } else {
      int b = m0 / TPB, ib = m0 - b * TPB;
#pragma unroll
      for (int mi = 0; mi < 2; ++mi)
#pragma unroll
        for (int ni = 0; ni < 2; ++ni)
#pragma unroll
          for (int g = 0; g < 4; ++g) {
            int i0 = ib + wm * 64 + mi * 32 + 8 * g + 4 * h, vcol = vbase + wn * 64 + ni * 32 + r;
            *(uint2*)(vt + (size_t)(b * 512 + vcol) * TPB + i0) =
                make_uint2(pack2(acc[mi][ni][4 * g], acc[mi][ni][4 * g + 1]), pack2(acc[mi][ni][4 * g + 2], acc[mi][ni][4 * g + 3]));
          }
    }
  }
  if (l == 0) {
    __shared__ int s_ada;
    for (;;) {
      __syncthreads();
      if (TIDX == 0) s_ada = atomicAdd(&w.ctr[40], 1);
      __syncthreads();
      const int it = s_ada;
      if (it >= 96) break;
      phase_ada_item(p, w, 1, it, 1, (float*)sA);
    }
  }
}

DI float quad_sum(float v) { v += dppf(v, 0); v += dppf(v, 1); return v; }
DI float row8_sum(float v) { v += dppf(v, 0); v += dppf(v, 1); v += dppf(v, 2); return v; }
DI void unpack8(uint4 u, float* f) {
  f[0] = __uint_as_float(u.x << 16); f[1] = __uint_as_float(u.x & 0xffff0000u); f[2] = __uint_as_float(u.y << 16); f[3] = __uint_as_float(u.y & 0xffff0000u);
  f[4] = __uint_as_float(u.z << 16); f[5] = __uint_as_float(u.z & 0xffff0000u); f[6] = __uint_as_float(u.w << 16); f[7] = __uint_as_float(u.w & 0xffff0000u);
}
DI uint4 pack8(const float* f) { return make_uint4(pack2(f[0], f[1]), pack2(f[2], f[3]), pack2(f[4], f[5]), pack2(f[6], f[7])); }
DI void phase_prep(CP p, const Ptrs& w, int l) {
  const int lane = TIDX & 63, gw = BIDX * 4 + (TIDX >> 6), nw = GDIM * 4;
  const int qd = lane & 3, vec = lane >> 2;
  float wa[16], wd[16];
  {
    const float* sa = (vec < 8 ? p.in[8] : p.in[9]) + l * 64 + qd * 16;
    const float* sd = (vec < 8 ? p.in[27] : p.in[28]) + l * 64 + qd * 16;
    const float qs = vec < 8 ? QS : 1.f;
#pragma unroll
    for (int j = 0; j < 16; ++j) { wa[j] = sa[j] * qs; wd[j] = sd[j] * qs; }
  }
  float mu4[4];
#pragma unroll
  for (int j = 0; j < 4; ++j) mu4[j] = p.in[11][l * 1792 + 1536 + lane * 4 + j];
  float cwB[4][4], cwC[4][4];
#pragma unroll
  for (int j = 0; j < 4; ++j) {
#pragma unroll
    for (int q = 0; q < 3; ++q) { cwB[q][j] = p.in[21][(l * 3 + q) * 1024 + 512 + lane * 4 + j]; cwC[q][j] = p.in[21][(l * 3 + q) * 1024 + 768 + lane * 4 + j]; }
    cwB[3][j] = p.in[22][l * 1024 + 512 + lane * 4 + j]; cwC[3][j] = p.in[22][l * 1024 + 768 + lane * 4 + j];
  }
  const float dtb_l = lane < 16 ? p.in[23][l * 16 + lane] : 0.f;
  const float Aneg_l = lane < 16 ? -__expf(p.in[24][l * 16 + lane]) : 0.f;
  for (int tok = gw; tok < T; tok += nw) {
    int b = tok / TPB, i = tok - b * TPB;
    bool isx = i >= CTXL;
    int ti = i - CTXL;
    uint4* pa = (uint4*)(w.pA + (size_t)tok * SPA) + lane * 2;
    uint4* pd = (uint4*)(w.pD + (size_t)tok * SPD) + lane * 2;
    const bf16_t* rb = w.pB + (size_t)tok * SPB + 1536 + lane * 4;
    bool hp = (i != 0) && (i != CTXL), hn = (i != CTXL - 1) && (i != TPB - 1);
    uint4 a0 = pa[0], a1 = pa[1], d0 = pd[0], d1 = pd[1];
    uint2 lc = *(const uint2*)rb, lp = make_uint2(0, 0), ln = make_uint2(0, 0);
    if (hp) lp = *(const uint2*)(rb - SPB);
    if (hn) ln = *(const uint2*)(rb + SPB);
    float4 rt[8];
    if (isx) {
      const float4* tp = (const float4*)(w.rope + (size_t)((qd < 2 ? (ti >> 6) : (ti & 63)) * 32));
#pragma unroll
      for (int j = 0; j < 8; ++j) rt[j] = tp[j];
    }
    float e[16];
    unpack8(a0, e); unpack8(a1, e + 8);
    {
      float ss = 0.f;
#pragma unroll
      for (int j = 0; j < 16; ++j) ss += e[j] * e[j];
      ss = quad_sum(ss);
      float sc = rsqrtf(ss * (1.f / 64.f) + 1e-6f);
#pragma unroll
      for (int j = 0; j < 16; ++j) e[j] = e[j] * sc * wa[j];
      pa[0] = pack8(e); pa[1] = pack8(e + 8);
    }
    unpack8(d0, e); unpack8(d1, e + 8);
    {
      float ss = 0.f;
#pragma unroll
      for (int j = 0; j < 16; ++j) ss += e[j] * e[j];
      ss = quad_sum(ss);
      float sc = rsqrtf(ss * (1.f / 64.f) + 1e-6f);
#pragma unroll
      for (int j = 0; j < 16; ++j) e[j] = e[j] * sc * wd[j];
      if (isx) {
#pragma unroll
        for (int j = 0; j < 16; ++j) {
          float pr = dppf(e[j], 0);
          float cs = (j & 1) ? rt[j >> 1].z : rt[j >> 1].x, sn = (j & 1) ? rt[j >> 1].w : rt[j >> 1].y;
          e[j] = e[j] * cs + ((qd & 1) ? pr : -pr) * sn;
        }
      }
      pd[0] = pack8(e); pd[1] = pack8(e + 8);
    }
    {
      const bf16_t* rc = w.pC + (size_t)tok * SPC;
      uint2 bc = *(const uint2*)(rc + 512 + lane * 4), cc = *(const uint2*)(rc + 768 + lane * 4);
      uint2 bp = make_uint2(0, 0), bn = make_uint2(0, 0), cp = make_uint2(0, 0), cn = make_uint2(0, 0);
      if (hp) { bp = *(const uint2*)(rc + 512 + lane * 4 - SPC); cp = *(const uint2*)(rc + 768 + lane * 4 - SPC); }
      if (hn) { bn = *(const uint2*)(rc + 512 + lane * 4 + SPC); cn = *(const uint2*)(rc + 768 + lane * 4 + SPC); }
      float dtraw = lane < 16 ? bf2f(rc[1024 + lane]) : 0.f;
      float Bc[4] = {__uint_as_float(bc.x << 16), __uint_as_float(bc.x & 0xffff0000u), __uint_as_float(bc.y << 16), __uint_as_float(bc.y & 0xffff0000u)};
      float Bp[4] = {__uint_as_float(bp.x << 16), __uint_as_float(bp.x & 0xffff0000u), __uint_as_float(bp.y << 16), __uint_as_float(bp.y & 0xffff0000u)};
      float Bn[4] = {__uint_as_float(bn.x << 16), __uint_as_float(bn.x & 0xffff0000u), __uint_as_float(bn.y << 16), __uint_as_float(bn.y & 0xffff0000u)};
      float Cc[4] = {__uint_as_float(cc.x << 16), __uint_as_float(cc.x & 0xffff0000u), __uint_as_float(cc.y << 16), __uint_as_float(cc.y & 0xffff0000u)};
      float Cp[4] = {__uint_as_float(cp.x << 16), __uint_as_float(cp.x & 0xffff0000u), __uint_as_float(cp.y << 16), __uint_as_float(cp.y & 0xffff0000u)};
      float Cn[4] = {__uint_as_float(cn.x << 16), __uint_as_float(cn.x & 0xffff0000u), __uint_as_float(cn.y << 16), __uint_as_float(cn.y & 0xffff0000u)};
      float ob[4], oc[4], prod = 0.f;
#pragma unroll
      for (int j = 0; j < 4; ++j) {
        ob[j] = bf2f(f2bf(siluf(cwB[0][j] * Bp[j] + cwB[1][j] * Bc[j] + cwB[2][j] * Bn[j] + cwB[3][j])));
        oc[j] = bf2f(f2bf(siluf(cwC[0][j] * Cp[j] + cwC[1][j] * Cc[j] + cwC[2][j] * Cn[j] + cwC[3][j])));
        prod += ob[j] * oc[j];
      }
      prod = row16_sum(prod); prod += __shfl_xor(prod, 16);
      bf16_t* mb = w.W1 + (size_t)tok * 512;
      *(uint2*)(mb + lane * 4) = make_uint2(pack2(ob[0], ob[1]), pack2(ob[2], ob[3]));
      *(uint2*)(mb + 256 + lane * 4) = make_uint2(pack2(oc[0], oc[1]), pack2(oc[2], oc[3]));
      if ((lane & 31) == 0) w.mcb[(size_t)tok * 2 + (lane >> 5)] = prod;
      if (lane < 16) {
        float dr = dtraw + dtb_l;
        float dt = dr > 20.f ? dr : log1pf(__expf(dr));
        *(float2*)(w.mdt + ((size_t)tok * 16 + lane) * 2) = make_float2(dt, __expf(dt * Aneg_l));
      }
    }
    {
      float c4[4] = {__uint_as_float(lc.x << 16), __uint_as_float(lc.x & 0xffff0000u), __uint_as_float(lc.y << 16), __uint_as_float(lc.y & 0xffff0000u)};
      float p4[4] = {__uint_as_float(lp.x << 16), __uint_as_float(lp.x & 0xffff0000u), __uint_as_float(lp.y << 16), __uint_as_float(lp.y & 0xffff0000u)};
      float n4[4] = {__uint_as_float(ln.x << 16), __uint_as_float(ln.x & 0xffff0000u), __uint_as_float(ln.y << 16), __uint_as_float(ln.y & 0xffff0000u)};
      float o[4];
#pragma unroll
      for (int j = 0; j < 4; ++j) { float sft = c4[j] + (0.5f * (p4[j] + n4[j]) - c4[j]) * mu4[j]; o[j] = lane < 32 ? tanhf(sft) : sft; }
      *(uint2*)(w.LA + (size_t)tok * 256 + lane * 4) = make_uint2(pack2(o[0], o[1]), pack2(o[2], o[3]));
    }
  }
}

DI void phase_lora(CP p, const Ptrs& w, int l, bf16_t* sA, bf16_t* sB) {
  const int tid = TIDX, lane = tid & 63, wid = tid >> 6, wm = wid >> 1, wn = wid & 1, r = lane & 31, h = lane >> 5;
  for (int it = BIDX; it < 132 * 16; it += GDIM) {
    int mt = it >> 4, q = it & 15, m = q >> 2, nt = q & 3, type = m >> 1, dir = m & 1, m0 = mt * 128, n0 = nt * 128;
    f32x16 acc[2][2];
    zero_acc(acc);
    gemm_128(w.LA + (size_t)m0 * 256 + m * 64, 256, w.W3 + (size_t)(m * 512 + n0) * 64, 64, 64, acc, sA, sB);
    const float* bias = p.in[type == 0 ? 12 : 14] + (l * 2 + dir) * 512;
    bf16_t* dst = w.R1 + (size_t)m * T * 512;
#pragma unroll
    for (int mi = 0; mi < 2; ++mi)
#pragma unroll
      for (int ni = 0; ni < 2; ++ni) {
        int col = n0 + wn * 64 + ni * 32 + r;
        float bc = bias[col];
#pragma unroll
        for (int i = 0; i < 16; ++i) {
          int row = m0 + wm * 64 + mi * 32 + crow(i, h);
          float x = acc[mi][ni][i] + bc, o;
          if (type == 0) o = 1.f - __expf(-0.6065306597126334f * sigmf(x));
          else o = sigmf(x);
          dst[(size_t)row * 512 + col] = f2bf(o);
        }
      }
  }
}

DI void phase_rwscal(CP p, const Ptrs& w, int l) {
  const int lane = TIDX & 63, gw = BIDX * 4 + (TIDX >> 6), nw = GDIM * 4;
  const int c0 = lane * 8, hd = lane >> 3;
  float mur[8], muk[8], kkc[8], kac[8], rkc[8];
#pragma unroll
  for (int j = 0; j < 8; ++j) {
    mur[j] = p.in[11][l * 1792 + c0 + j]; muk[j] = p.in[11][l * 1792 + 512 + c0 + j];
    kkc[j] = p.in[16][l * 512 + c0 + j]; kac[j] = p.in[17][l * 512 + c0 + j]; rkc[j] = p.in[18][l * 512 + c0 + j];
  }
  const bf16_t* Ad0 = w.R1 + (size_t)2 * T * 512, *Ad1 = w.R1 + (size_t)3 * T * 512;
  for (int tok = gw; tok < T; tok += nw) {
    int b = tok / TPB, i = tok - b * TPB;
    bool hp = (i != 0) && (i != CTXL), hn = (i != CTXL - 1) && (i != TPB - 1);
    const bf16_t* rb = w.pB + (size_t)tok * SPB + c0;
    uint4 ur = *(const uint4*)rb, uk = *(const uint4*)(rb + 512);
    uint4 urp = make_uint4(0, 0, 0, 0), urn = urp, ukp = urp, ukn = urp;
    if (hp) { urp = *(const uint4*)(rb - SPB); ukp = *(const uint4*)(rb + 512 - SPB); }
    if (hn) { urn = *(const uint4*)(rb + SPB); ukn = *(const uint4*)(rb + 512 + SPB); }
    uint4 ua0 = *(const uint4*)(Ad0 + (size_t)tok * 512 + c0), ua1 = *(const uint4*)(Ad1 + (size_t)tok * 512 + c0);
    float r[8], k[8], t0[8], t1[8];
    unpack8(ur, r); unpack8(urp, t0); unpack8(urn, t1);
#pragma unroll
    for (int j = 0; j < 8; ++j) r[j] = r[j] + (0.5f * (t0[j] + t1[j]) - r[j]) * mur[j];
    unpack8(uk, k); unpack8(ukp, t0); unpack8(ukn, t1);
    float ss = 0.f;
#pragma unroll
    for (int j = 0; j < 8; ++j) { k[j] = k[j] + (0.5f * (t0[j] + t1[j]) - k[j]) * muk[j]; float kv = k[j] * kkc[j]; ss += kv * kv; }
    ss = row8_sum(ss);
    float inv = 1.f / fmaxf(sqrtf(ss), 1e-12f);
    unpack8(ua0, t0); unpack8(ua1, t1);
    float br0 = 0.f, kr0 = 0.f, bo0 = 0.f, br1 = 0.f, kr1 = 0.f, bo1 = 0.f;
#pragma unroll
    for (int j = 0; j < 8; ++j) {
      float kk = k[j] * kkc[j] * inv;
      float kd0 = k[j] * (1.f + (t0[j] - 1.f) * kac[j]), kd1 = k[j] * (1.f + (t1[j] - 1.f) * kac[j]);
      br0 += kk * t0[j] * r[j]; br1 += kk * t1[j] * r[j];
      kr0 += kd0 * r[j]; kr1 += kd1 * r[j];
      bo0 += r[j] * kd0 * rkc[j]; bo1 += r[j] * kd1 * rkc[j];
    }
    br0 = row8_sum(br0); br1 = row8_sum(br1); kr0 = row8_sum(kr0); kr1 = row8_sum(kr1); bo0 = row8_sum(bo0); bo1 = row8_sum(bo1);
    if ((lane & 7) == 0) {
      float4* dst = (float4*)(w.bonus + ((size_t)tok * 8 + hd) * 8);
      dst[0] = make_float4(inv, br0, kr0, bo0);
      dst[1] = make_float4(br1, kr1, bo1, 0.f);
    }
  }
}

DI int pos2i(int pos, int dir) { return dir == 0 ? pos : (pos < CTXL ? CTXL - 1 - pos : (TPB + CTXL - 1) - pos); }

DI void rwkv_scan(CP p, const Ptrs& w, int l, int item, float* sm) {
  const int tid = TIDX, lane = tid & 63, wid = tid >> 6;
  const int chain = item >> 2, rq = item & 3, b = chain >> 4, hd = (chain >> 1) & 7, dir = chain & 1;
  const int sj = tid >> 4, skq = (tid & 15) * 4, sc_ = hd * 64 + skq;
  float mu_r[4], mu_k[4], mu_v[4], kk_c[4], ka_c[4];
#pragma unroll
  for (int j = 0; j < 4; ++j) {
    mu_r[j] = p.in[11][l * 1792 + sc_ + j]; mu_k[j] = p.in[11][l * 1792 + 512 + sc_ + j]; mu_v[j] = p.in[11][l * 1792 + 1024 + sc_ + j];
    kk_c[j] = p.in[16][l * 512 + sc_ + j]; ka_c[j] = p.in[17][l * 512 + sc_ + j];
  }
  const bf16_t* Wd = w.R1 + (size_t)(0 * 2 + dir) * T * 512;
  const bf16_t* Ad = w.R1 + (size_t)(1 * 2 + dir) * T * 512;
  bf16_t* yout = w.R2 + (size_t)dir * T * 512;
  constexpr int BUF = 6 * 1024 + 32;
  const int kg = lane & 15, rs = lane >> 4, row = rq * 16 + wid * 4 + rs;
  f2v SA = {0.f, 0.f}, SB = {0.f, 0.f};
  struct RPre { uint2 pq[3][3], pwd, pad_; float psc[3], pmk[2]; };
  RPre PA, PB;
  auto load = [&](int c, RPre& P) {
    int ii = pos2i(c * 16 + sj, dir);
    size_t tok = (size_t)b * TPB + ii;
    const bf16_t* prow = w.pB + tok * SPB + sc_;
    bool hp = (ii != 0) && (ii != CTXL), hn = (ii != CTXL - 1) && (ii != TPB - 1);
    const int op = hp ? -SPB : 0, on = hn ? SPB : 0;
    P.pmk[0] = hp ? 0.5f : 0.f; P.pmk[1] = hn ? 0.5f : 0.f;
#pragma unroll
    for (int q = 0; q < 3; ++q) {
      P.pq[q][0] = *(const uint2*)(prow + q * 512);
      P.pq[q][1] = *(const uint2*)(prow + q * 512 + op);
      P.pq[q][2] = *(const uint2*)(prow + q * 512 + on);
    }
    P.pwd = *(const uint2*)(Wd + tok * 512 + sc_);
    P.pad_ = *(const uint2*)(Ad + tok * 512 + sc_);
    const float* sc = w.bonus + (tok * 8 + hd) * 8;
    P.psc[0] = sc[0]; P.psc[1] = sc[1 + 3 * dir]; P.psc[2] = sc[2 + 3 * dir];
  };
  auto up4 = [](uint2 u, float* f) { f[0] = __uint_as_float(u.x << 16); f[1] = __uint_as_float(u.x & 0xffff0000u); f[2] = __uint_as_float(u.y << 16); f[3] = __uint_as_float(u.y & 0xffff0000u); };
  auto stage = [&](const RPre& P, float* bufp) {
    float rc[4], rp[4], rn[4], kc[4], kp[4], kn[4], vc[4], vp[4], vn[4], wd4[4], ad4[4];
    up4(P.pq[0][0], rc); up4(P.pq[0][1], rp); up4(P.pq[0][2], rn);
    up4(P.pq[1][0], kc); up4(P.pq[1][1], kp); up4(P.pq[1][2], kn);
    up4(P.pq[2][0], vc); up4(P.pq[2][1], vp); up4(P.pq[2][2], vn);
    up4(P.pwd, wd4); up4(P.pad_, ad4);
    float o0[4], o1[4], o2[4], o3[4], o4[4], o5[4];
#pragma unroll
    for (int j = 0; j < 4; ++j) {
      float r_s = rc[j] + ((P.pmk[0] * rp[j] + P.pmk[1] * rn[j]) - rc[j]) * mu_r[j];
      float k_s = kc[j] + ((P.pmk[0] * kp[j] + P.pmk[1] * kn[j]) - kc[j]) * mu_k[j];
      float v_s = vc[j] + ((P.pmk[0] * vp[j] + P.pmk[1] * vn[j]) - vc[j]) * mu_v[j];
      float kk = k_s * kk_c[j] * P.psc[0];
      float a = ad4[j], wv = 1.f - wd4[j];
      o0[j] = -kk; o1[j] = wv * r_s; o2[j] = wv; o3[j] = kk * a; o4[j] = k_s * (1.f + (a - 1.f) * ka_c[j]); o5[j] = v_s;
    }
    float* d = bufp + sj * 64 + skq;
    *(float4*)(d + 0 * 1024) = make_float4(o0[0], o0[1], o0[2], o0[3]);
    *(float4*)(d + 1 * 1024) = make_float4(o1[0], o1[1], o1[2], o1[3]);
    *(float4*)(d + 2 * 1024) = make_float4(o2[0], o2[1], o2[2], o2[3]);
    *(float4*)(d + 3 * 1024) = make_float4(o3[0], o3[1], o3[2], o3[3]);
    *(float4*)(d + 4 * 1024) = make_float4(o4[0], o4[1], o4[2], o4[3]);
    *(float4*)(d + 5 * 1024) = make_float4(o5[0], o5[1], o5[2], o5[3]);
    if (skq == 0) *(float2*)(bufp + 6 * 1024 + sj * 2) = make_float2(P.psc[1], P.psc[2]);
  };
  float* sY = sm + 2 * BUF;
  const int prow16 = wid * 4 + rs;
  const int ysel = (kg == 0) ? prow16 : (512 + tid);
  struct RStep { f4v a4, wr4, w4, b4, k4; float vv; float2 sc; };
  auto lds_step = [&](const float* bf, int j) {
    RStep q;
    q.a4 = *(const f4v*)(bf + 0 * 1024 + j * 64 + 4 * kg);
    q.wr4 = *(const f4v*)(bf + 1 * 1024 + j * 64 + 4 * kg);
    q.w4 = *(const f4v*)(bf + 2 * 1024 + j * 64 + 4 * kg);
    q.b4 = *(const f4v*)(bf + 3 * 1024 + j * 64 + 4 * kg);
    q.k4 = *(const f4v*)(bf + 4 * 1024 + j * 64 + 4 * kg);
    q.vv = bf[5 * 1024 + j * 64 + row];
    q.sc = *(const float2*)(bf + 6 * 1024 + j * 2);
    return q;
  };
  auto flush = [&](int c) {
    {
      int j = tid >> 4, rr = tid & 15;
      int ii = pos2i(c * 16 + j, dir);
      yout[((size_t)b * TPB + ii) * 512 + hd * 64 + rq * 16 + rr] = f2bf(sY[(c & 1) * 256 + j * 16 + rr]);
    }
  };
  __syncthreads();
  load(0, PA);
  stage(PA, sm);
  load(1, PB);
  __syncthreads();
  const int NCH = TPB / 16;
  auto run_chunk = [&](int c, const float* bf, float* sy) {
    flush(max(c - 1, 0));
    RStep cur = lds_step(bf, 0);
#pragma unroll
    for (int j = 0; j < 16; ++j) {
      RStep nxt = cur;
      if (j + 1 < 16) nxt = lds_step(bf, j + 1);
      f2v sa2 = SA * cur.a4.xy + SB * cur.a4.zw;
      f2v yp2 = SA * cur.wr4.xy + SB * cur.wr4.zw;
      float sa = sa2.x + sa2.y, yp = yp2.x + yp2.y;
      sa = row16_sum(sa); yp = row16_sum(yp);
      float y = yp + sa * cur.sc.x + cur.vv * cur.sc.y;
      SA = SA * cur.w4.xy + (sa * cur.b4.xy + cur.vv * cur.k4.xy);
      SB = SB * cur.w4.zw + (sa * cur.b4.zw + cur.vv * cur.k4.zw);
      sy[(kg == 0 ? j * 16 : 0) + ysel - (c & 1) * 0] = y;
      cur = nxt;
    }
  };
  for (int c = 0; c < NCH; c += 2) {
    load(min(c + 2, NCH - 1), PA);
    run_chunk(c, sm, sY);
    stage(PB, sm + BUF);
    __syncthreads();
    load(min(c + 3, NCH - 1), PB);
    run_chunk(c + 1, sm + BUF, sY + 256);
    stage(PA, sm);
    __syncthreads();
  }
  flush(NCH - 1);
}

DI void mamba_scan(CP p, const Ptrs& w, int l, int item, float* sm) {
  const int tid = TIDX, lane = tid & 63, wid = tid >> 6;
  const int chain = item >> 2, pq = item & 3, b = chain >> 4, hd = (chain >> 1) & 7, dir = chain & 1, gp = hd >> 2;
  const float* cw = p.in[21] + l * 3 * 1024;
  const float* cbv = p.in[22] + l * 1024;
  const int n_ = tid & 127, jh = tid >> 7;
  const int chB = 512 + gp * 128 + n_, chC = 768 + gp * 128 + n_;
  const float wB0 = cw[chB], wB1 = cw[1024 + chB], wB2 = cw[2048 + chB], bB = cbv[chB];
  const float wC0 = cw[chC], wC1 = cw[1024 + chC], wC2 = cw[2048 + chC], bC = cbv[chC];
  const int xj = tid >> 4, xp = tid & 15, chX = hd * 64 + pq * 16 + xp;
  const float wX0 = cw[chX], wX1 = cw[1024 + chX], wX2 = cw[2048 + chX], bX = cbv[chX];
  const float dtb = p.in[23][(l * 2 + dir) * 8 + hd];
  const float Aneg = -__expf(p.in[24][(l * 2 + dir) * 8 + hd]);
  const float Dsk = dir == 0 ? p.in[25][l * 8 + hd] : 0.f;
  bf16_t* yout = w.R2 + (size_t)(2 + dir) * T * 512;
  constexpr int BUF = 2 * 2048 + 256 + 256 + 64;
  const int ng = lane & 15, rs = lane >> 4, prow = wid * 4 + rs;
  f2v M0 = {0.f, 0.f}, M1 = {0.f, 0.f}, M2 = {0.f, 0.f}, M3 = {0.f, 0.f};
  struct MPre { uint4 pbq[2]; bf16_t px[3]; float pdt[3], pxm[2]; };
  MPre PA, PB;
  const bf16_t* mbc = w.W1;
  auto load = [&](int c, MPre& P) {
#pragma unroll
    for (int i = 0; i < 2; ++i) {
      int idx = tid + 256 * i, j = idx >> 5, q = idx & 31;
      int ii = pos2i(c * 16 + j, dir);
      P.pbq[i] = *(const uint4*)(mbc + ((size_t)b * TPB + ii) * 512 + (q < 16 ? 0 : 256) + gp * 128 + (q & 15) * 8);
    }
    {
      int pos = c * 16 + xj, ii = pos2i(pos, dir);
      size_t tok = (size_t)b * TPB + ii;
      const bf16_t* prw = w.pC + tok * SPC;
      bool hp = (ii != 0) && (ii != CTXL), hn = (ii != CTXL - 1) && (ii != TPB - 1);
      P.px[0] = prw[chX + (hp ? -SPC : 0)]; P.px[1] = prw[chX]; P.px[2] = prw[chX + (hn ? SPC : 0)];
      P.pxm[0] = hp ? 1.f : 0.f; P.pxm[1] = hn ? 1.f : 0.f;
      float2 dd = *(const float2*)(w.mdt + (tok * 16 + dir * 8 + hd) * 2);
      P.pdt[0] = dd.x; P.pdt[1] = dd.y; P.pdt[2] = w.mcb[tok * 2 + gp];
    }
  };
  auto stage = [&](const MPre& P, float* bufp) {
#pragma unroll
    for (int i = 0; i < 2; ++i) {
      int idx = tid + 256 * i, j = idx >> 5, q = idx & 31;
      float f[8];
      unpack8(P.pbq[i], f);
      float* d = bufp + (q < 16 ? 0 : 2048) + j * 128 + (q & 15) * 8;
      *(float4*)d = make_float4(f[0], f[1], f[2], f[3]);
      *(float4*)(d + 4) = make_float4(f[4], f[5], f[6], f[7]);
    }
    {
      float xs = siluf(wX0 * P.pxm[0] * bf2f(P.px[0]) + wX1 * bf2f(P.px[1]) + wX2 * P.pxm[1] * bf2f(P.px[2]) + bX);
      bufp[4096 + xj * 16 + xp] = xs * P.pdt[0];
      bufp[4096 + 256 + xj * 16 + xp] = Dsk * xs;
      if (xp == 0) *(float4*)(bufp + 4096 + 512 + xj * 4) = make_float4(P.pdt[1], P.pdt[2], 0.f, 0.f);
    }
  };
  float* sY = sm + 2 * BUF;
  const int ysel = (ng == 0) ? prow : (512 + tid);
  struct MStep { f4v B0, B1, C0, C1; float xq, ds; float4 sc; };
  auto lds_step = [&](const float* bf, int j) {
    MStep q;
    q.B0 = *(const f4v*)(bf + j * 128 + 8 * ng); q.B1 = *(const f4v*)(bf + j * 128 + 8 * ng + 4);
    q.C0 = *(const f4v*)(bf + 2048 + j * 128 + 8 * ng); q.C1 = *(const f4v*)(bf + 2048 + j * 128 + 8 * ng + 4);
    q.xq = bf[4096 + j * 16 + prow]; q.ds = bf[4096 + 256 + j * 16 + prow];
    q.sc = *(const float4*)(bf + 4096 + 512 + j * 4);
    return q;
  };
  auto flush = [&](int c) {
    {
      int j = tid >> 4, rr = tid & 15;
      int ii = pos2i(c * 16 + j, dir);
      yout[((size_t)b * TPB + ii) * 512 + hd * 64 + pq * 16 + rr] = f2bf(sY[(c & 1) * 256 + j * 16 + rr]);
    }
  };
  __syncthreads();
  load(0, PA);
  stage(PA, sm);
  load(1, PB);
  __syncthreads();
  const int NCH = TPB / 16;
  auto run_chunk = [&](int c, const float* bf, float* sy) {
    flush(max(c - 1, 0));
    MStep cur = lds_step(bf, 0);
#pragma unroll
    for (int j = 0; j < 16; ++j) {
      MStep nxt = cur;
      if (j + 1 < 16) nxt = lds_step(bf, j + 1);
      f2v ya = M0 * cur.C0.xy + M1 * cur.C0.zw, yb = M2 * cur.C1.xy + M3 * cur.C1.zw;
      ya += yb;
      float yp = row16_sum(ya.x + ya.y);
      float y = cur.sc.x * yp + cur.xq * cur.sc.y + cur.ds;
      const float dA = cur.sc.x, xq = cur.xq;
      M0 = M0 * dA + xq * cur.B0.xy; M1 = M1 * dA + xq * cur.B0.zw;
      M2 = M2 * dA + xq * cur.B1.xy; M3 = M3 * dA + xq * cur.B1.zw;
      sy[(ng == 0 ? j * 16 : 0) + ysel] = y;
      cur = nxt;
    }
  };
  for (int c = 0; c < NCH; c += 2) {
    load(min(c + 2, NCH - 1), PA);
    run_chunk(c, sm, sY);
    stage(PB, sm + BUF);
    __syncthreads();
    load(min(c + 3, NCH - 1), PB);
    run_chunk(c + 1, sm + BUF, sY + 256);
    stage(PA, sm);
    __syncthreads();
  }
  flush(NCH - 1);
}

DI void da_block(CP p, const Ptrs& w, int l, int b, int q0, int nkeys, int hd, bf16_t* sK, bf16_t* sV, float* smf, bf16_t* obase) {
  const int tid = TIDX, lane = tid & 63, wid = tid >> 6, r = lane & 31, h = lane >> 5;
  const int qb = wid >> 1, c = wid & 1;
  const size_t tokq = (size_t)b * TPB + q0 + qb * 32 + r;
  const bf16_t* qp = w.pD + tokq * SPD + hd * 128 + c * 64;
  bf16x8 Q0 = *(const bf16x8*)(qp + 0 * 16 + h * 8), Q1 = *(const bf16x8*)(qp + 1 * 16 + h * 8);
  bf16x8 Q2 = *(const bf16x8*)(qp + 2 * 16 + h * 8), Q3 = *(const bf16x8*)(qp + 3 * 16 + h * 8);
  const float mq = wave_max(fabsf(p.in[27][l * 64 + lane])), mk = wave_max(fabsf(p.in[28][l * 64 + lane]));
  const float Mb = 8.f * LOG2E * mq * mk + 0.5f;
  const float lam_init = 0.8f - 0.6f * __expf(-0.3f * (float)l);
  const float lam = __expf(wave_sum(p.in[29][l * 64 + lane] * p.in[30][l * 64 + lane])) - __expf(wave_sum(p.in[31][l * 64 + lane] * p.in[32][l * 64 + lane])) + lam_init;
  f32x16 O0, O1, O2, O3;
#pragma unroll
  for (int i = 0; i < 16; ++i) { O0[i] = 0.f; O1[i] = 0.f; O2[i] = 0.f; O3[i] = 0.f; }
  float ls = 0.f;
  const bf16_t* kbase = w.pD + (size_t)b * TPB * SPD + 512 + hd * 128;
  const bf16_t* vbase = w.VtD + (size_t)(b * 512 + hd * 128) * TPB;
  const int kkey = tid >> 4, kch = tid & 15, ve = tid >> 3, vch = tid & 7;
  const bf16_t* kg_ = kbase + (size_t)kkey * SPD + kch * 8;
  const bf16_t* vg_ = vbase + (size_t)ve * TPB + vch * 8;
  uint4 pk0, pk1, pk2, pk3, pv0, pv1, pv2, pv3;
#define DA_GLOAD(k0_) { const bf16_t* a_ = kg_ + (size_t)(k0_) * SPD; const bf16_t* b_ = vg_ + (k0_); \
    pk0 = *(const uint4*)(a_); pk1 = *(const uint4*)(a_ + (size_t)16 * SPD); pk2 = *(const uint4*)(a_ + (size_t)32 * SPD); pk3 = *(const uint4*)(a_ + (size_t)48 * SPD); \
    pv0 = *(const uint4*)(b_); pv1 = *(const uint4*)(b_ + (size_t)32 * TPB); pv2 = *(const uint4*)(b_ + (size_t)64 * TPB); pv3 = *(const uint4*)(b_ + (size_t)96 * TPB); }
  constexpr int DA_BUF = 64 * 136 + 128 * 72;
#define DA_STORE(bufi) { bf16_t* k_ = sK + (bufi) * DA_BUF; bf16_t* v_ = sV + (bufi) * DA_BUF; \
    *(uint4*)(k_ + (kkey) * 136 + kch * 8) = pk0; *(uint4*)(k_ + (kkey + 16) * 136 + kch * 8) = pk1; \
    *(uint4*)(k_ + (kkey + 32) * 136 + kch * 8) = pk2; *(uint4*)(k_ + (kkey + 48) * 136 + kch * 8) = pk3; \
    *(uint4*)(v_ + (ve) * 72 + vch * 8) = pv0; *(uint4*)(v_ + (ve + 32) * 72 + vch * 8) = pv1; \
    *(uint4*)(v_ + (ve + 64) * 72 + vch * 8) = pv2; *(uint4*)(v_ + (ve + 96) * 72 + vch * 8) = pv3; }
  DA_GLOAD(0)
  __syncthreads();
  DA_STORE(0)
  if (64 < nkeys) DA_GLOAD(64)
  __syncthreads();
  for (int k0 = 0; k0 < nkeys; k0 += 64) {
    const int cb_ = (k0 >> 6) & 1;
    const bf16_t* sKc = sK + cb_ * DA_BUF;
    const bf16_t* sVc = sV + cb_ * DA_BUF;
#pragma unroll
    for (int sub = 0; sub < 2; ++sub) {
      f32x16 S;
#pragma unroll
      for (int i = 0; i < 16; ++i) S[i] = -Mb;
      const bf16_t* kp = sKc + (sub * 32 + r) * 136 + c * 64 + h * 8;
      S = MFMA(*(const bf16x8*)(kp), Q0, S);
      S = MFMA(*(const bf16x8*)(kp + 16), Q1, S);
      S = MFMA(*(const bf16x8*)(kp + 32), Q2, S);
      S = MFMA(*(const bf16x8*)(kp + 48), Q3, S);
#pragma unroll
      for (int i = 0; i < 16; ++i) { S[i] = __builtin_amdgcn_exp2f(S[i]); ls += S[i]; }
      bf16x8 P0, P1;
      P0 = pack8_mfma(S[0], S[1], S[2], S[3], S[4], S[5], S[6], S[7]);
      P1 = pack8_mfma(S[8], S[9], S[10], S[11], S[12], S[13], S[14], S[15]);
#define DA_PV(OX, et)                                                                                   \
      {                                                                                                 \
        const bf16_t* vp = sVc + ((et) * 32 + r) * 72 + sub * 32 + 4 * h;                               \
        s16x4 lo = *(const s16x4*)vp, hi = *(const s16x4*)(vp + 8);                                     \
        s16x4 lo2 = *(const s16x4*)(vp + 16), hi2 = *(const s16x4*)(vp + 24);                           \
        OX = MFMA(__builtin_shufflevector(lo, hi, 0, 1, 2, 3, 4, 5, 6, 7), P0, OX);                     \
        OX = MFMA(__builtin_shufflevector(lo2, hi2, 0, 1, 2, 3, 4, 5, 6, 7), P1, OX);                   \
      }
      DA_PV(O0, 0) DA_PV(O1, 1) DA_PV(O2, 2) DA_PV(O3, 3)
#undef DA_PV
    }
    if (k0 + 64 < nkeys) {
      DA_STORE(cb_ ^ 1)
      if (k0 + 128 < nkeys) DA_GLOAD(k0 + 128)
    }
    __syncthreads();
  }
#undef DA_STORE
  ls += __shfl_xor(ls, 32);
  const float scl = c == 0 ? 1.f / ls : lam / ls;
#pragma unroll
  for (int i = 0; i < 16; ++i) { O0[i] *= scl; O1[i] *= scl; O2[i] *= scl; O3[i] *= scl; }
  __syncthreads();
  float* xb = smf + qb * 4096;
  if (c == 1) {
#pragma unroll
    for (int i = 0; i < 16; ++i) {
      int e = crow(i, h);
      xb[(e) * 32 + r] = O0[i]; xb[(32 + e) * 32 + r] = O1[i]; xb[(64 + e) * 32 + r] = O2[i]; xb[(96 + e) * 32 + r] = O3[i];
    }
  }
  __syncthreads();
  if (c == 0) {
    float ss = 0.f;
#pragma unroll
    for (int i = 0; i < 16; ++i) {
      int e = crow(i, h);
      O0[i] -= xb[(e) * 32 + r]; O1[i] -= xb[(32 + e) * 32 + r]; O2[i] -= xb[(64 + e) * 32 + r]; O3[i] -= xb[(96 + e) * 32 + r];
      ss += O0[i] * O0[i] + O1[i] * O1[i] + O2[i] * O2[i] + O3[i] * O3[i];
    }
    ss += __shfl_xor(ss, 32);
    const float inv = rsqrtf(ss * (1.f / 128.f) + 1e-6f) * (1.f - lam_init);
    const float* sub_w = p.in[33] + l * 128;
    const bf16_t* gp_ = w.pD + tokq * SPD + 1024 + hd * 128;
    bf16_t* op = obase + tokq * SPD + hd * 128;
#define DA_ST(OX, et)                                                                                   \
    _Pragma("unroll") for (int g = 0; g < 4; ++g) {                                                     \
      int e0 = (et) * 32 + 8 * g + 4 * h;                                                               \
      uint2 gg = *(const uint2*)(gp_ + e0);                                                             \
      float4 sw = *(const float4*)(sub_w + e0);                                                         \
      float g0 = bf2f((bf16_t)(gg.x & 0xffff)), g1 = bf2f((bf16_t)(gg.x >> 16)), g2 = bf2f((bf16_t)(gg.y & 0xffff)), g3 = bf2f((bf16_t)(gg.y >> 16)); \
      float o0 = OX[4 * g] * inv * sw.x * siluf(g0), o1 = OX[4 * g + 1] * inv * sw.y * siluf(g1);       \
      float o2 = OX[4 * g + 2] * inv * sw.z * siluf(g2), o3 = OX[4 * g + 3] * inv * sw.w * siluf(g3);   \
      *(uint2*)(op + e0) = make_uint2(pack2(o0, o1), pack2(o2, o3));                                    \
    }
    DA_ST(O0, 0) DA_ST(O1, 1) DA_ST(O2, 2) DA_ST(O3, 3)
#undef DA_ST
  }
}

DI void na_wave(CP p, const Ptrs& w, int l, int witem, bool ctxq, bf16_t* obase) {
  const int lane = TIDX & 63, r = lane & 31, h = lane >> 5;
  int b, hd, qi, gr0 = 0, cq = 0, qrow = 0, qcol = 0;
  if (!ctxq) {
    hd = witem & 7; cq = (witem >> 3) & 3; gr0 = ((witem >> 5) & 63) * 2; b = witem >> 11;
    qrow = gr0 + (r >> 4); qcol = cq * 16 + (r & 15); qi = CTXL + qrow * 64 + qcol;
  } else { hd = witem & 7; int qt = (witem >> 3) & 7; b = witem >> 6; qi = qt * 32 + r; }
  const size_t tokq = (size_t)b * TPB + qi;
  const bf16_t* qp = w.pA + tokq * SPA + hd * 64;
  bf16x8 Q[4];
#pragma unroll
  for (int s = 0; s < 4; ++s) Q[s] = *(const bf16x8*)(qp + s * 16 + h * 8);
  const float mq = wave_max(fabsf(p.in[8][l * 64 + lane])), mk = wave_max(fabsf(p.in[9][l * 64 + lane]));
  const float* rpb = p.in[10] + (size_t)(l * 8 + hd) * 15 * 31;
  float mb = 0.f;
  for (int e = lane; e < 465; e += 64) mb = fmaxf(mb, fabsf(rpb[e]));
  mb = wave_max(mb);
  const float Mb = 8.f * LOG2E * mq * mk + mb * LOG2E + 0.5f;
  f32x16 O[2];
#pragma unroll
  for (int e = 0; e < 2; ++e)
#pragma unroll
    for (int i = 0; i < 16; ++i) O[e][i] = 0.f;
  float ls = 0.f;
  const bf16_t* kbase = w.pA + (size_t)b * TPB * SPA + 512 + hd * 64;
  const bf16_t* vbase = w.VtA + (size_t)(b * 512 + hd * 64) * TPB;
  const int r0q = min(max(qrow - 4, 0), 120);
  const int c0 = min(max(qcol - 8, 0), 48);
  const int kr_lo = min(max(gr0 - 4, 0), 120), kr_hi = min(max(gr0 - 3, 0), 120) + 8;
  const int kc0 = min(max(cq * 16 - 8, 0), 32);
  const int ntile = ctxq ? 8 : 8 + (kr_hi - kr_lo);
  auto kidx = [&](int t) { return t < 8 ? t * 32 : CTXL + (kr_lo + (t - 8)) * 64 + kc0; };
  bf16x8 nK0, nK1, nK2, nK3;
  s16x4 nV[8];
#define NA_LOAD(t_) { const int ki_ = kidx(t_); const bf16_t* kp_ = kbase + (size_t)(ki_ + r) * SPA + h * 8; \
    nK0 = *(const bf16x8*)(kp_); nK1 = *(const bf16x8*)(kp_ + 16); nK2 = *(const bf16x8*)(kp_ + 32); nK3 = *(const bf16x8*)(kp_ + 48); \
    _Pragma("unroll") for (int et = 0; et < 2; ++et) _Pragma("unroll") for (int s2 = 0; s2 < 2; ++s2) { \
      const bf16_t* vp_ = vbase + (size_t)(et * 32 + r) * TPB + ki_ + s2 * 16 + 4 * h; \
      nV[(et * 2 + s2) * 2] = *(const s16x4*)vp_; nV[(et * 2 + s2) * 2 + 1] = *(const s16x4*)(vp_ + 8); } }
  NA_LOAD(0)
  for (int t = 0; t < ntile; ++t) {
    bool local = t >= 8;
    const int kr = kr_lo + (t - 8);
    bf16x8 cK0 = nK0, cK1 = nK1, cK2 = nK2, cK3 = nK3;
    s16x4 cV[8];
#pragma unroll
    for (int i = 0; i < 8; ++i) cV[i] = nV[i];
    if (t + 1 < ntile) NA_LOAD(t + 1)
    f32x16 S;
#pragma unroll
    for (int i = 0; i < 16; ++i) S[i] = -Mb;
    S = MFMA(cK0, Q[0], S); S = MFMA(cK1, Q[1], S); S = MFMA(cK2, Q[2], S); S = MFMA(cK3, Q[3], S);
    if (local) {
      const bool row_ok = (kr >= r0q) && (kr < r0q + 8);
      const float* rp = rpb + min(max(kr - qrow + 7, 0), 14) * 31;
#pragma unroll
      for (int i = 0; i < 16; ++i) {
        int kcol = kc0 + crow(i, h);
        bool ok = row_ok && (kcol >= c0) && (kcol < c0 + 16);
        int dc = min(max(kcol - qcol + 15, 0), 30);
        float bias = rp[dc] * LOG2E;
        S[i] = ok ? __builtin_amdgcn_exp2f(S[i] + bias) : 0.f;
      }
    } else {
#pragma unroll
      for (int i = 0; i < 16; ++i) S[i] = __builtin_amdgcn_exp2f(S[i]);
    }
    bf16x8 P[2];
#pragma unroll
    for (int i = 0; i < 16; ++i) ls += S[i];
#pragma unroll
    for (int s2 = 0; s2 < 2; ++s2) {
      P[s2] = pack8_mfma(S[8 * s2 + 0], S[8 * s2 + 1], S[8 * s2 + 2], S[8 * s2 + 3], S[8 * s2 + 4], S[8 * s2 + 5], S[8 * s2 + 6], S[8 * s2 + 7]);
    }
#pragma unroll
    for (int et = 0; et < 2; ++et)
#pragma unroll
      for (int s2 = 0; s2 < 2; ++s2) {
        bf16x8 vf = __builtin_shufflevector(cV[(et * 2 + s2) * 2], cV[(et * 2 + s2) * 2 + 1], 0, 1, 2, 3, 4, 5, 6, 7);
        O[et] = MFMA(vf, P[s2], O[et]);
      }
  }
#undef NA_LOAD
  ls += __shfl_xor(ls, 32);
  const float inv = 1.f / ls;
  const bf16_t* gp_ = w.pA + tokq * SPA + 1024 + hd * 64;
  bf16_t* op = obase + tokq * SPA + hd * 64;
#pragma unroll
  for (int et = 0; et < 2; ++et)
#pragma unroll
    for (int g = 0; g < 4; ++g) {
      int e0 = et * 32 + 8 * g + 4 * h;
      uint2 gg = *(const uint2*)(gp_ + e0);
      float g0 = bf2f((bf16_t)(gg.x & 0xffff)), g1 = bf2f((bf16_t)(gg.x >> 16)), g2 = bf2f((bf16_t)(gg.y & 0xffff)), g3 = bf2f((bf16_t)(gg.y >> 16));
      float o0 = O[et][4 * g] * inv * siluf(g0), o1 = O[et][4 * g + 1] * inv * siluf(g1);
      float o2 = O[et][4 * g + 2] * inv * siluf(g2), o3 = O[et][4 * g + 3] * inv * siluf(g3);
      *(uint2*)(op + e0) = make_uint2(pack2(o0, o1), pack2(o2, o3));
    }
}

template <int MM, int DUMMY = 0>
DI void phase_mixers(CP p, const Ptrs& w, int l, float* sm) {
  __shared__ int s_item;
  const bool ctxo = (l == 0);
  const int n_scan = (MM & 1) ? 256 : 0, n_da = (MM & 2) ? 1024 : 0, n_dac = ((MM & 2) && ctxo) ? 32 : 0;
  const int n_na = (MM & 4) ? 1024 : 0, n_nac = ((MM & 4) && ctxo) ? 32 : 0;
  const int total = n_scan + n_da + n_dac + n_na + n_nac;
  int* ctr = &w.ctr[l * 16 + MM + ((MM != 1) ? DUMMY * 8 : 0)];
  bf16_t* oD = DUMMY ? w.R1 : w.pD; bf16_t* oA = DUMMY ? w.R1 : w.pA;
  if constexpr (MM == 1 && DUMMY == 1) {
    __syncthreads();
    if (TIDX == 0) {
      unsigned hw = (unsigned)__builtin_amdgcn_s_getreg((31 << 11) | 4);
      unsigned key = ((hw >> 8) & 0xffu) | (xb_xcc_id() << 8);
      s_item = atomicAdd(&w.cuf[l * 4096 + key], 1);
    }
    __syncthreads();
    int first = s_item;
    if (first != 0) return;
  }
  for (;;) {
    __syncthreads();
    if (TIDX == 0) s_item = atomicAdd(ctr, 1);
    __syncthreads();
    int it = s_item;
    if (it >= total) break;
    if constexpr ((MM & 1) != 0) {
      if (it < 128) { __builtin_amdgcn_s_setprio(3); rwkv_scan(p, w, l, it, sm); __builtin_amdgcn_s_setprio(0); if (DUMMY) break; continue; }
      if (it < 256) { __builtin_amdgcn_s_setprio(3); mamba_scan(p, w, l, it - 128, sm); __builtin_amdgcn_s_setprio(0); if (DUMMY) break; continue; }
      it -= 256;
    }
    if constexpr ((MM & 2) != 0) {
      if (it < n_da) { int hd = it & 3, qt = (it >> 2) & 127, b = it >> 9; da_block(p, w, l, b, CTXL + qt * 64, TPB, hd, (bf16_t*)sm, (bf16_t*)sm + 64 * 136, sm, oD); continue; }
      it -= n_da;
      if (it < n_dac) { int hd = it & 3, qt = (it >> 2) & 3, b = it >> 4; da_block(p, w, l, b, qt * 64, CTXL, hd, (bf16_t*)sm, (bf16_t*)sm + 64 * 136, sm, oD); continue; }
      it -= n_dac;
    }
    if constexpr ((MM & 4) != 0) {
      if (it < n_na) { na_wave(p, w, l, it * 4 + (TIDX >> 6), false, oA); continue; }
      it -= n_na;
      na_wave(p, w, l, it * 4 + (TIDX >> 6), true, oA);
    }
  }
}

DI void phase_finish(CP p, const Ptrs& w, int l) {
  const int lane = TIDX & 63, gw = BIDX * 4 + (TIDX >> 6), nw = GDIM * 4;
  const int c0 = lane * 8, hd = lane >> 3;
  float lnw[8], lnb[8], muv[8], nrm[8];
#pragma unroll
  for (int j = 0; j < 8; ++j) { lnw[j] = p.in[19][l * 512 + c0 + j]; lnb[j] = p.in[20][l * 512 + c0 + j]; muv[j] = p.in[11][l * 1792 + 1024 + c0 + j]; nrm[j] = p.in[26][l * 512 + c0 + j]; }
  const bf16_t* yB0 = w.R2, *yB1 = w.R2 + (size_t)T * 512, *yM0 = w.R2 + (size_t)2 * T * 512, *yM1 = w.R2 + (size_t)3 * T * 512;
  for (int tok = gw; tok < T; tok += nw) {
    int b = tok / TPB, i = tok - b * TPB;
    if (l != 0 && i < CTXL) continue;
    bool hp = (i != 0) && (i != CTXL), hn = (i != CTXL - 1) && (i != TPB - 1);
    bf16_t* rb = w.pB + (size_t)tok * SPB;
    bf16_t* rc = w.pC + (size_t)tok * SPC + 1040;
    uint4 u0 = *(const uint4*)(yB0 + (size_t)tok * 512 + c0), u1 = *(const uint4*)(yB1 + (size_t)tok * 512 + c0);
    uint4 uv = *(const uint4*)(rb + 1024 + c0), up = make_uint4(0, 0, 0, 0), un = make_uint4(0, 0, 0, 0);
    if (hp) up = *(const uint4*)(rb + 1024 + c0 - SPB);
    if (hn) un = *(const uint4*)(rb + 1024 + c0 + SPB);
    uint4 ug = *(const uint4*)(rb + 1792 + c0);
    const float* bsc = w.bonus + ((size_t)tok * 8 + hd) * 8;
    float2 bon2 = make_float2(bsc[3], bsc[6]);
    uint4 m0 = *(const uint4*)(yM0 + (size_t)tok * 512 + c0), m1 = *(const uint4*)(yM1 + (size_t)tok * 512 + c0);
    uint4 uz = *(const uint4*)(rc + c0);
    float y[8], t[8], vv[8], vp[8], vn[8], g[8];
    unpack8(u0, y); unpack8(u1, t);
    float sm_ = 0.f;
#pragma unroll
    for (int j = 0; j < 8; ++j) { y[j] += t[j]; sm_ += y[j]; }
    float mean = row8_sum(sm_) * (1.f / 64.f);
    float vs = 0.f;
#pragma unroll
    for (int j = 0; j < 8; ++j) { y[j] -= mean; vs += y[j] * y[j]; }
    float rstd = rsqrtf(row8_sum(vs) * (1.f / 64.f) + 64e-5f);
    unpack8(uv, vv); unpack8(up, vp); unpack8(un, vn); unpack8(ug, g);
    float bon = bon2.x + bon2.y;
#pragma unroll
    for (int j = 0; j < 8; ++j) {
      float yn = y[j] * rstd * lnw[j] + lnb[j];
      float v_s = vv[j] + (0.5f * (vp[j] + vn[j]) - vv[j]) * muv[j];
      t[j] = (yn + bon * v_s) * siluf(g[j]);
    }
    *(uint4*)(rb + 1792 + c0) = pack8(t);
    unpack8(m0, y); unpack8(m1, t); unpack8(uz, g);
    float ss = 0.f;
#pragma unroll
    for (int j = 0; j < 8; ++j) { y[j] = (y[j] + t[j]) * siluf(g[j]); ss += y[j] * y[j]; }
    ss = row16_sum(ss); ss += __shfl_xor(ss, 16);
    float inv = rsqrtf(ss * (1.f / 256.f) + 1e-6f);
#pragma unroll
    for (int j = 0; j < 8; ++j) t[j] = y[j] * inv * nrm[j];
    *(uint4*)(rc + c0) = pack8(t);
  }
}

DI void phase_merge(CP p, const Ptrs& w, int l, bf16_t* sA, bf16_t* sB, unsigned* sU) {
  const int tid = TIDX, lane = tid & 63, wid = tid >> 6, wm = wid >> 1, wn = wid & 1, r = lane & 31, h = lane >> 5;
  const bf16_t* gate_t = (const bf16_t*)((const char*)w.R1 + R1_GATE);
  const bf16_t* up_t = (const bf16_t*)((const char*)w.R1 + R1_UP);
  const int nmt = l == 0 ? 132 : 128;
  const int nrounds = tile_rounds(nmt, 16);
  for (int kk = 0; kk < nrounds; ++kk) {
    int mt, nt;
    if (!tile_map(kk, nmt, 16, mt, nt)) continue;
    if (l != 0) mt += mt < 64 ? 2 : 4;
    int m0 = mt * 128, n0 = nt * 128;
    unsigned totp[2][2][8];
#pragma unroll
    for (int a = 0; a < 2; ++a)
#pragma unroll
      for (int c = 0; c < 2; ++c)
#pragma unroll
        for (int i = 0; i < 8; ++i) totp[a][c][i] = 0u;
#pragma unroll 1
    for (int br = 0; br < 4; ++br) {
      const bf16_t* ys; int lds_;
      if (br == 0) { ys = w.pA; lds_ = SPA; } else if (br == 1) { ys = w.pB + 1792; lds_ = SPB; } else if (br == 2) { ys = w.pC + 1040; lds_ = SPC; } else { ys = w.pD; lds_ = SPD; }
      {
        f32x16 U[2][2];
        zero_acc(U);
        gemm_128(ys + (size_t)m0 * lds_, lds_, up_t + (size_t)(br * 2048 + n0) * 512, 512, 512, U, sA, sB);
#pragma unroll
        for (int a = 0; a < 2; ++a)
#pragma unroll
          for (int c = 0; c < 2; ++c)
#pragma unroll
            for (int i = 0; i < 8; ++i) sU[((a * 2 + c) * 8 + i) * 256 + tid] = pack2(U[a][c][2 * i], U[a][c][2 * i + 1]);
      }
      f32x16 G[2][2];
      zero_acc(G);
      gemm_128_2set(w.H + (size_t)m0 * 2048, 2048, gate_t + (size_t)(br * 2048 + n0) * 2048, 2048, 2048, G, sA, sB);
#pragma unroll
      for (int a = 0; a < 2; ++a)
#pragma unroll
        for (int c = 0; c < 2; ++c)
#pragma unroll
          for (int i = 0; i < 8; ++i) {
            unsigned uv = sU[((a * 2 + c) * 8 + i) * 256 + tid];
            float u0 = __uint_as_float(uv << 16), u1 = __uint_as_float(uv & 0xffff0000u);
            const unsigned tv = totp[a][c][i];
            float t0 = __uint_as_float(tv << 16) + sigmf(G[a][c][2 * i]) * u0;
            float t1 = __uint_as_float(tv & 0xffff0000u) + sigmf(G[a][c][2 * i + 1]) * u1;
            totp[a][c][i] = pack2(t0, t1);
          }
    }
    bf16_t* dst = w.R2;
#pragma unroll
    for (int mi = 0; mi < 2; ++mi)
#pragma unroll
      for (int ni = 0; ni < 2; ++ni)
#pragma unroll
        for (int i = 0; i < 16; ++i) {
          int row = m0 + wm * 64 + mi * 32 + crow(i, h), col = n0 + wn * 64 + ni * 32 + r;
          const unsigned tv = totp[mi][ni][i >> 1];
          dst[(size_t)row * 2048 + col] = (bf16_t)((i & 1) ? (tv >> 16) : (tv & 0xffffu));
        }
  }
}

DI void phase_out(CP p, const Ptrs& w, int l, bf16_t* sA, bf16_t* sB) {
  const int tid = TIDX, lane = tid & 63, wid = tid >> 6, wm = wid >> 1, wn = wid & 1, r = lane & 31, h = lane >> 5;
  const bf16_t* out_t = (const bf16_t*)((const char*)w.R1 + R1_OUT);
  const int nmt = l == 0 ? 132 : 128;
  const int nrounds = tile_rounds(nmt, 16);
  for (int kk = 0; kk < nrounds; ++kk) {
    int mt, nt;
    if (!tile_map(kk, nmt, 16, mt, nt)) continue;
    if (l != 0) mt += mt < 64 ? 2 : 4;
    int m0 = mt * 128, n0 = nt * 128;
    int b = m0 / TPB, ib = m0 - b * TPB;
    bool isctx = ib < CTXL;
    f32x16 acc[2][2];
    zero_acc(acc);
    gemm_128_deep(w.R2 + (size_t)m0 * 2048, 2048, out_t + (size_t)n0 * 2048, 2048, 2048, acc, sA, sB);
    const float* gate = w.mod + (l * 3 + (isctx ? 2 : b)) * 6144 + 4096;
#pragma unroll
    for (int mi = 0; mi < 2; ++mi)
#pragma unroll
      for (int ni = 0; ni < 2; ++ni) {
        int col = n0 + wn * 64 + ni * 32 + r;
        float gt = gate[col];
#pragma unroll
        for (int i = 0; i < 16; ++i) {
          int ii = ib + wm * 64 + mi * 32 + crow(i, h);
          const float* src = xrow(p, w, l, b * TPB + ii);
          float* dstp = isctx ? w.xc1 + (size_t)(b * CTXL + ii) * DM : p.out + (size_t)(b * 8192 + ii - CTXL) * DM;
          dstp[col] = src[col] + gt * acc[mi][ni][i];
        }
      }
  }
}

constexpr int SMEM_BYTES = 4 * 128 * 72 * 2;
constexpr int NPH = 18;
#ifndef ONE_LAUNCH
#define ONE_LAUNCH 1
#endif
#ifndef PHMASK
#define PHMASK 0x1ff
#endif

template <int SP>
DI void run_phase(int l, char* smem_raw) {
  CP p = launder_params();
  const Ptrs w = mkptrs(p.ws);
  float* smf = (float*)smem_raw;
  bf16_t* sA = (bf16_t*)smem_raw;
  bf16_t* sB = sA + 128 * 72;
  if constexpr (SP == 0) {
    if (l == 0) {
      if (BIDX == 0 && TIDX < 64) w.ctr[TIDX] = 0;
      if (BIDX >= 2 && BIDX < 34) w.cuf[(BIDX - 2) * 256 + TIDX] = 0;
      if (BIDX == 1) for (int e = TIDX; e < 2048; e += 256) { float ang = (float)(e >> 4) * exp2f(-(float)(e & 15) * (13.287712379549449f / 16.f)); w.rope[2 * e] = cosf(ang); w.rope[2 * e + 1] = sinf(ang); }
      for (int it = BIDX; it < 384; it += GDIM) phase_ada_item(p, w, 0, it, 4, smf);
      conv_w1(p, w, 0, smf);
    }
    conv_w3(p, w, l, smf);
  } else if constexpr (SP == 1) phase_norm(p, w, l);
  else if constexpr (SP == 2) phase_inproj(p, w, l, sA, sB);
  else if constexpr (SP == 3) {
    phase_prep(p, w, l);
  } else if constexpr (SP == 4) phase_lora(p, w, l, sA, sB);
  else if constexpr (SP == 5) phase_mixers<1>(p, w, l, smf);
  else if constexpr (SP == 9) phase_mixers<2>(p, w, l, smf);
  else if constexpr (SP == 10) phase_mixers<4>(p, w, l, smf);
  else if constexpr (SP == 13) phase_rwscal(p, w, l);
  else if constexpr (SP == 14) phase_mixers<1, 1>(p, w, l, smf);
  else if constexpr (SP == 11) phase_mixers<2, 1>(p, w, l, smf);
  else if constexpr (SP == 12) phase_mixers<4, 1>(p, w, l, smf);
  else if constexpr (SP == 6) {
    conv_w2(p, w, l, smf);
    if (l + 1 < 2) conv_w1(p, w, l + 1, smf);
    phase_finish(p, w, l);
  } else if constexpr (SP == 7) phase_merge(p, w, l, sA, sB, (unsigned*)(smem_raw + 2 * 128 * 72 * 2));
  else phase_out(p, w, l, sA, sB);
}

template <int SP>
__global__ void __launch_bounds__(256, 2) phase_kernel(Params p, int l) {
  __shared__ __attribute__((aligned(16))) char smem_raw[SMEM_BYTES];
  run_phase<SP>(l, smem_raw);
}

template <int SP>
__device__ __attribute__((noinline)) void run_phase_ni(int l, char* smem_raw) {
  run_phase<SP>(l, smem_raw);
}
#ifndef CMASK
#define CMASK 0x7fff
#endif
#ifndef DUPMASK
#define DUPMASK 0
#endif
#define RUNP(k) if ((CMASK & (1 << k)) && (pmask & (1 << k))) { run_phase<k>(RP_ARGS); if ((DUPMASK & (1 << k)) && (k != 8 || l == 0)) { xcd_barrier(xb); run_phase<k>(RP_ARGS); } }
#ifdef NOINL
#define run_phase run_phase_ni
#define RP_ARGS l, smem_raw
#else
#define RP_ARGS l, smem_raw
#endif
__global__ void __launch_bounds__(256, 2) fwd_kernel(Params p) {
  __shared__ __attribute__((aligned(16))) char smem_raw[SMEM_BYTES];
#if ONE_LAUNCH
  __shared__ uint4 xb_words;
  if (threadIdx.x == 0) xb_words = make_uint4(0u, 0u, 0u, 0u);
  __syncthreads();
  XcdBarrier xb = xcd_barrier_post((unsigned*)(launder_params().ws + OFF_BAR), (volatile LAS unsigned*)&xb_words);
  const int lmask = launder_params().ph_lo, pmask = launder_params().ph_hi;
#ifdef PROBE_SYNC
  for (int q = 0; q < 50; ++q) xcd_barrier(xb);
#endif
  for (int l = 0; l < 2; ++l) {
    if (!((lmask >> l) & 1)) continue;
    RUNP(0); xcd_barrier(xb);
    if (lmask == 0x7fffffff) cg::this_grid().sync();
    RUNP(1); xcd_barrier(xb);
    RUNP(2); xcd_barrier(xb);
    RUNP(3); xcd_barrier(xb);
    RUNP(4); xcd_barrier(xb);
    RUNP(13); xcd_barrier(xb);
#ifndef SEQMIX
#define SEQMIX 0
#endif
    RUNP(14); if (SEQMIX) xcd_barrier(xb);
#ifdef PROBE_DA
    RUNP(11); xcd_barrier(xb);
#endif
#ifdef PROBE_NA
    RUNP(12); xcd_barrier(xb);
#endif
    RUNP(9); if (SEQMIX) xcd_barrier(xb); RUNP(10); RUNP(5); xcd_barrier(xb);
    RUNP(6); xcd_barrier(xb);
    RUNP(7); xcd_barrier(xb);
    RUNP(8); xcd_barrier(xb);
  }
#endif
}


extern "C" void kernel_launch(void* const* d_in, const int* in_sizes, int n_in, void* d_out, int out_size, void* d_ws, size_t ws_size, hipStream_t stream) {
  static int grid_blocks = 0;
  if (!grid_blocks) {
    int dev = 0, cus = 0, per_cu = 0;
    (void)hipGetDevice(&dev);
    (void)hipDeviceGetAttribute(&cus, hipDeviceAttributeMultiprocessorCount, dev);
    (void)hipOccupancyMaxActiveBlocksPerMultiprocessor(&per_cu, fwd_kernel, 256, 0);
    if (per_cu > 2) per_cu = 2;
    if (per_cu < 1) per_cu = 1;
    grid_blocks = cus * per_cu;
  }
  if (n_in < 37 || ws_size < WS_NEED) { fprintf(stderr, "bad args: n_in=%d ws=%zu need=%zu\n", n_in, ws_size, (size_t)WS_NEED); return; }
  Params p;
  memset(&p, 0, sizeof(p));
  for (int i = 0; i < 37; ++i) p.in[i] = (const float*)d_in[i];
  p.out = (float*)d_out;
  p.ws = (char*)d_ws;
#if ONE_LAUNCH
  p.ph_lo = 3; p.ph_hi = 0x7fff;
  (void)hipMemsetAsync((char*)d_ws + OFF_BAR, 0, XCD_BAR_WORDS * 4, stream);
  (void)hipMemsetAsync((char*)d_ws + OFF_MOD, 0, 3 * 6144 * 4, stream);
  void* args[] = {&p};
  hipError_t e = hipLaunchCooperativeKernel((void*)fwd_kernel, dim3(grid_blocks), dim3(256), args, 0, stream);
  if (e != hipSuccess) fprintf(stderr, "cooperative launch failed: %s (grid %d)\n", hipGetErrorString(e), grid_blocks);
#ifdef PROBE_EXTRA
  {
    (void)hipMemsetAsync((char*)d_ws + OFF_BAR, 0, XCD_BAR_WORDS * 4, stream);
    Params p2 = p; p2.ph_lo = 1; p2.ph_hi = PROBE_EXTRA;
    void* args2[] = {&p2};
    (void)hipLaunchCooperativeKernel((void*)fwd_kernel, dim3(grid_blocks), dim3(256), args2, 0, stream);
  }
#endif
#else
  for (int l = 0; l < 2; ++l) {
    hipLaunchKernelGGL(phase_kernel<0>, dim3(grid_blocks), dim3(256), 0, stream, p, l);
    hipLaunchKernelGGL(phase_kernel<1>, dim3(grid_blocks), dim3(256), 0, stream, p, l);
    hipLaunchKernelGGL(phase_kernel<2>, dim3(grid_blocks), dim3(256), 0, stream, p, l);
    hipLaunchKernelGGL(phase_kernel<3>, dim3(grid_blocks), dim3(256), 0, stream, p, l);
    hipLaunchKernelGGL(phase_kernel<4>, dim3(grid_blocks), dim3(256), 0, stream, p, l);
    hipLaunchKernelGGL(phase_kernel<5>, dim3(grid_blocks), dim3(256), 0, stream, p, l);
    hipLaunchKernelGGL(phase_kernel<9>, dim3(grid_blocks), dim3(256), 0, stream, p, l);
    hipLaunchKernelGGL(phase_kernel<10>, dim3(grid_blocks), dim3(256), 0, stream, p, l);
    hipLaunchKernelGGL(phase_kernel<6>, dim3(grid_blocks), dim3(256), 0, stream, p, l);
    hipLaunchKernelGGL(phase_kernel<7>, dim3(grid_blocks), dim3(256), 0, stream, p, l);
    hipLaunchKernelGGL(phase_kernel<8>, dim3(grid_blocks), dim3(256), 0, stream, p, l);
  }
#endif
}
```

```cpp
#include <hip/hip_runtime.h>
#include <hip/hip_cooperative_groups.h>
#include <stdint.h>
#include <cstdio>
#include <cstring>
namespace cg = cooperative_groups;

typedef unsigned short bf16_t;
typedef __attribute__((ext_vector_type(8))) short bf16x8;
typedef __attribute__((ext_vector_type(4))) short s16x4;
typedef __attribute__((ext_vector_type(16))) float f32x16;
typedef __attribute__((ext_vector_type(2))) float f2v;
typedef __attribute__((ext_vector_type(4))) float f4v;
#define DI __device__ __forceinline__
#define MFMA(a, b, c) __builtin_amdgcn_mfma_f32_32x32x16_bf16((a), (b), (c), 0, 0, 0)

constexpr int DM = 2048, TPB = 8448, T = 16896, CTXL = 256;
constexpr int SPA = 1536, SPB = 2304, SPC = 1664, SPD = 1536;
constexpr int NPAD = 8064;
constexpr float LOG2E = 1.4426950408889634f;
constexpr float QS = 0.125f * LOG2E;

constexpr size_t al256(size_t x) { return (x + 255) & ~(size_t)255; }
constexpr size_t OFF_MOD = 0;
constexpr size_t OFF_CTR = al256(OFF_MOD + 2 * 3 * 6144 * 4);
constexpr size_t OFF_BAR = al256(OFF_CTR + 256);
constexpr size_t OFF_CUF = al256(OFF_BAR + 3456 * 4);
constexpr size_t OFF_ROPE = al256(OFF_CUF + 2 * 4096 * 4);
constexpr size_t OFF_BONUS = al256(OFF_ROPE + 128 * 16 * 8);
constexpr size_t OFF_MDT = al256(OFF_BONUS + (size_t)T * 64 * 4);
constexpr size_t OFF_MCB = al256(OFF_MDT + (size_t)T * 32 * 4);
constexpr size_t OFF_W3 = al256(OFF_MCB + (size_t)T * 2 * 4);
constexpr size_t OFF_LA = al256(OFF_W3 + 4 * 512 * 64 * 2);
constexpr size_t OFF_XC1 = al256(OFF_LA + (size_t)T * 256 * 2);
constexpr size_t OFF_W1 = al256(OFF_XC1 + (size_t)2 * 256 * 2048 * 4);
constexpr size_t OFF_H = al256(OFF_W1 + (size_t)NPAD * 2048 * 2);
constexpr size_t OFF_PA = al256(OFF_H + (size_t)T * 2048 * 2);
constexpr size_t OFF_PB = al256(OFF_PA + (size_t)T * SPA * 2);
constexpr size_t OFF_PC = al256(OFF_PB + (size_t)T * SPB * 2);
constexpr size_t OFF_PD = al256(OFF_PC + (size_t)T * SPC * 2);
constexpr size_t OFF_VTA = al256(OFF_PD + (size_t)T * SPD * 2);
constexpr size_t OFF_VTD = al256(OFF_VTA + (size_t)2 * 512 * TPB * 2);
constexpr size_t OFF_R1 = al256(OFF_VTD + (size_t)2 * 512 * TPB * 2);
constexpr size_t OFF_R2 = al256(OFF_R1 + (size_t)4 * T * 512 * 2);
constexpr size_t WS_NEED = al256(OFF_R2 + (size_t)4 * T * 512 * 2);
constexpr size_t R1_GATE = 0, R1_UP = (size_t)4 * 2048 * 2048 * 2, R1_OUT = R1_UP + (size_t)4 * 2048 * 512 * 2;

struct Params {
  const float* in[37];
  float* out;
  char* ws;
  int ph_lo, ph_hi;
};


typedef const __attribute__((address_space(4))) Params& CP;
DI int ltid() { int t = threadIdx.x; asm volatile("" : "+v"(t)); return t; }
DI int lbid() { int t = blockIdx.x; asm volatile("" : "+s"(t)); return t; }
DI int lgdim() { int t = gridDim.x; asm volatile("" : "+s"(t)); return t; }
#define TIDX ltid()
#define BIDX lbid()
#define GDIM lgdim()
DI CP launder_params() {
  auto kp = __builtin_amdgcn_kernarg_segment_ptr();
  asm volatile("" : "+s"(kp));
  return *(const __attribute__((address_space(4))) Params*)kp;
}


#define XB_TMO      128
#define XB_XCNT(j)  (256  + 64 * (j))
#define XB_XSUB(j)  (1280 + 64 * (j))
#define XB_XGEN(j)  (2304 + 64 * (j))
#define XB_TOP      3328
#define XB_TOPGEN   3392
#define XCD_BAR_WORDS 3456
#define XB_SPIN_CAP (1u << 22)
#define LAS __attribute__((address_space(3)))
DI unsigned xb_ld(unsigned* p) { return __hip_atomic_load(p, __ATOMIC_RELAXED, __HIP_MEMORY_SCOPE_AGENT); }
DI unsigned xb_add(unsigned* p, unsigned v) { return __hip_atomic_fetch_add(p, v, __ATOMIC_RELAXED, __HIP_MEMORY_SCOPE_AGENT); }
DI unsigned xb_xcc_id() { return (unsigned)__builtin_amdgcn_s_getreg((3 << 11) | 20) & 0xFu; }
#define XB_SPIN(cond, bar) do { unsigned _sp = 0; while (cond) { __builtin_amdgcn_s_sleep(1); \
    if ((++_sp & 255u) == 0u) { if (xb_ld(&(bar)[XB_TMO])) break; if (_sp > XB_SPIN_CAP) { atomicAdd(&(bar)[XB_TMO], 1u); break; } } } } while (0)
struct XcdBarrier { unsigned* bar; unsigned x; volatile LAS unsigned* st; };
DI XcdBarrier xcd_barrier_post(unsigned* bar, volatile LAS unsigned* st) {
  XcdBarrier b; b.bar = bar; b.x = xb_xcc_id(); b.st = st;
  if (threadIdx.x == 0) (void)xb_add(&bar[XB_XCNT(b.x)], 1u);
  return b;
}
DI void xcd_barrier_complete(unsigned* bar, unsigned x, unsigned& nloc, unsigned& nx) {
  const unsigned G = gridDim.x * gridDim.y * gridDim.z;
  unsigned sum, cnt, mine, sp = 0u;
  for (;;) {
    sum = 0u; cnt = 0u; mine = 0u;
#pragma unroll
    for (unsigned j = 0; j < 16; ++j) { const unsigned c = xb_ld(&bar[XB_XCNT(j)]); sum += c; cnt += (c > 0u) ? 1u : 0u; mine = (j == x) ? c : mine; }
    if (sum == G) break;
    __builtin_amdgcn_s_sleep(1);
    if ((++sp & 255u) == 0u) { if (xb_ld(&bar[XB_TMO])) break; if (sp > XB_SPIN_CAP) { atomicAdd(&bar[XB_TMO], 1u); break; } }
  }
  nloc = mine > 0u ? mine : 1u; nx = cnt > 0u ? cnt : 1u;
}
DI void xcd_barrier(const XcdBarrier& b) {
  asm volatile("s_waitcnt vmcnt(0)" ::: "memory");
  __syncthreads();
  if (threadIdx.x == 0) {
    unsigned* bar = b.bar;
    __builtin_amdgcn_s_waitcnt(0);
    unsigned nloc = b.st[0], nx = b.st[1];
    if (nloc == 0u) { xcd_barrier_complete(bar, b.x, nloc, nx); b.st[0] = nloc; b.st[1] = nx; }
    const unsigned old = xb_add(&bar[XB_XSUB(b.x)], 1u);
    const unsigned gen = old / nloc;
    if (old + 1u == (gen + 1u) * nloc) {
      __builtin_amdgcn_fence(__ATOMIC_RELEASE, "agent");
      asm volatile("s_waitcnt vmcnt(0)" ::: "memory");
      const unsigned og = xb_add(&bar[XB_TOP], 1u);
      const unsigned tg = og / nx;
      if (og + 1u == (tg + 1u) * nx) xb_add(&bar[XB_TOPGEN], 1u);
      else XB_SPIN(xb_ld(&bar[XB_TOPGEN]) == tg, bar);
      __builtin_amdgcn_fence(__ATOMIC_ACQUIRE, "agent");
      xb_add(&bar[XB_XGEN(b.x)], 1u);
      asm volatile("s_waitcnt vmcnt(0)" ::: "memory");
    } else {
      XB_SPIN(xb_ld(&bar[XB_XGEN(b.x)]) == gen, bar);
      __builtin_amdgcn_fence(__ATOMIC_ACQUIRE, "agent");
      asm volatile("s_waitcnt vmcnt(0)" ::: "memory");
    }
  }
  __syncthreads();
}

DI bf16_t f2bf(float x) { return __builtin_bit_cast(bf16_t, (__bf16)x); }
DI float bf2f(bf16_t h) { return __uint_as_float(((unsigned)h) << 16); }
typedef __attribute__((ext_vector_type(2))) __bf16 bf16x2_t;
DI unsigned pack2(float a, float b) { bf16x2_t v; v.x = (__bf16)a; v.y = (__bf16)b; return __builtin_bit_cast(unsigned, v); }
DI bf16x8 pack8_mfma(float a0, float a1, float a2, float a3, float a4, float a5, float a6, float a7) {
  uint4 u = make_uint4(pack2(a0, a1), pack2(a2, a3), pack2(a4, a5), pack2(a6, a7));
  return __builtin_bit_cast(bf16x8, u);
}
DI float sigmf(float x) { return __builtin_amdgcn_rcpf(1.f + __expf(-x)); }
DI float siluf(float x) { return x * sigmf(x); }
DI float dppf(float v, const int ctrl_sel) {
  int iv = __float_as_int(v), r;
  switch (ctrl_sel) {
    case 0: r = __builtin_amdgcn_update_dpp(0, iv, 0xB1, 0xf, 0xf, false); break;
    case 1: r = __builtin_amdgcn_update_dpp(0, iv, 0x4E, 0xf, 0xf, false); break;
    case 2: r = __builtin_amdgcn_update_dpp(0, iv, 0x141, 0xf, 0xf, false); break;
    default: r = __builtin_amdgcn_update_dpp(0, iv, 0x140, 0xf, 0xf, false); break;
  }
  return __int_as_float(r);
}
DI float row16_sum(float v) { v += dppf(v, 0); v += dppf(v, 1); v += dppf(v, 2); v += dppf(v, 3); return v; }
DI float wave_sum(float v) { v = row16_sum(v); v += __shfl_xor(v, 16); v += __shfl_xor(v, 32); return v; }
DI float wave_max(float v) {
  for (int o = 1; o < 64; o <<= 1) v = fmaxf(v, __shfl_xor(v, o));
  return v;
}
DI int crow(int i, int h) { return (i & 3) + 8 * (i >> 2) + 4 * h; }

struct Ptrs {
  float* mod; int* ctr; int* cuf; float* rope; float* bonus; float* mdt; float* mcb; bf16_t* W3; bf16_t* LA; float* xc1; bf16_t* W1; bf16_t* H;
  bf16_t *pA, *pB, *pC, *pD, *VtA, *VtD; bf16_t* R1; bf16_t* R2;
};
DI Ptrs mkptrs(char* ws) {
  Ptrs q;
  q.mod = (float*)(ws + OFF_MOD); q.ctr = (int*)(ws + OFF_CTR); q.rope = (float*)(ws + OFF_ROPE); q.cuf = (int*)(ws + OFF_CUF); q.bonus = (float*)(ws + OFF_BONUS); q.mdt = (float*)(ws + OFF_MDT); q.mcb = (float*)(ws + OFF_MCB);
  q.W3 = (bf16_t*)(ws + OFF_W3); q.LA = (bf16_t*)(ws + OFF_LA); q.xc1 = (float*)(ws + OFF_XC1);
  q.W1 = (bf16_t*)(ws + OFF_W1); q.H = (bf16_t*)(ws + OFF_H);
  q.pA = (bf16_t*)(ws + OFF_PA); q.pB = (bf16_t*)(ws + OFF_PB); q.pC = (bf16_t*)(ws + OFF_PC); q.pD = (bf16_t*)(ws + OFF_PD);
  q.VtA = (bf16_t*)(ws + OFF_VTA); q.VtD = (bf16_t*)(ws + OFF_VTD);
  q.R1 = (bf16_t*)(ws + OFF_R1); q.R2 = (bf16_t*)(ws + OFF_R2);
  return q;
}

DI const float* xrow(CP p, const Ptrs& w, int l, int tok) {
  int b = tok / TPB, i = tok - b * TPB;
  if (l == 0) return i < CTXL ? p.in[2] + (size_t)(b * CTXL + i) * DM : p.in[0] + (size_t)(b * 8192 + i - CTXL) * DM;
  return i < CTXL ? w.xc1 + (size_t)(b * CTXL + i) * DM : p.out + (size_t)(b * 8192 + i - CTXL) * DM;
}

DI void transpose_tile(const float* __restrict__ src, int ld_src, int k0, int n0, bool win_map, bf16_t* __restrict__ dst, int ld_dst, float* sm) {
  const int tid = TIDX;
  __syncthreads();
  {
    int cgp = (tid & 15) * 4, n = n0 + cgp;
    int ns = n;
    if (win_map) ns = n < 5904 ? n : (n < 6016 ? -1 : n - 112);
#pragma unroll
    for (int i = 0; i < 4; ++i) {
      int kk = (tid >> 4) + 16 * i;
      float4 v = make_float4(0.f, 0.f, 0.f, 0.f);
      if (ns >= 0) v = *(const float4*)(src + (size_t)(k0 + kk) * ld_src + ns);
      float* d = sm + kk * 65 + cgp;
      d[0] = v.x; d[1] = v.y; d[2] = v.z; d[3] = v.w;
    }
  }
  __syncthreads();
  {
    int n = tid >> 2, kq = (tid & 3) * 16;
    unsigned o[8];
#pragma unroll
    for (int j = 0; j < 8; ++j) o[j] = pack2(sm[(kq + 2 * j) * 65 + n], sm[(kq + 2 * j + 1) * 65 + n]);
    uint4* dp = (uint4*)(dst + (size_t)(n0 + n) * ld_dst + k0 + kq);
    dp[0] = make_uint4(o[0], o[1], o[2], o[3]);
    dp[1] = make_uint4(o[4], o[5], o[6], o[7]);
  }
}

DI void gemm_128(const bf16_t* __restrict__ A, int lda, const bf16_t* __restrict__ B, int ldb, int K, f32x16 (&acc)[2][2], bf16_t* sA, bf16_t* sB) {
  const int tid = TIDX, lane = tid & 63, wid = tid >> 6, wm = wid >> 1, wn = wid & 1, r = lane & 31, h = lane >> 5;
  const int lrow = tid >> 3, lkc = (tid & 7) * 8;
  const bf16_t* ga = A + (size_t)lrow * lda + lkc;
  const bf16_t* gb = B + (size_t)lrow * ldb + lkc;
  uint4 ra0, ra1, ra2, ra3, rb0, rb1, rb2, rb3;
  ra0 = *(const uint4*)(ga); ra1 = *(const uint4*)(ga + (size_t)32 * lda); ra2 = *(const uint4*)(ga + (size_t)64 * lda); ra3 = *(const uint4*)(ga + (size_t)96 * lda);
  rb0 = *(const uint4*)(gb); rb1 = *(const uint4*)(gb + (size_t)32 * ldb); rb2 = *(const uint4*)(gb + (size_t)64 * ldb); rb3 = *(const uint4*)(gb + (size_t)96 * ldb);
  for (int k0 = 0; k0 < K; k0 += 64) {
    __syncthreads();
    *(uint4*)(sA + (lrow) * 72 + lkc) = ra0; *(uint4*)(sA + (lrow + 32) * 72 + lkc) = ra1; *(uint4*)(sA + (lrow + 64) * 72 + lkc) = ra2; *(uint4*)(sA + (lrow + 96) * 72 + lkc) = ra3;
    *(uint4*)(sB + (lrow) * 72 + lkc) = rb0; *(uint4*)(sB + (lrow + 32) * 72 + lkc) = rb1; *(uint4*)(sB + (lrow + 64) * 72 + lkc) = rb2; *(uint4*)(sB + (lrow + 96) * 72 + lkc) = rb3;
    __syncthreads();
    if (k0 + 64 < K) {
      const bf16_t* ga2 = ga + k0 + 64; const bf16_t* gb2 = gb + k0 + 64;
      ra0 = *(const uint4*)(ga2); ra1 = *(const uint4*)(ga2 + (size_t)32 * lda); ra2 = *(const uint4*)(ga2 + (size_t)64 * lda); ra3 = *(const uint4*)(ga2 + (size_t)96 * lda);
      rb0 = *(const uint4*)(gb2); rb1 = *(const uint4*)(gb2 + (size_t)32 * ldb); rb2 = *(const uint4*)(gb2 + (size_t)64 * ldb); rb3 = *(const uint4*)(gb2 + (size_t)96 * ldb);
    }
#pragma unroll
    for (int s = 0; s < 4; ++s) {
      bf16x8 a0 = *(const bf16x8*)(sA + (wm * 64 + r) * 72 + s * 16 + h * 8);
      bf16x8 a1 = *(const bf16x8*)(sA + (wm * 64 + 32 + r) * 72 + s * 16 + h * 8);
      bf16x8 b0 = *(const bf16x8*)(sB + (wn * 64 + r) * 72 + s * 16 + h * 8);
      bf16x8 b1 = *(const bf16x8*)(sB + (wn * 64 + 32 + r) * 72 + s * 16 + h * 8);
      acc[0][0] = MFMA(a0, b0, acc[0][0]); acc[0][1] = MFMA(a0, b1, acc[0][1]);
      acc[1][0] = MFMA(a1, b0, acc[1][0]); acc[1][1] = MFMA(a1, b1, acc[1][1]);
    }
  }
}
DI void gemm_128_2set(const bf16_t* __restrict__ A, int lda, const bf16_t* __restrict__ B, int ldb, int K, f32x16 (&acc)[2][2], bf16_t* sA, bf16_t* sB) {
  const int tid = TIDX, lane = tid & 63, wid = tid >> 6, wm = wid >> 1, wn = wid & 1, r = lane & 31, h = lane >> 5;
  const int lrow = tid >> 3, lkc = (tid & 7) * 8;
  const bf16_t* ga = A + (size_t)lrow * lda + lkc;
  const bf16_t* gb = B + (size_t)lrow * ldb + lkc;
  uint4 pa0, pa1, pa2, pa3, pb0, pb1, pb2, pb3, qa0, qa1, qa2, qa3, qb0, qb1, qb2, qb3;
#define GL2_P(off) { const bf16_t* x = ga + (off); const bf16_t* y = gb + (off); \
    pa0 = *(const uint4*)(x); pa1 = *(const uint4*)(x + (size_t)32 * lda); pa2 = *(const uint4*)(x + (size_t)64 * lda); pa3 = *(const uint4*)(x + (size_t)96 * lda); \
    pb0 = *(const uint4*)(y); pb1 = *(const uint4*)(y + (size_t)32 * ldb); pb2 = *(const uint4*)(y + (size_t)64 * ldb); pb3 = *(const uint4*)(y + (size_t)96 * ldb); }
#define GL2_Q(off) { const bf16_t* x = ga + (off); const bf16_t* y = gb + (off); \
    qa0 = *(const uint4*)(x); qa1 = *(const uint4*)(x + (size_t)32 * lda); qa2 = *(const uint4*)(x + (size_t)64 * lda); qa3 = *(const uint4*)(x + (size_t)96 * lda); \
    qb0 = *(const uint4*)(y); qb1 = *(const uint4*)(y + (size_t)32 * ldb); qb2 = *(const uint4*)(y + (size_t)64 * ldb); qb3 = *(const uint4*)(y + (size_t)96 * ldb); }
#define ST2(a0, a1, a2, a3, b0, b1, b2, b3) { \
    *(uint4*)(sA + (lrow) * 72 + lkc) = a0; *(uint4*)(sA + (lrow + 32) * 72 + lkc) = a1; *(uint4*)(sA + (lrow + 64) * 72 + lkc) = a2; *(uint4*)(sA + (lrow + 96) * 72 + lkc) = a3; \
    *(uint4*)(sB + (lrow) * 72 + lkc) = b0; *(uint4*)(sB + (lrow + 32) * 72 + lkc) = b1; *(uint4*)(sB + (lrow + 64) * 72 + lkc) = b2; *(uint4*)(sB + (lrow + 96) * 72 + lkc) = b3; }
#define MMA2() _Pragma("unroll") for (int s = 0; s < 4; ++s) { \
      bf16x8 a0 = *(const bf16x8*)(sA + (wm * 64 + r) * 72 + s * 16 + h * 8); \
      bf16x8 a1 = *(const bf16x8*)(sA + (wm * 64 + 32 + r) * 72 + s * 16 + h * 8); \
      bf16x8 b0 = *(const bf16x8*)(sB + (wn * 64 + r) * 72 + s * 16 + h * 8); \
      bf16x8 b1 = *(const bf16x8*)(sB + (wn * 64 + 32 + r) * 72 + s * 16 + h * 8); \
      acc[0][0] = MFMA(a0, b0, acc[0][0]); acc[0][1] = MFMA(a0, b1, acc[0][1]); \
      acc[1][0] = MFMA(a1, b0, acc[1][0]); acc[1][1] = MFMA(a1, b1, acc[1][1]); }
  GL2_P(0)
  GL2_Q(64)
  for (int k0 = 0; k0 < K - 128; k0 += 128) {
    __syncthreads();
    ST2(pa0, pa1, pa2, pa3, pb0, pb1, pb2, pb3)
    __syncthreads();
    GL2_P(k0 + 128)
    MMA2()
    __syncthreads();
    ST2(qa0, qa1, qa2, qa3, qb0, qb1, qb2, qb3)
    __syncthreads();
    GL2_Q(k0 + 192)
    MMA2()
  }
  __syncthreads();
  ST2(pa0, pa1, pa2, pa3, pb0, pb1, pb2, pb3)
  __syncthreads();
  MMA2()
  __syncthreads();
  ST2(qa0, qa1, qa2, qa3, qb0, qb1, qb2, qb3)
  __syncthreads();
  MMA2()
#undef GL2_P
#undef GL2_Q
#undef ST2
#undef MMA2
}
DI void gemm_128_deep(const bf16_t* __restrict__ A, int lda, const bf16_t* __restrict__ B, int ldb, int K, f32x16 (&acc)[2][2], bf16_t* sA, bf16_t* sBunused) {
  (void)sBunused;
  const int tid = TIDX, lane = tid & 63, wid = tid >> 6, wm = wid >> 1, wn = wid & 1, r = lane & 31, h = lane >> 5;
  const int lrow = tid >> 3, lkc = (tid & 7) * 8;
  const bf16_t* ga = A + (size_t)lrow * lda + lkc;
  const bf16_t* gb = B + (size_t)lrow * ldb + lkc;
  uint4 pa0, pa1, pa2, pa3, pb0, pb1, pb2, pb3, qa0, qa1, qa2, qa3, qb0, qb1, qb2, qb3;
#define GL_P(off) { const bf16_t* x = ga + (off); const bf16_t* y = gb + (off); \
    pa0 = *(const uint4*)(x); pa1 = *(const uint4*)(x + (size_t)32 * lda); pa2 = *(const uint4*)(x + (size_t)64 * lda); pa3 = *(const uint4*)(x + (size_t)96 * lda); \
    pb0 = *(const uint4*)(y); pb1 = *(const uint4*)(y + (size_t)32 * ldb); pb2 = *(const uint4*)(y + (size_t)64 * ldb); pb3 = *(const uint4*)(y + (size_t)96 * ldb); }
#define GL_Q(off) { const bf16_t* x = ga + (off); const bf16_t* y = gb + (off); \
    qa0 = *(const uint4*)(x); qa1 = *(const uint4*)(x + (size_t)32 * lda); qa2 = *(const uint4*)(x + (size_t)64 * lda); qa3 = *(const uint4*)(x + (size_t)96 * lda); \
    qb0 = *(const uint4*)(y); qb1 = *(const uint4*)(y + (size_t)32 * ldb); qb2 = *(const uint4*)(y + (size_t)64 * ldb); qb3 = *(const uint4*)(y + (size_t)96 * ldb); }
#define ST_LDS(buf, a0, a1, a2, a3, b0, b1, b2, b3) { bf16_t* da = sA + (buf) * (2 * 128 * 72); bf16_t* db = da + 128 * 72; \
    *(uint4*)(da + (lrow) * 72 + lkc) = a0; *(uint4*)(da + (lrow + 32) * 72 + lkc) = a1; *(uint4*)(da + (lrow + 64) * 72 + lkc) = a2; *(uint4*)(da + (lrow + 96) * 72 + lkc) = a3; \
    *(uint4*)(db + (lrow) * 72 + lkc) = b0; *(uint4*)(db + (lrow + 32) * 72 + lkc) = b1; *(uint4*)(db + (lrow + 64) * 72 + lkc) = b2; *(uint4*)(db + (lrow + 96) * 72 + lkc) = b3; }
#define MMA_TILE(buf) { const bf16_t* ca = sA + (buf) * (2 * 128 * 72); const bf16_t* cb = ca + 128 * 72; \
    _Pragma("unroll") for (int s = 0; s < 4; ++s) { \
      bf16x8 a0 = *(const bf16x8*)(ca + (wm * 64 + r) * 72 + s * 16 + h * 8); \
      bf16x8 a1 = *(const bf16x8*)(ca + (wm * 64 + 32 + r) * 72 + s * 16 + h * 8); \
      bf16x8 b0 = *(const bf16x8*)(cb + (wn * 64 + r) * 72 + s * 16 + h * 8); \
      bf16x8 b1 = *(const bf16x8*)(cb + (wn * 64 + 32 + r) * 72 + s * 16 + h * 8); \
      acc[0][0] = MFMA(a0, b0, acc[0][0]); acc[0][1] = MFMA(a0, b1, acc[0][1]); \
      acc[1][0] = MFMA(a1, b0, acc[1][0]); acc[1][1] = MFMA(a1, b1, acc[1][1]); } }
  GL_P(0)
  GL_Q(64)
  __syncthreads();
  ST_LDS(0, pa0, pa1, pa2, pa3, pb0, pb1, pb2, pb3)
  GL_P(128)
  __syncthreads();
  for (int k0 = 0; k0 < K - 256; k0 += 128) {
    MMA_TILE(0)
    ST_LDS(1, qa0, qa1, qa2, qa3, qb0, qb1, qb2, qb3)
    GL_Q(k0 + 192)
    __syncthreads();
    MMA_TILE(1)
    ST_LDS(0, pa0, pa1, pa2, pa3, pb0, pb1, pb2, pb3)
    GL_P(k0 + 256)
    __syncthreads();
  }
  MMA_TILE(0)
  ST_LDS(1, qa0, qa1, qa2, qa3, qb0, qb1, qb2, qb3)
  GL_Q(K - 64)
  __syncthreads();
  MMA_TILE(1)
  ST_LDS(0, pa0, pa1, pa2, pa3, pb0, pb1, pb2, pb3)
  __syncthreads();
  MMA_TILE(0)
  ST_LDS(1, qa0, qa1, qa2, qa3, qb0, qb1, qb2, qb3)
  __syncthreads();
  MMA_TILE(1)
  __syncthreads();
#undef GL_P
#undef GL_Q
#undef ST_LDS
#undef MMA_TILE
}
DI bool tile_map(int k, int MT, int NT, int& mt, int& nt) {
  const int gd = GDIM, b = BIDX;
  if (gd & 63) { int it = b + k * gd; if (it >= MT * NT) return false; mt = it / NT; nt = it - mt * NT; return true; }
  const int gsm = gd >> 6, x = b & 7, j = b >> 3;
  const int ngn = (NT + 7) >> 3, ngm = (MT + gsm - 1) / gsm;
  const int g = k * 8 + x;
  if (g >= ngm * ngn) return false;
  const int gm = g / ngn, gn = g - gm * ngn;
  mt = gm * gsm + (j >> 3); nt = gn * 8 + (j & 7);
  return mt < MT && nt < NT;
}
DI int tile_rounds(int MT, int NT) {
  const int gd = GDIM;
  if (gd & 63) return (MT * NT + gd - 1) / gd;
  const int gsm = gd >> 6;
  return (((NT + 7) >> 3) * ((MT + gsm - 1) / gsm) + 7) >> 3;
}
DI void zero_acc(f32x16 (&acc)[2][2]) {
#pragma unroll
  for (int a = 0; a < 2; ++a)
#pragma unroll
    for (int b = 0; b < 2; ++b)
#pragma unroll
      for (int i = 0; i < 16; ++i) acc[a][b][i] = 0.f;
}

DI void phase_ada_item(CP p, const Ptrs& w, int l, int item, int ksplit, float* sm) {
  const int tid = TIDX, lane = tid & 63, wid = tid >> 6;
  const int cgp = item % 96, kq = item / 96, j = cgp * 64 + lane;
  const int rows_w = 512 / ksplit;
  float* act = sm;
  float* red = sm + 3 * 2048;
  __syncthreads();
  for (int e = tid; e < 3 * 2048; e += 256) {
    int v = e >> 11, k = e & 2047;
    float x = v < 2 ? p.in[1][v * 2048 + k] : p.in[3][k];
    act[e] = siluf(x);
  }
  __syncthreads();
  const float* wa = p.in[5] + (size_t)l * 2048 * 6144 + j;
  float a0 = 0.f, a1 = 0.f, a2 = 0.f;
  const int kb = kq * (2048 / ksplit) + wid * rows_w;
#pragma unroll 32
  for (int k = 0; k < rows_w; ++k) {
    float wv = wa[(size_t)(kb + k) * 6144];
    a0 += act[kb + k] * wv; a1 += act[2048 + kb + k] * wv; a2 += act[4096 + kb + k] * wv;
  }
  red[(wid * 3 + 0) * 64 + lane] = a0; red[(wid * 3 + 1) * 64 + lane] = a1; red[(wid * 3 + 2) * 64 + lane] = a2;
  __syncthreads();
  if (tid < 192) {
    int v = tid >> 6, ll = tid & 63, jj = cgp * 64 + ll;
    float s = red[(0 * 3 + v) * 64 + ll] + red[(1 * 3 + v) * 64 + ll] + red[(2 * 3 + v) * 64 + ll] + red[(3 * 3 + v) * 64 + ll];
    if (ksplit == 1) w.mod[(l * 3 + v) * 6144 + jj] = s + p.in[6][l * 6144 + jj];
    else atomicAdd(&w.mod[(l * 3 + v) * 6144 + jj], kq == 0 ? s + p.in[6][l * 6144 + jj] : s);
  }
}
DI void conv_w1(CP p, const Ptrs& w, int l, float* sm) {
  const float* src = p.in[7] + (size_t)l * 2048 * 7952;
  for (int it = BIDX; it < 126 * 32; it += GDIM) {
    int nt = it >> 5, kt = it & 31;
    transpose_tile(src, 7952, kt * 64, nt * 64, true, w.W1, 2048, sm);
  }
}
DI void conv_w3(CP p, const Ptrs& w, int l, float* sm) {
  for (int it = BIDX; it < 32; it += GDIM) {
    int m = it >> 3, nt = it & 7, type = m >> 1, dir = m & 1;
    const float* src = p.in[type == 0 ? 13 : 15] + (size_t)((l * 2 + dir) * 64) * 512;
    transpose_tile(src, 512, 0, nt * 64, false, w.W3 + (size_t)m * 512 * 64, 64, sm);
  }
}
DI void conv_w2(CP p, const Ptrs& w, int l, float* sm) {
  bf16_t* gate_t = (bf16_t*)((char*)w.R1 + R1_GATE);
  bf16_t* up_t = (bf16_t*)((char*)w.R1 + R1_UP);
  bf16_t* out_t = (bf16_t*)((char*)w.R1 + R1_OUT);
  for (int it = BIDX; it < 6144; it += GDIM) {
    if (it < 4096) {
      int i = it >> 10, r = it & 1023, nt = r >> 5, kt = r & 31;
      transpose_tile(p.in[34] + (size_t)(l * 4 + i) * 2048 * 2048, 2048, kt * 64, nt * 64, false, gate_t + (size_t)i * 2048 * 2048, 2048, sm);
    } else if (it < 5120) {
      int q = it - 4096, i = q >> 8, r = q & 255, nt = r >> 3, kt = r & 7;
      transpose_tile(p.in[35] + (size_t)(l * 4 + i) * 512 * 2048, 2048, kt * 64, nt * 64, false, up_t + (size_t)i * 2048 * 512, 512, sm);
    } else {
      int r = it - 5120, nt = r >> 5, kt = r & 31;
      transpose_tile(p.in[36] + (size_t)l * 2048 * 2048, 2048, kt * 64, nt * 64, false, out_t, 2048, sm);
    }
  }
}

DI void phase_norm(CP p, const Ptrs& w, int l) {
  const int lane = TIDX & 63, gw = BIDX * 4 + (TIDX >> 6), nw = GDIM * 4;
  const float* nwt = p.in[4] + l * 2048;
  for (int tok = gw; tok < T; tok += nw) {
    int b = tok / TPB, i = tok - b * TPB, v = i < CTXL ? 2 : b;
    const float* xr = xrow(p, w, l, tok);
    const float* md = w.mod + (l * 3 + v) * 6144;
    float4 xv[8];
    float ss = 0.f;
#pragma unroll
    for (int j = 0; j < 8; ++j) { xv[j] = *(const float4*)(xr + (j * 64 + lane) * 4); ss += xv[j].x * xv[j].x + xv[j].y * xv[j].y + xv[j].z * xv[j].z + xv[j].w * xv[j].w; }
    ss = wave_sum(ss);
    float inv = rsqrtf(ss * (1.f / 2048.f) + 1e-6f);
#pragma unroll
    for (int j = 0; j < 8; ++j) {
      int c = (j * 64 + lane) * 4;
      float4 nw4 = *(const float4*)(nwt + c), sh = *(const float4*)(md + c), sc = *(const float4*)(md + 2048 + c);
      float y0 = xv[j].x * inv * nw4.x * (1.f + sc.x) + sh.x, y1 = xv[j].y * inv * nw4.y * (1.f + sc.y) + sh.y;
      float y2 = xv[j].z * inv * nw4.z * (1.f + sc.z) + sh.z, y3 = xv[j].w * inv * nw4.w * (1.f + sc.w) + sh.w;
      *(uint2*)(w.H + (size_t)tok * 2048 + c) = make_uint2(pack2(y0, y1), pack2(y2, y3));
    }
  }
}

DI void phase_inproj(CP p, const Ptrs& w, int l, bf16_t* sA, bf16_t* sB) {
  const int tid = TIDX, lane = tid & 63, wid = tid >> 6, wm = wid >> 1, wn = wid & 1, r = lane & 31, h = lane >> 5;
  const int nrounds = tile_rounds(132, 63);
  for (int kk = 0; kk < nrounds; ++kk) {
    int mt, nt;
    if (!tile_map(kk, 132, 63, mt, nt)) continue;
    int m0 = mt * 128, n0 = nt * 128;
    f32x16 acc[2][2];
    zero_acc(acc);
    gemm_128_deep(w.H + (size_t)m0 * 2048, 2048, w.W1 + (size_t)n0 * 2048, 2048, 2048, acc, sA, sB);
    bf16_t* dst = nullptr; int stride = 0, cbase = 0; bf16_t* vt = nullptr; int vbase = 0;
    if (n0 < 2048) { int sub = n0 >> 9; if (sub == 2) { vt = w.VtA; vbase = n0 - 1024; } else { dst = w.pA; stride = SPA; cbase = sub == 3 ? n0 - 512 : n0; } }
    else if (n0 < 4352) { dst = w.pB; stride = SPB; cbase = n0 - 2048; }
    else if (n0 < 6016) { dst = w.pC; stride = SPC; cbase = n0 - 4352; }
    else { int cd = n0 - 6016, sub = cd >> 9; if (sub == 2) { vt = w.VtD; vbase = cd - 1024; } else { dst = w.pD; stride = SPD; cbase = sub == 3 ? cd - 512 : cd; } }
    if (dst) {
#pragma unroll
      for (int mi = 0; mi < 2; ++mi)
#pragma unroll
        for (int ni = 0; ni < 2; ++ni)
#pragma unroll
          for (int i = 0; i < 16; ++i) {
            int row = m0 + wm * 64 + mi * 32 + crow(i, h), col = cbase + wn * 64 + ni * 32 + r;
            dst[(size_t)row * stride + col] = f2bf(acc[mi][ni][i]);
          }
    } else {
      int b = m0 / TPB, ib = m0 - b * TPB;
#pragma unroll
      for (int mi = 0; mi < 2; ++mi)
#pragma unroll
        for (int ni = 0; ni < 2; ++ni)
#pragma unroll
          for (int g = 0; g < 4; ++g) {
            int i0 = ib + wm * 64 + mi * 32 + 8 * g + 4 * h, vcol = vbase + wn * 64 + ni * 32 + r;
            *(uint2*)(vt + (size_t)(b * 512 + vcol) * TPB + i0) =
                make_uint2(pack2(acc[mi][ni][4 * g], acc[mi][ni][4 * g + 1]), pack2(acc[mi][ni][4 * g + 2], acc[mi][ni][4 * g + 3]));
          }
    }
  }
  if (l == 0) {
    __shared__ int s_ada;
    for (;;) {
      __syncthreads();
      if (TIDX == 0) s_ada = atomicAdd(&w.ctr[40], 1);
      __syncthreads();
      const int it = s_ada;
      if (it >= 96) break;
      phase_ada_item(p, w, 1, it, 1, (float*)sA);
    }
  }
}

DI float quad_sum(float v) { v += dppf(v, 0); v += dppf(v, 1); return v; }
DI float row8_sum(float v) { v += dppf(v, 0); v += dppf(v, 1); v += dppf(v, 2); return v; }
DI void unpack8(uint4 u, float* f) {
  f[0] = __uint_as_float(u.x << 16); f[1] = __uint_as_float(u.x & 0xffff0000u); f[2] = __uint_as_float(u.y << 16); f[3] = __uint_as_float(u.y & 0xffff0000u);
  f[4] = __uint_as_float(u.z << 16); f[5] = __uint_as_float(u.z & 0xffff0000u); f[6] = __uint_as_float(u.w << 16); f[7] = __uint_as_float(u.w & 0xffff0000u);
}
DI uint4 pack8(const float* f) { return make_uint4(pack2(f[0], f[1]), pack2(f[2], f[3]), pack2(f[4], f[5]), pack2(f[6], f[7])); }
DI void phase_prep(CP p, const Ptrs& w, int l) {
  const int lane = TIDX & 63, gw = BIDX * 4 + (TIDX >> 6), nw = GDIM * 4;
  const int qd = lane & 3, vec = lane >> 2;
  float wa[16], wd[16];
  {
    const float* sa = (vec < 8 ? p.in[8] : p.in[9]) + l * 64 + qd * 16;
    const float* sd = (vec < 8 ? p.in[27] : p.in[28]) + l * 64 + qd * 16;
    const float qs = vec < 8 ? QS : 1.f;
#pragma unroll
    for (int j = 0; j < 16; ++j) { wa[j] = sa[j] * qs; wd[j] = sd[j] * qs; }
  }
  float mu4[4];
#pragma unroll
  for (int j = 0; j < 4; ++j) mu4[j] = p.in[11][l * 1792 + 1536 + lane * 4 + j];
  float cwB[4][4], cwC[4][4];
#pragma unroll
  for (int j = 0; j < 4; ++j) {
#pragma unroll
    for (int q = 0; q < 3; ++q) { cwB[q][j] = p.in[21][(l * 3 + q) * 1024 + 512 + lane * 4 + j]; cwC[q][j] = p.in[21][(l * 3 + q) * 1024 + 768 + lane * 4 + j]; }
    cwB[3][j] = p.in[22][l * 1024 + 512 + lane * 4 + j]; cwC[3][j] = p.in[22][l * 1024 + 768 + lane * 4 + j];
  }
  const float dtb_l = lane < 16 ? p.in[23][l * 16 + lane] : 0.f;
  const float Aneg_l = lane < 16 ? -__expf(p.in[24][l * 16 + lane]) : 0.f;
  for (int tok = gw; tok < T; tok += nw) {
    int b = tok / TPB, i = tok - b * TPB;
    bool isx = i >= CTXL;
    int ti = i - CTXL;
    uint4* pa = (uint4*)(w.pA + (size_t)tok * SPA) + lane * 2;
    uint4* pd = (uint4*)(w.pD + (size_t)tok * SPD) + lane * 2;
    const bf16_t* rb = w.pB + (size_t)tok * SPB + 1536 + lane * 4;
    bool hp = (i != 0) && (i != CTXL), hn = (i != CTXL - 1) && (i != TPB - 1);
    uint4 a0 = pa[0], a1 = pa[1], d0 = pd[0], d1 = pd[1];
    uint2 lc = *(const uint2*)rb, lp = make_uint2(0, 0), ln = make_uint2(0, 0);
    if (hp) lp = *(const uint2*)(rb - SPB);
    if (hn) ln = *(const uint2*)(rb + SPB);
    float4 rt[8];
    if (isx) {
      const float4* tp = (const float4*)(w.rope + (size_t)((qd < 2 ? (ti >> 6) : (ti & 63)) * 32));
#pragma unroll
      for (int j = 0; j < 8; ++j) rt[j] = tp[j];
    }
    float e[16];
    unpack8(a0, e); unpack8(a1, e + 8);
    {
      float ss = 0.f;
#pragma unroll
      for (int j = 0; j < 16; ++j) ss += e[j] * e[j];
      ss = quad_sum(ss);
      float sc = rsqrtf(ss * (1.f / 64.f) + 1e-6f);
#pragma unroll
      for (int j = 0; j < 16; ++j) e[j] = e[j] * sc * wa[j];
      pa[0] = pack8(e); pa[1] = pack8(e + 8);
    }
    unpack8(d0, e); unpack8(d1, e + 8);
    {
      float ss = 0.f;
#pragma unroll
      for (int j = 0; j < 16; ++j) ss += e[j] * e[j];
      ss = quad_sum(ss);
      float sc = rsqrtf(ss * (1.f / 64.f) + 1e-6f);
#pragma unroll
      for (int j = 0; j < 16; ++j) e[j] = e[j] * sc * wd[j];
      if (isx) {
#pragma unroll
        for (int j = 0; j < 16; ++j) {
          float pr = dppf(e[j], 0);
          float cs = (j & 1) ? rt[j >> 1].z : rt[j >> 1].x, sn = (j & 1) ? rt[j >> 1].w : rt[j >> 1].y;
          e[j] = e[j] * cs + ((qd & 1) ? pr : -pr) * sn;
        }
      }
      pd[0] = pack8(e); pd[1] = pack8(e + 8);
    }
    {
      const bf16_t* rc = w.pC + (size_t)tok * SPC;
      uint2 bc = *(const uint2*)(rc + 512 + lane * 4), cc = *(const uint2*)(rc + 768 + lane * 4);
      uint2 bp = make_uint2(0, 0), bn = make_uint2(0, 0), cp = make_uint2(0, 0), cn = make_uint2(0, 0);
      if (hp) { bp = *(const uint2*)(rc + 512 + lane * 4 - SPC); cp = *(const uint2*)(rc + 768 + lane * 4 - SPC); }
      if (hn) { bn = *(const uint2*)(rc + 512 + lane * 4 + SPC); cn = *(const uint2*)(rc + 768 + lane * 4 + SPC); }
      float dtraw = lane < 16 ? bf2f(rc[1024 + lane]) : 0.f;
      float Bc[4] = {__uint_as_float(bc.x << 16), __uint_as_float(bc.x & 0xffff0000u), __uint_as_float(bc.y << 16), __uint_as_float(bc.y & 0xffff0000u)};
      float Bp[4] = {__uint_as_float(bp.x << 16), __uint_as_float(bp.x & 0xffff0000u), __uint_as_float(bp.y << 16), __uint_as_float(bp.y & 0xffff0000u)};
      float Bn[4] = {__uint_as_float(bn.x << 16), __uint_as_float(bn.x & 0xffff0000u), __uint_as_float(bn.y << 16), __uint_as_float(bn.y & 0xffff0000u)};
      float Cc[4] = {__uint_as_float(cc.x << 16), __uint_as_float(cc.x & 0xffff0000u), __uint_as_float(cc.y << 16), __uint_as_float(cc.y & 0xffff0000u)};
      float Cp[4] = {__uint_as_float(cp.x << 16), __uint_as_float(cp.x & 0xffff0000u), __uint_as_float(cp.y << 16), __uint_as_float(cp.y & 0xffff0000u)};
      float Cn[4] = {__uint_as_float(cn.x << 16), __uint_as_float(cn.x & 0xffff0000u), __uint_as_float(cn.y << 16), __uint_as_float(cn.y & 0xffff0000u)};
      float ob[4], oc[4], prod = 0.f;
#pragma unroll
      for (int j = 0; j < 4; ++j) {
        ob[j] = bf2f(f2bf(siluf(cwB[0][j] * Bp[j] + cwB[1][j] * Bc[j] + cwB[2][j] * Bn[j] + cwB[3][j])));
        oc[j] = bf2f(f2bf(siluf(cwC[0][j] * Cp[j] + cwC[1][j] * Cc[j] + cwC[2][j] * Cn[j] + cwC[3][j])));
        prod += ob[j] * oc[j];
      }
      prod = row16_sum(prod); prod += __shfl_xor(prod, 16);
      bf16_t* mb = w.W1 + (size_t)tok * 512;
      *(uint2*)(mb + lane * 4) = make_uint2(pack2(ob[0], ob[1]), pack2(ob[2], ob[3]));
      *(uint2*)(mb + 256 + lane * 4) = make_uint2(pack2(oc[0], oc[1]), pack2(oc[2], oc[3]));
      if ((lane & 31) == 0) w.mcb[(size_t)tok * 2 + (lane >> 5)] = prod;
      if (lane < 16) {
        float dr = dtraw + dtb_l;
        float dt = dr > 20.f ? dr : log1pf(__expf(dr));
        *(float2*)(w.mdt + ((size_t)tok * 16 + lane) * 2) = make_float2(dt, __expf(dt * Aneg_l));
      }
    }
    {
      float c4[4] = {__uint_as_float(lc.x << 16), __uint_as_float(lc.x & 0xffff0000u), __uint_as_float(lc.y << 16), __uint_as_float(lc.y & 0xffff0000u)};
      float p4[4] = {__uint_as_float(lp.x << 16), __uint_as_float(lp.x & 0xffff0000u), __uint_as_float(lp.y << 16), __uint_as_float(lp.y & 0xffff0000u)};
      float n4[4] = {__uint_as_float(ln.x << 16), __uint_as_float(ln.x & 0xffff0000u), __uint_as_float(ln.y << 16), __uint_as_float(ln.y & 0xffff0000u)};
      float o[4];
#pragma unroll
      for (int j = 0; j < 4; ++j) { float sft = c4[j] + (0.5f * (p4[j] + n4[j]) - c4[j]) * mu4[j]; o[j] = lane < 32 ? tanhf(sft) : sft; }
      *(uint2*)(w.LA + (size_t)tok * 256 + lane * 4) = make_uint2(pack2(o[0], o[1]), pack2(o[2], o[3]));
    }
  }
}

DI void phase_lora(CP p, const Ptrs& w, int l, bf16_t* sA, bf16_t* sB) {
  const int tid = TIDX, lane = tid & 63, wid = tid >> 6, wm = wid >> 1, wn = wid & 1, r = lane & 31, h = lane >> 5;
  for (int it = BIDX; it < 132 * 16; it += GDIM) {
    int mt = it >> 4, q = it & 15, m = q >> 2, nt = q & 3, type = m >> 1, dir = m & 1, m0 = mt * 128, n0 = nt * 128;
    f32x16 acc[2][2];
    zero_acc(acc);
    gemm_128(w.LA + (size_t)m0 * 256 + m * 64, 256, w.W3 + (size_t)(m * 512 + n0) * 64, 64, 64, acc, sA, sB);
    const float* bias = p.in[type == 0 ? 12 : 14] + (l * 2 + dir) * 512;
    bf16_t* dst = w.R1 + (size_t)m * T * 512;
#pragma unroll
    for (int mi = 0; mi < 2; ++mi)
#pragma unroll
      for (int ni = 0; ni < 2; ++ni) {
        int col = n0 + wn * 64 + ni * 32 + r;
        float bc = bias[col];
#pragma unroll
        for (int i = 0; i < 16; ++i) {
          int row = m0 + wm * 64 + mi * 32 + crow(i, h);
          float x = acc[mi][ni][i] + bc, o;
          if (type == 0) o = 1.f - __expf(-0.6065306597126334f * sigmf(x));
          else o = sigmf(x);
          dst[(size_t)row * 512 + col] = f2bf(o);
        }
      }
  }
}

DI void phase_rwscal(CP p, const Ptrs& w, int l) {
  const int lane = TIDX & 63, gw = BIDX * 4 + (TIDX >> 6), nw = GDIM * 4;
  const int c0 = lane * 8, hd = lane >> 3;
  float mur[8], muk[8], kkc[8], kac[8], rkc[8];
#pragma unroll
  for (int j = 0; j < 8; ++j) {
    mur[j] = p.in[11][l * 1792 + c0 + j]; muk[j] = p.in[11][l * 1792 + 512 + c0 + j];
    kkc[j] = p.in[16][l * 512 + c0 + j]; kac[j] = p.in[17][l * 512 + c0 + j]; rkc[j] = p.in[18][l * 512 + c0 + j];
  }
  const bf16_t* Ad0 = w.R1 + (size_t)2 * T * 512, *Ad1 = w.R1 + (size_t)3 * T * 512;
  for (int tok = gw; tok < T; tok += nw) {
    int b = tok / TPB, i = tok - b * TPB;
    bool hp = (i != 0) && (i != CTXL), hn = (i != CTXL - 1) && (i != TPB - 1);
    const bf16_t* rb = w.pB + (size_t)tok * SPB + c0;
    uint4 ur = *(const uint4*)rb, uk = *(const uint4*)(rb + 512);
    uint4 urp = make_uint4(0, 0, 0, 0), urn = urp, ukp = urp, ukn = urp;
    if (hp) { urp = *(const uint4*)(rb - SPB); ukp = *(const uint4*)(rb + 512 - SPB); }
    if (hn) { urn = *(const uint4*)(rb + SPB); ukn = *(const uint4*)(rb + 512 + SPB); }
    uint4 ua0 = *(const uint4*)(Ad0 + (size_t)tok * 512 + c0), ua1 = *(const uint4*)(Ad1 + (size_t)tok * 512 + c0);
    float r[8], k[8], t0[8], t1[8];
    unpack8(ur, r); unpack8(urp, t0); unpack8(urn, t1);
#pragma unroll
    for (int j = 0; j < 8; ++j) r[j] = r[j] + (0.5f * (t0[j] + t1[j]) - r[j]) * mur[j];
    unpack8(uk, k); unpack8(ukp, t0); unpack8(ukn, t1);
    float ss = 0.f;
#pragma unroll
    for (int j = 0; j < 8; ++j) { k[j] = k[j] + (0.5f * (t0[j] + t1[j]) - k[j]) * muk[j]; float kv = k[j] * kkc[j]; ss += kv * kv; }
    ss = row8_sum(ss);
    float inv = 1.f / fmaxf(sqrtf(ss), 1e-12f);
    unpack8(ua0, t0); unpack8(ua1, t1);
    float br0 = 0.f, kr0 = 0.f, bo0 = 0.f, br1 = 0.f, kr1 = 0.f, bo1 = 0.f;
#pragma unroll
    for (int j = 0; j < 8; ++j) {
      float kk = k[j] * kkc[j] * inv;
      float kd0 = k[j] * (1.f + (t0[j] - 1.f) * kac[j]), kd1 = k[j] * (1.f + (t1[j] - 1.f) * kac[j]);
      br0 += kk * t0[j] * r[j]; br1 += kk * t1[j] * r[j];
      kr0 += kd0 * r[j]; kr1 += kd1 * r[j];
      bo0 += r[j] * kd0 * rkc[j]; bo1 += r[j] * kd1 * rkc[j];
    }
    br0 = row8_sum(br0); br1 = row8_sum(br1); kr0 = row8_sum(kr0); kr1 = row8_sum(kr1); bo0 = row8_sum(bo0); bo1 = row8_sum(bo1);
    if ((lane & 7) == 0) {
      float4* dst = (float4*)(w.bonus + ((size_t)tok * 8 + hd) * 8);
      dst[0] = make_float4(inv, br0, kr0, bo0);
      dst[1] = make_float4(br1, kr1, bo1, 0.f);
    }
  }
}

DI int pos2i(int pos, int dir) { return dir == 0 ? pos : (pos < CTXL ? CTXL - 1 - pos : (TPB + CTXL - 1) - pos); }

DI void rwkv_scan(CP p, const Ptrs& w, int l, int item, float* sm) {
  const int tid = TIDX, lane = tid & 63, wid = tid >> 6;
  const int chain = item >> 2, rq = item & 3, b = chain >> 4, hd = (chain >> 1) & 7, dir = chain & 1;
  const int sj = tid >> 4, skq = (tid & 15) * 4, sc_ = hd * 64 + skq;
  float mu_r[4], mu_k[4], mu_v[4], kk_c[4], ka_c[4];
#pragma unroll
  for (int j = 0; j < 4; ++j) {
    mu_r[j] = p.in[11][l * 1792 + sc_ + j]; mu_k[j] = p.in[11][l * 1792 + 512 + sc_ + j]; mu_v[j] = p.in[11][l * 1792 + 1024 + sc_ + j];
    kk_c[j] = p.in[16][l * 512 + sc_ + j]; ka_c[j] = p.in[17][l * 512 + sc_ + j];
  }
  const bf16_t* Wd = w.R1 + (size_t)(0 * 2 + dir) * T * 512;
  const bf16_t* Ad = w.R1 + (size_t)(1 * 2 + dir) * T * 512;
  bf16_t* yout = w.R2 + (size_t)dir * T * 512;
  constexpr int BUF = 6 * 1024 + 32;
  const int kg = lane & 15, rs = lane >> 4, row = rq * 16 + wid * 4 + rs;
  f2v SA = {0.f, 0.f}, SB = {0.f, 0.f};
  struct RPre { uint2 pq[3][3], pwd, pad_; float psc[3], pmk[2]; };
  RPre PA, PB;
  auto load = [&](int c, RPre& P) {
    int ii = pos2i(c * 16 + sj, dir);
    size_t tok = (size_t)b * TPB + ii;
    const bf16_t* prow = w.pB + tok * SPB + sc_;
    bool hp = (ii != 0) && (ii != CTXL), hn = (ii != CTXL - 1) && (ii != TPB - 1);
    const int op = hp ? -SPB : 0, on = hn ? SPB : 0;
    P.pmk[0] = hp ? 0.5f : 0.f; P.pmk[1] = hn ? 0.5f : 0.f;
#pragma unroll
    for (int q = 0; q < 3; ++q) {
      P.pq[q][0] = *(const uint2*)(prow + q * 512);
      P.pq[q][1] = *(const uint2*)(prow + q * 512 + op);
      P.pq[q][2] = *(const uint2*)(prow + q * 512 + on);
    }
    P.pwd = *(const uint2*)(Wd + tok * 512 + sc_);
    P.pad_ = *(const uint2*)(Ad + tok * 512 + sc_);
    const float* sc = w.bonus + (tok * 8 + hd) * 8;
    P.psc[0] = sc[0]; P.psc[1] = sc[1 + 3 * dir]; P.psc[2] = sc[2 + 3 * dir];
  };
  auto up4 = [](uint2 u, float* f) { f[0] = __uint_as_float(u.x << 16); f[1] = __uint_as_float(u.x & 0xffff0000u); f[2] = __uint_as_float(u.y << 16); f[3] = __uint_as_float(u.y & 0xffff0000u); };
  auto stage = [&](const RPre& P, float* bufp) {
    float rc[4], rp[4], rn[4], kc[4], kp[4], kn[4], vc[4], vp[4], vn[4], wd4[4], ad4[4];
    up4(P.pq[0][0], rc); up4(P.pq[0][1], rp); up4(P.pq[0][2], rn);
    up4(P.pq[1][0], kc); up4(P.pq[1][1], kp); up4(P.pq[1][2], kn);
    up4(P.pq[2][0], vc); up4(P.pq[2][1], vp); up4(P.pq[2][2], vn);
    up4(P.pwd, wd4); up4(P.pad_, ad4);
    float o0[4], o1[4], o2[4], o3[4], o4[4], o5[4];
#pragma unroll
    for (int j = 0; j < 4; ++j) {
      float r_s = rc[j] + ((P.pmk[0] * rp[j] + P.pmk[1] * rn[j]) - rc[j]) * mu_r[j];
      float k_s = kc[j] + ((P.pmk[0] * kp[j] + P.pmk[1] * kn[j]) - kc[j]) * mu_k[j];
      float v_s = vc[j] + ((P.pmk[0] * vp[j] + P.pmk[1] * vn[j]) - vc[j]) * mu_v[j];
      float kk = k_s * kk_c[j] * P.psc[0];
      float a = ad4[j], wv = 1.f - wd4[j];
      o0[j] = -kk; o1[j] = wv * r_s; o2[j] = wv; o3[j] = kk * a; o4[j] = k_s * (1.f + (a - 1.f) * ka_c[j]); o5[j] = v_s;
    }
    float* d = bufp + sj * 64 + skq;
    *(float4*)(d + 0 * 1024) = make_float4(o0[0], o0[1], o0[2], o0[3]);
    *(float4*)(d + 1 * 1024) = make_float4(o1[0], o1[1], o1[2], o1[3]);
    *(float4*)(d + 2 * 1024) = make_float4(o2[0], o2[1], o2[2], o2[3]);
    *(float4*)(d + 3 * 1024) = make_float4(o3[0], o3[1], o3[2], o3[3]);
    *(float4*)(d + 4 * 1024) = make_float4(o4[0], o4[1], o4[2], o4[3]);
    *(float4*)(d + 5 * 1024) = make_float4(o5[0], o5[1], o5[2], o5[3]);
    if (skq == 0) *(float2*)(bufp + 6 * 1024 + sj * 2) = make_float2(P.psc[1], P.psc[2]);
  };
  float* sY = sm + 2 * BUF;
  const int prow16 = wid * 4 + rs;
  const int ysel = (kg == 0) ? prow16 : (512 + tid);
  struct RStep { f4v a4, wr4, w4, b4, k4; float vv; float2 sc; };
  auto lds_step = [&](const float* bf, int j) {
    RStep q;
    q.a4 = *(const f4v*)(bf + 0 * 1024 + j * 64 + 4 * kg);
    q.wr4 = *(const f4v*)(bf + 1 * 1024 + j * 64 + 4 * kg);
    q.w4 = *(const f4v*)(bf + 2 * 1024 + j * 64 + 4 * kg);
    q.b4 = *(const f4v*)(bf + 3 * 1024 + j * 64 + 4 * kg);
    q.k4 = *(const f4v*)(bf + 4 * 1024 + j * 64 + 4 * kg);
    q.vv = bf[5 * 1024 + j * 64 + row];
    q.sc = *(const float2*)(bf + 6 * 1024 + j * 2);
    return q;
  };
  auto flush = [&](int c) {
    {
      int j = tid >> 4, rr = tid & 15;
      int ii = pos2i(c * 16 + j, dir);
      yout[((size_t)b * TPB + ii) * 512 + hd * 64 + rq * 16 + rr] = f2bf(sY[(c & 1) * 256 + j * 16 + rr]);
    }
  };
  __syncthreads();
  load(0, PA);
  stage(PA, sm);
  load(1, PB);
  __syncthreads();
  const int NCH = TPB / 16;
  auto run_chunk = [&](int c, const float* bf, float* sy) {
    flush(max(c - 1, 0));
    RStep cur = lds_step(bf, 0);
#pragma unroll
    for (int j = 0; j < 16; ++j) {
      RStep nxt = cur;
      if (j + 1 < 16) nxt = lds_step(bf, j + 1);
      f2v sa2 = SA * cur.a4.xy + SB * cur.a4.zw;
      f2v yp2 = SA * cur.wr4.xy + SB * cur.wr4.zw;
      float sa = sa2.x + sa2.y, yp = yp2.x + yp2.y;
      sa = row16_sum(sa); yp = row16_sum(yp);
      float y = yp + sa * cur.sc.x + cur.vv * cur.sc.y;
      SA = SA * cur.w4.xy + (sa * cur.b4.xy + cur.vv * cur.k4.xy);
      SB = SB * cur.w4.zw + (sa * cur.b4.zw + cur.vv * cur.k4.zw);
      sy[(kg == 0 ? j * 16 : 0) + ysel - (c & 1) * 0] = y;
      cur = nxt;
    }
  };
  for (int c = 0; c < NCH; c += 2) {
    load(min(c + 2, NCH - 1), PA);
    run_chunk(c, sm, sY);
    stage(PB, sm + BUF);
    __syncthreads();
    load(min(c + 3, NCH - 1), PB);
    run_chunk(c + 1, sm + BUF, sY + 256);
    stage(PA, sm);
    __syncthreads();
  }
  flush(NCH - 1);
}

DI void mamba_scan(CP p, const Ptrs& w, int l, int item, float* sm) {
  const int tid = TIDX, lane = tid & 63, wid = tid >> 6;
  const int chain = item >> 2, pq = item & 3, b = chain >> 4, hd = (chain >> 1) & 7, dir = chain & 1, gp = hd >> 2;
  const float* cw = p.in[21] + l * 3 * 1024;
  const float* cbv = p.in[22] + l * 1024;
  const int n_ = tid & 127, jh = tid >> 7;
  const int chB = 512 + gp * 128 + n_, chC = 768 + gp * 128 + n_;
  const float wB0 = cw[chB], wB1 = cw[1024 + chB], wB2 = cw[2048 + chB], bB = cbv[chB];
  const float wC0 = cw[chC], wC1 = cw[1024 + chC], wC2 = cw[2048 + chC], bC = cbv[chC];
  const int xj = tid >> 4, xp = tid & 15, chX = hd * 64 + pq * 16 + xp;
  const float wX0 = cw[chX], wX1 = cw[1024 + chX], wX2 = cw[2048 + chX], bX = cbv[chX];
  const float dtb = p.in[23][(l * 2 + dir) * 8 + hd];
  const float Aneg = -__expf(p.in[24][(l * 2 + dir) * 8 + hd]);
  const float Dsk = dir == 0 ? p.in[25][l * 8 + hd] : 0.f;
  bf16_t* yout = w.R2 + (size_t)(2 + dir) * T * 512;
  constexpr int BUF = 2 * 2048 + 256 + 256 + 64;
  const int ng = lane & 15, rs = lane >> 4, prow = wid * 4 + rs;
  f2v M0 = {0.f, 0.f}, M1 = {0.f, 0.f}, M2 = {0.f, 0.f}, M3 = {0.f, 0.f};
  struct MPre { uint4 pbq[2]; bf16_t px[3]; float pdt[3], pxm[2]; };
  MPre PA, PB;
  const bf16_t* mbc = w.W1;
  auto load = [&](int c, MPre& P) {
#pragma unroll
    for (int i = 0; i < 2; ++i) {
      int idx = tid + 256 * i, j = idx >> 5, q = idx & 31;
      int ii = pos2i(c * 16 + j, dir);
      P.pbq[i] = *(const uint4*)(mbc + ((size_t)b * TPB + ii) * 512 + (q < 16 ? 0 : 256) + gp * 128 + (q & 15) * 8);
    }
    {
      int pos = c * 16 + xj, ii = pos2i(pos, dir);
      size_t tok = (size_t)b * TPB + ii;
      const bf16_t* prw = w.pC + tok * SPC;
      bool hp = (ii != 0) && (ii != CTXL), hn = (ii != CTXL - 1) && (ii != TPB - 1);
      P.px[0] = prw[chX + (hp ? -SPC : 0)]; P.px[1] = prw[chX]; P.px[2] = prw[chX + (hn ? SPC : 0)];
      P.pxm[0] = hp ? 1.f : 0.f; P.pxm[1] = hn ? 1.f : 0.f;
      float2 dd = *(const float2*)(w.mdt + (tok * 16 + dir * 8 + hd) * 2);
      P.pdt[0] = dd.x; P.pdt[1] = dd.y; P.pdt[2] = w.mcb[tok * 2 + gp];
    }
  };
  auto stage = [&](const MPre& P, float* bufp) {
#pragma unroll
    for (int i = 0; i < 2; ++i) {
      int idx = tid + 256 * i, j = idx >> 5, q = idx & 31;
      float f[8];
      unpack8(P.pbq[i], f);
      float* d = bufp + (q < 16 ? 0 : 2048) + j * 128 + (q & 15) * 8;
      *(float4*)d = make_float4(f[0], f[1], f[2], f[3]);
      *(float4*)(d + 4) = make_float4(f[4], f[5], f[6], f[7]);
    }
    {
      float xs = siluf(wX0 * P.pxm[0] * bf2f(P.px[0]) + wX1 * bf2f(P.px[1]) + wX2 * P.pxm[1] * bf2f(P.px[2]) + bX);
      bufp[4096 + xj * 16 + xp] = xs * P.pdt[0];
      bufp[4096 + 256 + xj * 16 + xp] = Dsk * xs;
      if (xp == 0) *(float4*)(bufp + 4096 + 512 + xj * 4) = make_float4(P.pdt[1], P.pdt[2], 0.f, 0.f);
    }
  };
  float* sY = sm + 2 * BUF;
  const int ysel = (ng == 0) ? prow : (512 + tid);
  struct MStep { f4v B0, B1, C0, C1; float xq, ds; float4 sc; };
  auto lds_step = [&](const float* bf, int j) {
    MStep q;
    q.B0 = *(const f4v*)(bf + j * 128 + 8 * ng); q.B1 = *(const f4v*)(bf + j * 128 + 8 * ng + 4);
    q.C0 = *(const f4v*)(bf + 2048 + j * 128 + 8 * ng); q.C1 = *(const f4v*)(bf + 2048 + j * 128 + 8 * ng + 4);
    q.xq = bf[4096 + j * 16 + prow]; q.ds = bf[4096 + 256 + j * 16 + prow];
    q.sc = *(const float4*)(bf + 4096 + 512 + j * 4);
    return q;
  };
  auto flush = [&](int c) {
    {
      int j = tid >> 4, rr = tid & 15;
      int ii = pos2i(c * 16 + j, dir);
      yout[((size_t)b * TPB + ii) * 512 + hd * 64 + pq * 16 + rr] = f2bf(sY[(c & 1) * 256 + j * 16 + rr]);
    }
  };
  __syncthreads();
  load(0, PA);
  stage(PA, sm);
  load(1, PB);
  __syncthreads();
  const int NCH = TPB / 16;
  auto run_chunk = [&](int c, const float* bf, float* sy) {
    flush(max(c - 1, 0));
    MStep cur = lds_step(bf, 0);
#pragma unroll
    for (int j = 0; j < 16; ++j) {
      MStep nxt = cur;
      if (j + 1 < 16) nxt = lds_step(bf, j + 1);
      f2v ya = M0 * cur.C0.xy + M1 * cur.C0.zw, yb = M2 * cur.C1.xy + M3 * cur.C1.zw;
      ya += yb;
      float yp = row16_sum(ya.x + ya.y);
      float y = cur.sc.x * yp + cur.xq * cur.sc.y + cur.ds;
      const float dA = cur.sc.x, xq = cur.xq;
      M0 = M0 * dA + xq * cur.B0.xy; M1 = M1 * dA + xq * cur.B0.zw;
      M2 = M2 * dA + xq * cur.B1.xy; M3 = M3 * dA + xq * cur.B1.zw;
      sy[(ng == 0 ? j * 16 : 0) + ysel] = y;
      cur = nxt;
    }
  };
  for (int c = 0; c < NCH; c += 2) {
    load(min(c + 2, NCH - 1), PA);
    run_chunk(c, sm, sY);
    stage(PB, sm + BUF);
    __syncthreads();
    load(min(c + 3, NCH - 1), PB);
    run_chunk(c + 1, sm + BUF, sY + 256);
    stage(PA, sm);
    __syncthreads();
  }
  flush(NCH - 1);
}

DI void da_block(CP p, const Ptrs& w, int l, int b, int q0, int nkeys, int hd, bf16_t* sK, bf16_t* sV, float* smf, bf16_t* obase) {
  const int tid = TIDX, lane = tid & 63, wid = tid >> 6, r = lane & 31, h = lane >> 5;
  const int qb = wid >> 1, c = wid & 1;
  const size_t tokq = (size_t)b * TPB + q0 + qb * 32 + r;
  const bf16_t* qp = w.pD + tokq * SPD + hd * 128 + c * 64;
  bf16x8 Q0 = *(const bf16x8*)(qp + 0 * 16 + h * 8), Q1 = *(const bf16x8*)(qp + 1 * 16 + h * 8);
  bf16x8 Q2 = *(const bf16x8*)(qp + 2 * 16 + h * 8), Q3 = *(const bf16x8*)(qp + 3 * 16 + h * 8);
  const float mq = wave_max(fabsf(p.in[27][l * 64 + lane])), mk = wave_max(fabsf(p.in[28][l * 64 + lane]));
  const float Mb = 8.f * LOG2E * mq * mk + 0.5f;
  const float lam_init = 0.8f - 0.6f * __expf(-0.3f * (float)l);
  const float lam = __expf(wave_sum(p.in[29][l * 64 + lane] * p.in[30][l * 64 + lane])) - __expf(wave_sum(p.in[31][l * 64 + lane] * p.in[32][l * 64 + lane])) + lam_init;
  f32x16 O0, O1, O2, O3;
#pragma unroll
  for (int i = 0; i < 16; ++i) { O0[i] = 0.f; O1[i] = 0.f; O2[i] = 0.f; O3[i] = 0.f; }
  float ls = 0.f;
  const bf16_t* kbase = w.pD + (size_t)b * TPB * SPD + 512 + hd * 128;
  const bf16_t* vbase = w.VtD + (size_t)(b * 512 + hd * 128) * TPB;
  const int kkey = tid >> 4, kch = tid & 15, ve = tid >> 3, vch = tid & 7;
  const bf16_t* kg_ = kbase + (size_t)kkey * SPD + kch * 8;
  const bf16_t* vg_ = vbase + (size_t)ve * TPB + vch * 8;
  uint4 pk0, pk1, pk2, pk3, pv0, pv1, pv2, pv3;
#define DA_GLOAD(k0_) { const bf16_t* a_ = kg_ + (size_t)(k0_) * SPD; const bf16_t* b_ = vg_ + (k0_); \
    pk0 = *(const uint4*)(a_); pk1 = *(const uint4*)(a_ + (size_t)16 * SPD); pk2 = *(const uint4*)(a_ + (size_t)32 * SPD); pk3 = *(const uint4*)(a_ + (size_t)48 * SPD); \
    pv0 = *(const uint4*)(b_); pv1 = *(const uint4*)(b_ + (size_t)32 * TPB); pv2 = *(const uint4*)(b_ + (size_t)64 * TPB); pv3 = *(const uint4*)(b_ + (size_t)96 * TPB); }
  constexpr int DA_BUF = 64 * 136 + 128 * 72;
#define DA_STORE(bufi) { bf16_t* k_ = sK + (bufi) * DA_BUF; bf16_t* v_ = sV + (bufi) * DA_BUF; \
    *(uint4*)(k_ + (kkey) * 136 + kch * 8) = pk0; *(uint4*)(k_ + (kkey + 16) * 136 + kch * 8) = pk1; \
    *(uint4*)(k_ + (kkey + 32) * 136 + kch * 8) = pk2; *(uint4*)(k_ + (kkey + 48) * 136 + kch * 8) = pk3; \
    *(uint4*)(v_ + (ve) * 72 + vch * 8) = pv0; *(uint4*)(v_ + (ve + 32) * 72 + vch * 8) = pv1; \
    *(uint4*)(v_ + (ve + 64) * 72 + vch * 8) = pv2; *(uint4*)(v_ + (ve + 96) * 72 + vch * 8) = pv3; }
  DA_GLOAD(0)
  __syncthreads();
  DA_STORE(0)
  if (64 < nkeys) DA_GLOAD(64)
  __syncthreads();
  for (int k0 = 0; k0 < nkeys; k0 += 64) {
    const int cb_ = (k0 >> 6) & 1;
    const bf16_t* sKc = sK + cb_ * DA_BUF;
    const bf16_t* sVc = sV + cb_ * DA_BUF;
#pragma unroll
    for (int sub = 0; sub < 2; ++sub) {
      f32x16 S;
#pragma unroll
      for (int i = 0; i < 16; ++i) S[i] = -Mb;
      const bf16_t* kp = sKc + (sub * 32 + r) * 136 + c * 64 + h * 8;
      S = MFMA(*(const bf16x8*)(kp), Q0, S);
      S = MFMA(*(const bf16x8*)(kp + 16), Q1, S);
      S = MFMA(*(const bf16x8*)(kp + 32), Q2, S);
      S = MFMA(*(const bf16x8*)(kp + 48), Q3, S);
#pragma unroll
      for (int i = 0; i < 16; ++i) { S[i] = __builtin_amdgcn_exp2f(S[i]); ls += S[i]; }
      bf16x8 P0, P1;
      P0 = pack8_mfma(S[0], S[1], S[2], S[3], S[4], S[5], S[6], S[7]);
      P1 = pack8_mfma(S[8], S[9], S[10], S[11], S[12], S[13], S[14], S[15]);
#define DA_PV(OX, et)                                                                                   \
      {                                                                                                 \
        const bf16_t* vp = sVc + ((et) * 32 + r) * 72 + sub * 32 + 4 * h;                               \
        s16x4 lo = *(const s16x4*)vp, hi = *(const s16x4*)(vp + 8);                                     \
        s16x4 lo2 = *(const s16x4*)(vp + 16), hi2 = *(const s16x4*)(vp + 24);                           \
        OX = MFMA(__builtin_shufflevector(lo, hi, 0, 1, 2, 3, 4, 5, 6, 7), P0, OX);                     \
        OX = MFMA(__builtin_shufflevector(lo2, hi2, 0, 1, 2, 3, 4, 5, 6, 7), P1, OX);                   \
      }
      DA_PV(O0, 0) DA_PV(O1, 1) DA_PV(O2, 2) DA_PV(O3, 3)
#undef DA_PV
    }
    if (k0 + 64 < nkeys) {
      DA_STORE(cb_ ^ 1)
      if (k0 + 128 < nkeys) DA_GLOAD(k0 + 128)
    }
    __syncthreads();
  }
#undef DA_STORE
  ls += __shfl_xor(ls, 32);
  const float scl = c == 0 ? 1.f / ls : lam / ls;
#pragma unroll
  for (int i = 0; i < 16; ++i) { O0[i] *= scl; O1[i] *= scl; O2[i] *= scl; O3[i] *= scl; }
  __syncthreads();
  float* xb = smf + qb * 4096;
  if (c == 1) {
#pragma unroll
    for (int i = 0; i < 16; ++i) {
      int e = crow(i, h);
      xb[(e) * 32 + r] = O0[i]; xb[(32 + e) * 32 + r] = O1[i]; xb[(64 + e) * 32 + r] = O2[i]; xb[(96 + e) * 32 + r] = O3[i];
    }
  }
  __syncthreads();
  if (c == 0) {
    float ss = 0.f;
#pragma unroll
    for (int i = 0; i < 16; ++i) {
      int e = crow(i, h);
      O0[i] -= xb[(e) * 32 + r]; O1[i] -= xb[(32 + e) * 32 + r]; O2[i] -= xb[(64 + e) * 32 + r]; O3[i] -= xb[(96 + e) * 32 + r];
      ss += O0[i] * O0[i] + O1[i] * O1[i] + O2[i] * O2[i] + O3[i] * O3[i];
    }
    ss += __shfl_xor(ss, 32);
    const float inv = rsqrtf(ss * (1.f / 128.f) + 1e-6f) * (1.f - lam_init);
    const float* sub_w = p.in[33] + l * 128;
    const bf16_t* gp_ = w.pD + tokq * SPD + 1024 + hd * 128;
    bf16_t* op = obase + tokq * SPD + hd * 128;
#define DA_ST(OX, et)                                                                                   \
    _Pragma("unroll") for (int g = 0; g < 4; ++g) {                                                     \
      int e0 = (et) * 32 + 8 * g + 4 * h;                                                               \
      uint2 gg = *(const uint2*)(gp_ + e0);                                                             \
      float4 sw = *(const float4*)(sub_w + e0);                                                         \
      float g0 = bf2f((bf16_t)(gg.x & 0xffff)), g1 = bf2f((bf16_t)(gg.x >> 16)), g2 = bf2f((bf16_t)(gg.y & 0xffff)), g3 = bf2f((bf16_t)(gg.y >> 16)); \
      float o0 = OX[4 * g] * inv * sw.x * siluf(g0), o1 = OX[4 * g + 1] * inv * sw.y * siluf(g1);       \
      float o2 = OX[4 * g + 2] * inv * sw.z * siluf(g2), o3 = OX[4 * g + 3] * inv * sw.w * siluf(g3);   \
      *(uint2*)(op + e0) = make_uint2(pack2(o0, o1), pack2(o2, o3));                                    \
    }
    DA_ST(O0, 0) DA_ST(O1, 1) DA_ST(O2, 2) DA_ST(O3, 3)
#undef DA_ST
  }
}

DI void na_wave(CP p, const Ptrs& w, int l, int witem, bool ctxq, bf16_t* obase) {
  const int lane = TIDX & 63, r = lane & 31, h = lane >> 5;
  int b, hd, qi, gr0 = 0, cq = 0, qrow = 0, qcol = 0;
  if (!ctxq) {
    hd = witem & 7; cq = (witem >> 3) & 3; gr0 = ((witem >> 5) & 63) * 2; b = witem >> 11;
    qrow = gr0 + (r >> 4); qcol = cq * 16 + (r & 15); qi = CTXL + qrow * 64 + qcol;
  } else { hd = witem & 7; int qt = (witem >> 3) & 7; b = witem >> 6; qi = qt * 32 + r; }
  const size_t tokq = (size_t)b * TPB + qi;
  const bf16_t* qp = w.pA + tokq * SPA + hd * 64;
  bf16x8 Q[4];
#pragma unroll
  for (int s = 0; s < 4; ++s) Q[s] = *(const bf16x8*)(qp + s * 16 + h * 8);
  const float mq = wave_max(fabsf(p.in[8][l * 64 + lane])), mk = wave_max(fabsf(p.in[9][l * 64 + lane]));
  const float* rpb = p.in[10] + (size_t)(l * 8 + hd) * 15 * 31;
  float mb = 0.f;
  for (int e = lane; e < 465; e += 64) mb = fmaxf(mb, fabsf(rpb[e]));
  mb = wave_max(mb);
  const float Mb = 8.f * LOG2E * mq * mk + mb * LOG2E + 0.5f;
  f32x16 O[2];
#pragma unroll
  for (int e = 0; e < 2; ++e)
#pragma unroll
    for (int i = 0; i < 16; ++i) O[e][i] = 0.f;
  float ls = 0.f;
  const bf16_t* kbase = w.pA + (size_t)b * TPB * SPA + 512 + hd * 64;
  const bf16_t* vbase = w.VtA + (size_t)(b * 512 + hd * 64) * TPB;
  const int r0q = min(max(qrow - 4, 0), 120);
  const int c0 = min(max(qcol - 8, 0), 48);
  const int kr_lo = min(max(gr0 - 4, 0), 120), kr_hi = min(max(gr0 - 3, 0), 120) + 8;
  const int kc0 = min(max(cq * 16 - 8, 0), 32);
  const int ntile = ctxq ? 8 : 8 + (kr_hi - kr_lo);
  auto kidx = [&](int t) { return t < 8 ? t * 32 : CTXL + (kr_lo + (t - 8)) * 64 + kc0; };
  bf16x8 nK0, nK1, nK2, nK3;
  s16x4 nV[8];
#define NA_LOAD(t_) { const int ki_ = kidx(t_); const bf16_t* kp_ = kbase + (size_t)(ki_ + r) * SPA + h * 8; \
    nK0 = *(const bf16x8*)(kp_); nK1 = *(const bf16x8*)(kp_ + 16); nK2 = *(const bf16x8*)(kp_ + 32); nK3 = *(const bf16x8*)(kp_ + 48); \
    _Pragma("unroll") for (int et = 0; et < 2; ++et) _Pragma("unroll") for (int s2 = 0; s2 < 2; ++s2) { \
      const bf16_t* vp_ = vbase + (size_t)(et * 32 + r) * TPB + ki_ + s2 * 16 + 4 * h; \
      nV[(et * 2 + s2) * 2] = *(const s16x4*)vp_; nV[(et * 2 + s2) * 2 + 1] = *(const s16x4*)(vp_ + 8); } }
  NA_LOAD(0)
  for (int t = 0; t < ntile; ++t) {
    bool local = t >= 8;
    const int kr = kr_lo + (t - 8);
    bf16x8 cK0 = nK0, cK1 = nK1, cK2 = nK2, cK3 = nK3;
    s16x4 cV[8];
#pragma unroll
    for (int i = 0; i < 8; ++i) cV[i] = nV[i];
    if (t + 1 < ntile) NA_LOAD(t + 1)
    f32x16 S;
#pragma unroll
    for (int i = 0; i < 16; ++i) S[i] = -Mb;
    S = MFMA(cK0, Q[0], S); S = MFMA(cK1, Q[1], S); S = MFMA(cK2, Q[2], S); S = MFMA(cK3, Q[3], S);
    if (local) {
      const bool row_ok = (kr >= r0q) && (kr < r0q + 8);
      const float* rp = rpb + min(max(kr - qrow + 7, 0), 14) * 31;
#pragma unroll
      for (int i = 0; i < 16; ++i) {
        int kcol = kc0 + crow(i, h);
        bool ok = row_ok && (kcol >= c0) && (kcol < c0 + 16);
        int dc = min(max(kcol - qcol + 15, 0), 30);
        float bias = rp[dc] * LOG2E;
        S[i] = ok ? __builtin_amdgcn_exp2f(S[i] + bias) : 0.f;
      }
    } else {
#pragma unroll
      for (int i = 0; i < 16; ++i) S[i] = __builtin_amdgcn_exp2f(S[i]);
    }
    bf16x8 P[2];
#pragma unroll
    for (int i = 0; i < 16; ++i) ls += S[i];
#pragma unroll
    for (int s2 = 0; s2 < 2; ++s2) {
      P[s2] = pack8_mfma(S[8 * s2 + 0], S[8 * s2 + 1], S[8 * s2 + 2], S[8 * s2 + 3], S[8 * s2 + 4], S[8 * s2 + 5], S[8 * s2 + 6], S[8 * s2 + 7]);
    }
#pragma unroll
    for (int et = 0; et < 2; ++et)
#pragma unroll
      for (int s2 = 0; s2 < 2; ++s2) {
        bf16x8 vf = __builtin_shufflevector(cV[(et * 2 + s2) * 2], cV[(et * 2 + s2) * 2 + 1], 0, 1, 2, 3, 4, 5, 6, 7);
        O[et] = MFMA(vf, P[s2], O[et]);
      }
  }
#undef NA_LOAD
  ls += __shfl_xor(ls, 32);
  const float inv = 1.f / ls;
  const bf16_t* gp_ = w.pA + tokq * SPA + 1024 + hd * 64;
  bf16_t* op = obase + tokq * SPA + hd * 64;
#pragma unroll
  for (int et = 0; et < 2; ++et)
#pragma unroll
    for (int g = 0; g < 4; ++g) {
      int e0 = et * 32 + 8 * g + 4 * h;
      uint2 gg = *(const uint2*)(gp_ + e0);
      float g0 = bf2f((bf16_t)(gg.x & 0xffff)), g1 = bf2f((bf16_t)(gg.x >> 16)), g2 = bf2f((bf16_t)(gg.y & 0xffff)), g3 = bf2f((bf16_t)(gg.y >> 16));
      float o0 = O[et][4 * g] * inv * siluf(g0), o1 = O[et][4 * g + 1] * inv * siluf(g1);
      float o2 = O[et][4 * g + 2] * inv * siluf(g2), o3 = O[et][4 * g + 3] * inv * siluf(g3);
      *(uint2*)(op + e0) = make_uint2(pack2(o0, o1), pack2(o2, o3));
    }
}

template <int MM, int DUMMY = 0>
DI void phase_mixers(CP p, const Ptrs& w, int l, float* sm) {
  __shared__ int s_item;
  const bool ctxo = (l == 0);
  const int n_scan = (MM & 1) ? 256 : 0, n_da = (MM & 2) ? 1024 : 0, n_dac = ((MM & 2) && ctxo) ? 32 : 0;
  const int n_na = (MM & 4) ? 1024 : 0, n_nac = ((MM & 4) && ctxo) ? 32 : 0;
  const int total = n_scan + n_da + n_dac + n_na + n_nac;
  int* ctr = &w.ctr[l * 16 + MM + ((MM != 1) ? DUMMY * 8 : 0)];
  bf16_t* oD = DUMMY ? w.R1 : w.pD; bf16_t* oA = DUMMY ? w.R1 : w.pA;
  if constexpr (MM == 1 && DUMMY == 1) {
    __syncthreads();
    if (TIDX == 0) {
      unsigned hw = (unsigned)__builtin_amdgcn_s_getreg((31 << 11) | 4);
      unsigned key = ((hw >> 8) & 0xffu) | (xb_xcc_id() << 8);
      s_item = atomicAdd(&w.cuf[l * 4096 + key], 1);
    }
    __syncthreads();
    int first = s_item;
    if (first != 0) return;
  }
  for (;;) {
    __syncthreads();
    if (TIDX == 0) s_item = atomicAdd(ctr, 1);
    __syncthreads();
    int it = s_item;
    if (it >= total) break;
    if constexpr ((MM & 1) != 0) {
      if (it < 128) { __builtin_amdgcn_s_setprio(3); rwkv_scan(p, w, l, it, sm); __builtin_amdgcn_s_setprio(0); if (DUMMY) break; continue; }
      if (it < 256) { __builtin_amdgcn_s_setprio(3); mamba_scan(p, w, l, it - 128, sm); __builtin_amdgcn_s_setprio(0); if (DUMMY) break; continue; }
      it -= 256;
    }
    if constexpr ((MM & 2) != 0) {
      if (it < n_da) { int hd = it & 3, qt = (it >> 2) & 127, b = it >> 9; da_block(p, w, l, b, CTXL + qt * 64, TPB, hd, (bf16_t*)sm, (bf16_t*)sm + 64 * 136, sm, oD); continue; }
      it -= n_da;
      if (it < n_dac) { int hd = it & 3, qt = (it >> 2) & 3, b = it >> 4; da_block(p, w, l, b, qt * 64, CTXL, hd, (bf16_t*)sm, (bf16_t*)sm + 64 * 136, sm, oD); continue; }
      it -= n_dac;
    }
    if constexpr ((MM & 4) != 0) {
      if (it < n_na) { na_wave(p, w, l, it * 4 + (TIDX >> 6), false, oA); continue; }
      it -= n_na;
      na_wave(p, w, l, it * 4 + (TIDX >> 6), true, oA);
    }
  }
}

DI void phase_finish(CP p, const Ptrs& w, int l) {
  const int lane = TIDX & 63, gw = BIDX * 4 + (TIDX >> 6), nw = GDIM * 4;
  const int c0 = lane * 8, hd = lane >> 3;
  float lnw[8], lnb[8], muv[8], nrm[8];
#pragma unroll
  for (int j = 0; j < 8; ++j) { lnw[j] = p.in[19][l * 512 + c0 + j]; lnb[j] = p.in[20][l * 512 + c0 + j]; muv[j] = p.in[11][l * 1792 + 1024 + c0 + j]; nrm[j] = p.in[26][l * 512 + c0 + j]; }
  const bf16_t* yB0 = w.R2, *yB1 = w.R2 + (size_t)T * 512, *yM0 = w.R2 + (size_t)2 * T * 512, *yM1 = w.R2 + (size_t)3 * T * 512;
  for (int tok = gw; tok < T; tok += nw) {
    int b = tok / TPB, i = tok - b * TPB;
    if (l != 0 && i < CTXL) continue;
    bool hp = (i != 0) && (i != CTXL), hn = (i != CTXL - 1) && (i != TPB - 1);
    bf16_t* rb = w.pB + (size_t)tok * SPB;
    bf16_t* rc = w.pC + (size_t)tok * SPC + 1040;
    uint4 u0 = *(const uint4*)(yB0 + (size_t)tok * 512 + c0), u1 = *(const uint4*)(yB1 + (size_t)tok * 512 + c0);
    uint4 uv = *(const uint4*)(rb + 1024 + c0), up = make_uint4(0, 0, 0, 0), un = make_uint4(0, 0, 0, 0);
    if (hp) up = *(const uint4*)(rb + 1024 + c0 - SPB);
    if (hn) un = *(const uint4*)(rb + 1024 + c0 + SPB);
    uint4 ug = *(const uint4*)(rb + 1792 + c0);
    const float* bsc = w.bonus + ((size_t)tok * 8 + hd) * 8;
    float2 bon2 = make_float2(bsc[3], bsc[6]);
    uint4 m0 = *(const uint4*)(yM0 + (size_t)tok * 512 + c0), m1 = *(const uint4*)(yM1 + (size_t)tok * 512 + c0);
    uint4 uz = *(const uint4*)(rc + c0);
    float y[8], t[8], vv[8], vp[8], vn[8], g[8];
    unpack8(u0, y); unpack8(u1, t);
    float sm_ = 0.f;
#pragma unroll
    for (int j = 0; j < 8; ++j) { y[j] += t[j]; sm_ += y[j]; }
    float mean = row8_sum(sm_) * (1.f / 64.f);
    float vs = 0.f;
#pragma unroll
    for (int j = 0; j < 8; ++j) { y[j] -= mean; vs += y[j] * y[j]; }
    float rstd = rsqrtf(row8_sum(vs) * (1.f / 64.f) + 64e-5f);
    unpack8(uv, vv); unpack8(up, vp); unpack8(un, vn); unpack8(ug, g);
    float bon = bon2.x + bon2.y;
#pragma unroll
    for (int j = 0; j < 8; ++j) {
      float yn = y[j] * rstd * lnw[j] + lnb[j];
      float v_s = vv[j] + (0.5f * (vp[j] + vn[j]) - vv[j]) * muv[j];
      t[j] = (yn + bon * v_s) * siluf(g[j]);
    }
    *(uint4*)(rb + 1792 + c0) = pack8(t);
    unpack8(m0, y); unpack8(m1, t); unpack8(uz, g);
    float ss = 0.f;
#pragma unroll
    for (int j = 0; j < 8; ++j) { y[j] = (y[j] + t[j]) * siluf(g[j]); ss += y[j] * y[j]; }
    ss = row16_sum(ss); ss += __shfl_xor(ss, 16);
    float inv = rsqrtf(ss * (1.f / 256.f) + 1e-6f);
#pragma unroll
    for (int j = 0; j < 8; ++j) t[j] = y[j] * inv * nrm[j];
    *(uint4*)(rc + c0) = pack8(t);
  }
}

DI void phase_merge(CP p, const Ptrs& w, int l, bf16_t* sA, bf16_t* sB, unsigned* sU) {
  const int tid = TIDX, lane = tid & 63, wid = tid >> 6, wm = wid >> 1, wn = wid & 1, r = lane & 31, h = lane >> 5;
  const bf16_t* gate_t = (const bf16_t*)((const char*)w.R1 + R1_GATE);
  const bf16_t* up_t = (const bf16_t*)((const char*)w.R1 + R1_UP);
  const int nmt = l == 0 ? 132 : 128;
  const int nrounds = tile_rounds(nmt, 16);
  for (int kk = 0; kk < nrounds; ++kk) {
    int mt, nt;
    if (!tile_map(kk, nmt, 16, mt, nt)) continue;
    if (l != 0) mt += mt < 64 ? 2 : 4;
    int m0 = mt * 128, n0 = nt * 128;
    unsigned totp[2][2][8];
#pragma unroll
    for (int a = 0; a < 2; ++a)
#pragma unroll
      for (int c = 0; c < 2; ++c)
#pragma unroll
        for (int i = 0; i < 8; ++i) totp[a][c][i] = 0u;
#pragma unroll 1
    for (int br = 0; br < 4; ++br) {
      const bf16_t* ys; int lds_;
      if (br == 0) { ys = w.pA; lds_ = SPA; } else if (br == 1) { ys = w.pB + 1792; lds_ = SPB; } else if (br == 2) { ys = w.pC + 1040; lds_ = SPC; } else { ys = w.pD; lds_ = SPD; }
      {
        f32x16 U[2][2];
        zero_acc(U);
        gemm_128_2set(ys + (size_t)m0 * lds_, lds_, up_t + (size_t)(br * 2048 + n0) * 512, 512, 512, U, sA, sB);
#pragma unroll
        for (int a = 0; a < 2; ++a)
#pragma unroll
          for (int c = 0; c < 2; ++c)
#pragma unroll
            for (int i = 0; i < 8; ++i) sU[((a * 2 + c) * 8 + i) * 256 + tid] = pack2(U[a][c][2 * i], U[a][c][2 * i + 1]);
      }
      f32x16 G[2][2];
      zero_acc(G);
      gemm_128_2set(w.H + (size_t)m0 * 2048, 2048, gate_t + (size_t)(br * 2048 + n0) * 2048, 2048, 2048, G, sA, sB);
#pragma unroll
      for (int a = 0; a < 2; ++a)
#pragma unroll
        for (int c = 0; c < 2; ++c)
#pragma unroll
          for (int i = 0; i < 8; ++i) {
            unsigned uv = sU[((a * 2 + c) * 8 + i) * 256 + tid];
            float u0 = __uint_as_float(uv << 16), u1 = __uint_as_float(uv & 0xffff0000u);
            const unsigned tv = totp[a][c][i];
            float t0 = __uint_as_float(tv << 16) + sigmf(G[a][c][2 * i]) * u0;
            float t1 = __uint_as_float(tv & 0xffff0000u) + sigmf(G[a][c][2 * i + 1]) * u1;
            totp[a][c][i] = pack2(t0, t1);
          }
    }
    bf16_t* dst = w.R2;
#pragma unroll
    for (int mi = 0; mi < 2; ++mi)
#pragma unroll
      for (int ni = 0; ni < 2; ++ni)
#pragma unroll
        for (int i = 0; i < 16; ++i) {
          int row = m0 + wm * 64 + mi * 32 + crow(i, h), col = n0 + wn * 64 + ni * 32 + r;
          const unsigned tv = totp[mi][ni][i >> 1];
          dst[(size_t)row * 2048 + col] = (bf16_t)((i & 1) ? (tv >> 16) : (tv & 0xffffu));
        }
  }
}

DI void phase_out(CP p, const Ptrs& w, int l, bf16_t* sA, bf16_t* sB) {
  const int tid = TIDX, lane = tid & 63, wid = tid >> 6, wm = wid >> 1, wn = wid & 1, r = lane & 31, h = lane >> 5;
  const bf16_t* out_t = (const bf16_t*)((const char*)w.R1 + R1_OUT);
  const int nmt = l == 0 ? 132 : 128;
  const int nrounds = tile_rounds(nmt, 16);
  for (int kk = 0; kk < nrounds; ++kk) {
    int mt, nt;
    if (!tile_map(kk, nmt, 16, mt, nt)) continue;
    if (l != 0) mt += mt < 64 ? 2 : 4;
    int m0 = mt * 128, n0 = nt * 128;
    int b = m0 / TPB, ib = m0 - b * TPB;
    bool isctx = ib < CTXL;
    f32x16 acc[2][2];
    zero_acc(acc);
    gemm_128_deep(w.R2 + (size_t)m0 * 2048, 2048, out_t + (size_t)n0 * 2048, 2048, 2048, acc, sA, sB);
    const float* gate = w.mod + (l * 3 + (isctx ? 2 : b)) * 6144 + 4096;
#pragma unroll
    for (int mi = 0; mi < 2; ++mi)
#pragma unroll
      for (int ni = 0; ni < 2; ++ni) {
        int col = n0 + wn * 64 + ni * 32 + r;
        float gt = gate[col];
#pragma unroll
        for (int i = 0; i < 16; ++i) {
          int ii = ib + wm * 64 + mi * 32 + crow(i, h);
          const float* src = xrow(p, w, l, b * TPB + ii);
          float* dstp = isctx ? w.xc1 + (size_t)(b * CTXL + ii) * DM : p.out + (size_t)(b * 8192 + ii - CTXL) * DM;
          dstp[col] = src[col] + gt * acc[mi][ni][i];
        }
      }
  }
}

constexpr int SMEM_BYTES = 4 * 128 * 72 * 2;
constexpr int NPH = 18;
#ifndef ONE_LAUNCH
#define ONE_LAUNCH 1
#endif
#ifndef PHMASK
#define PHMASK 0x1ff
#endif

template <int SP>
DI void run_phase(int l, char* smem_raw) {
  CP p = launder_params();
  const Ptrs w = mkptrs(p.ws);
  float* smf = (float*)smem_raw;
  bf16_t* sA = (bf16_t*)smem_raw;
  bf16_t* sB = sA + 128 * 72;
  if constexpr (SP == 0) {
    if (l == 0) {
      if (BIDX == 0 && TIDX < 64) w.ctr[TIDX] = 0;
      if (BIDX >= 2 && BIDX < 34) w.cuf[(BIDX - 2) * 256 + TIDX] = 0;
      if (BIDX == 1) for (int e = TIDX; e < 2048; e += 256) { float ang = (float)(e >> 4) * exp2f(-(float)(e & 15) * (13.287712379549449f / 16.f)); w.rope[2 * e] = cosf(ang); w.rope[2 * e + 1] = sinf(ang); }
      for (int it = BIDX; it < 384; it += GDIM) phase_ada_item(p, w, 0, it, 4, smf);
      conv_w1(p, w, 0, smf);
    }
    conv_w3(p, w, l, smf);
  } else if constexpr (SP == 1) phase_norm(p, w, l);
  else if constexpr (SP == 2) phase_inproj(p, w, l, sA, sB);
  else if constexpr (SP == 3) {
    phase_prep(p, w, l);
  } else if constexpr (SP == 4) phase_lora(p, w, l, sA, sB);
  else if constexpr (SP == 5) phase_mixers<1>(p, w, l, smf);
  else if constexpr (SP == 9) phase_mixers<2>(p, w, l, smf);
  else if constexpr (SP == 10) phase_mixers<4>(p, w, l, smf);
  else if constexpr (SP == 13) phase_rwscal(p, w, l);
  else if constexpr (SP == 14) phase_mixers<1, 1>(p, w, l, smf);
  else if constexpr (SP == 11) phase_mixers<2, 1>(p, w, l, smf);
  else if constexpr (SP == 12) phase_mixers<4, 1>(p, w, l, smf);
  else if constexpr (SP == 6) {
    conv_w2(p, w, l, smf);
    if (l + 1 < 2) conv_w1(p, w, l + 1, smf);
    phase_finish(p, w, l);
  } else if constexpr (SP == 7) phase_merge(p, w, l, sA, sB, (unsigned*)(smem_raw + 2 * 128 * 72 * 2));
  else phase_out(p, w, l, sA, sB);
}

template <int SP>
__global__ void __launch_bounds__(256, 2) phase_kernel(Params p, int l) {
  __shared__ __attribute__((aligned(16))) char smem_raw[SMEM_BYTES];
  run_phase<SP>(l, smem_raw);
}

template <int SP>
__device__ __attribute__((noinline)) void run_phase_ni(int l, char* smem_raw) {
  run_phase<SP>(l, smem_raw);
}
#ifndef CMASK
#define CMASK 0x7fff
#endif
#ifndef DUPMASK
#define DUPMASK 0
#endif
#define RUNP(k) if ((CMASK & (1 << k)) && (pmask & (1 << k))) { run_phase<k>(RP_ARGS); if ((DUPMASK & (1 << k)) && (k != 8 || l == 0)) { xcd_barrier(xb); run_phase<k>(RP_ARGS); } }
#ifdef NOINL
#define run_phase run_phase_ni
#define RP_ARGS l, smem_raw
#else
#define RP_ARGS l, smem_raw
#endif
__global__ void __launch_bounds__(256, 2) fwd_kernel(Params p) {
  __shared__ __attribute__((aligned(16))) char smem_raw[SMEM_BYTES];
#if ONE_LAUNCH
  __shared__ uint4 xb_words;
  if (threadIdx.x == 0) xb_words = make_uint4(0u, 0u, 0u, 0u);
  __syncthreads();
  XcdBarrier xb = xcd_barrier_post((unsigned*)(launder_params().ws + OFF_BAR), (volatile LAS unsigned*)&xb_words);
  const int lmask = launder_params().ph_lo, pmask = launder_params().ph_hi;
#ifdef PROBE_SYNC
  for (int q = 0; q < 50; ++q) xcd_barrier(xb);
#endif
  for (int l = 0; l < 2; ++l) {
    if (!((lmask >> l) & 1)) continue;
    RUNP(0); xcd_barrier(xb);
    if (lmask == 0x7fffffff) cg::this_grid().sync();
    RUNP(1); xcd_barrier(xb);
    RUNP(2); xcd_barrier(xb);
    RUNP(3); xcd_barrier(xb);
    RUNP(4); xcd_barrier(xb);
    RUNP(13); xcd_barrier(xb);
#ifndef SEQMIX
#define SEQMIX 0
#endif
    RUNP(14); if (SEQMIX) xcd_barrier(xb);
#ifdef PROBE_DA
    RUNP(11); xcd_barrier(xb);
#endif
#ifdef PROBE_NA
    RUNP(12); xcd_barrier(xb);
#endif
    RUNP(9); if (SEQMIX) xcd_barrier(xb); RUNP(10); RUNP(5); xcd_barrier(xb);
    RUNP(6); xcd_barrier(xb);
    RUNP(7); xcd_barrier(xb);
    RUNP(8); xcd_barrier(xb);
  }
#endif
}


extern "C" void kernel_launch(void* const* d_in, const int* in_sizes, int n_in, void* d_out, int out_size, void* d_ws, size_t ws_size, hipStream_t stream) {
  static int grid_blocks = 0;
  if (!grid_blocks) {
    int dev = 0, cus = 0, per_cu = 0;
    (void)hipGetDevice(&dev);
    (void)hipDeviceGetAttribute(&cus, hipDeviceAttributeMultiprocessorCount, dev);
    (void)hipOccupancyMaxActiveBlocksPerMultiprocessor(&per_cu, fwd_kernel, 256, 0);
    if (per_cu > 2) per_cu = 2;
    if (per_cu < 1) per_cu = 1;
    grid_blocks = cus * per_cu;
  }
  if (n_in < 37 || ws_size < WS_NEED) { fprintf(stderr, "bad args: n_in=%d ws=%zu need=%zu\n", n_in, ws_size, (size_t)WS_NEED); return; }
  Params p;
  memset(&p, 0, sizeof(p));
  for (int i = 0; i < 37; ++i) p.in[i] = (const float*)d_in[i];
  p.out = (float*)d_out;
  p.ws = (char*)d_ws;
#if ONE_LAUNCH
  p.ph_lo = 3; p.ph_hi = 0x7fff;
  (void)hipMemsetAsync((char*)d_ws + OFF_BAR, 0, XCD_BAR_WORDS * 4, stream);
  (void)hipMemsetAsync((char*)d_ws + OFF_MOD, 0, 3 * 6144 * 4, stream);
  void* args[] = {&p};
  hipError_t e = hipLaunchCooperativeKernel((void*)fwd_kernel, dim3(grid_blocks), dim3(256), args, 0, stream);
  if (e != hipSuccess) fprintf(stderr, "cooperative launch failed: %s (grid %d)\n", hipGetErrorString(e), grid_blocks);
#ifdef PROBE_EXTRA
  {
    (void)hipMemsetAsync((char*)d_ws + OFF_BAR, 0, XCD_BAR_WORDS * 4, stream);
    Params p2 = p; p2.ph_lo = 1; p2.ph_hi = PROBE_EXTRA;
    void* args2[] = {&p2};
    (void)hipLaunchCooperativeKernel((void*)fwd_kernel, dim3(grid_blocks), dim3(256), args2, 0, stream);
  }
#endif
#else
  for (int l = 0; l < 2; ++l) {
    hipLaunchKernelGGL(phase_kernel<0>, dim3(grid_blocks), dim3(256), 0, stream, p, l);
    hipLaunchKernelGGL(phase_kernel<1>, dim3(grid_blocks), dim3(256), 0, stream, p, l);
    hipLaunchKernelGGL(phase_kernel<2>, dim3(grid_blocks), dim3(256), 0, stream, p, l);
    hipLaunchKernelGGL(phase_kernel<3>, dim3(grid_blocks), dim3(256), 0, stream, p, l);
    hipLaunchKernelGGL(phase_kernel<4>, dim3(grid_blocks), dim3(256), 0, stream, p, l);
    hipLaunchKernelGGL(phase_kernel<5>, dim3(grid_blocks), dim3(256), 0, stream, p, l);
    hipLaunchKernelGGL(phase_kernel<9>, dim3(grid_blocks), dim3(256), 0, stream, p, l);
    hipLaunchKernelGGL(phase_kernel<10>, dim3(grid_blocks), dim3(256), 0, stream, p, l);
    hipLaunchKernelGGL(phase_kernel<6>, dim3(grid_blocks), dim3(256), 0, stream, p, l);
    hipLaunchKernelGGL(phase_kernel<7>, dim3(grid_blocks), dim3(256), 0, stream, p, l);
    hipLaunchKernelGGL(phase_kernel<8>, dim3(grid_blocks), dim3(256), 0, stream, p, l);
  }
#endif
}
```

```cpp
#include <hip/hip_runtime.h>
#include <hip/hip_cooperative_groups.h>
#include <stdint.h>
#include <cstdio>
#include <cstring>
namespace cg = cooperative_groups;

typedef unsigned short bf16_t;
typedef __attribute__((ext_vector_type(8))) short bf16x8;
typedef __attribute__((ext_vector_type(4))) short s16x4;
typedef __attribute__((ext_vector_type(16))) float f32x16;
typedef __attribute__((ext_vector_type(2))) float f2v;
typedef __attribute__((ext_vector_type(4))) float f4v;
#define DI __device__ __forceinline__
#define MFMA(a, b, c) __builtin_amdgcn_mfma_f32_32x32x16_bf16((a), (b), (c), 0, 0, 0)

constexpr int DM = 2048, TPB = 8448, T = 16896, CTXL = 256;
constexpr int SPA = 1536, SPB = 2304, SPC = 1664, SPD = 1536;
constexpr int NPAD = 8064;
constexpr float LOG2E = 1.4426950408889634f;
constexpr float QS = 0.125f * LOG2E;

constexpr size_t al256(size_t x) { return (x + 255) & ~(size_t)255; }
constexpr size_t OFF_MOD = 0;
constexpr size_t OFF_CTR = al256(OFF_MOD + 2 * 3 * 6144 * 4);
constexpr size_t OFF_BAR = al256(OFF_CTR + 256);
constexpr size_t OFF_CUF = al256(OFF_BAR + 3456 * 4);
constexpr size_t OFF_ROPE = al256(OFF_CUF + 2 * 4096 * 4);
constexpr size_t OFF_BONUS = al256(OFF_ROPE + 128 * 16 * 8);
constexpr size_t OFF_MDT = al256(OFF_BONUS + (size_t)T * 64 * 4);
constexpr size_t OFF_MCB = al256(OFF_MDT + (size_t)T * 32 * 4);
constexpr size_t OFF_W3 = al256(OFF_MCB + (size_t)T * 2 * 4);
constexpr size_t OFF_LA = al256(OFF_W3 + 4 * 512 * 64 * 2);
constexpr size_t OFF_XC1 = al256(OFF_LA + (size_t)T * 256 * 2);
constexpr size_t OFF_W1 = al256(OFF_XC1 + (size_t)2 * 256 * 2048 * 4);
constexpr size_t OFF_H = al256(OFF_W1 + (size_t)NPAD * 2048 * 2);
constexpr size_t OFF_PA = al256(OFF_H + (size_t)T * 2048 * 2);
constexpr size_t OFF_PB = al256(OFF_PA + (size_t)T * SPA * 2);
constexpr size_t OFF_PC = al256(OFF_PB + (size_t)T * SPB * 2);
constexpr size_t OFF_PD = al256(OFF_PC + (size_t)T * SPC * 2);
constexpr size_t OFF_VTA = al256(OFF_PD + (size_t)T * SPD * 2);
constexpr size_t OFF_VTD = al256(OFF_VTA + (size_t)2 * 512 * TPB * 2);
constexpr size_t OFF_R1 = al256(OFF_VTD + (size_t)2 * 512 * TPB * 2);
constexpr size_t OFF_R2 = al256(OFF_R1 + (size_t)4 * T * 512 * 2);
constexpr size_t WS_NEED = al256(OFF_R2 + (size_t)4 * T * 512 * 2);
constexpr size_t R1_GATE = 0, R1_UP = (size_t)4 * 2048 * 2048 * 2, R1_OUT = R1_UP + (size_t)4 * 2048 * 512 * 2;

struct Params {
  const float* in[37];
  float* out;
  char* ws;
  int ph_lo, ph_hi;
};


typedef const __attribute__((address_space(4))) Params& CP;
DI int ltid() { int t = threadIdx.x; asm volatile("" : "+v"(t)); return t; }
DI int lbid() { int t = blockIdx.x; asm volatile("" : "+s"(t)); return t; }
DI int lgdim() { int t = gridDim.x; asm volatile("" : "+s"(t)); return t; }
#define TIDX ltid()
#define BIDX lbid()
#define GDIM lgdim()
DI CP launder_params() {
  auto kp = __builtin_amdgcn_kernarg_segment_ptr();
  asm volatile("" : "+s"(kp));
  return *(const __attribute__((address_space(4))) Params*)kp;
}


#define XB_TMO      128
#define XB_XCNT(j)  (256  + 64 * (j))
#define XB_XSUB(j)  (1280 + 64 * (j))
#define XB_XGEN(j)  (2304 + 64 * (j))
#define XB_TOP      3328
#define XB_TOPGEN   3392
#define XCD_BAR_WORDS 3456
#define XB_SPIN_CAP (1u << 22)
#define LAS __attribute__((address_space(3)))
DI unsigned xb_ld(unsigned* p) { return __hip_atomic_load(p, __ATOMIC_RELAXED, __HIP_MEMORY_SCOPE_AGENT); }
DI unsigned xb_add(unsigned* p, unsigned v) { return __hip_atomic_fetch_add(p, v, __ATOMIC_RELAXED, __HIP_MEMORY_SCOPE_AGENT); }
DI unsigned xb_xcc_id() { return (unsigned)__builtin_amdgcn_s_getreg((3 << 11) | 20) & 0xFu; }
#define XB_SPIN(cond, bar) do { unsigned _sp = 0; while (cond) { __builtin_amdgcn_s_sleep(1); \
    if ((++_sp & 255u) == 0u) { if (xb_ld(&(bar)[XB_TMO])) break; if (_sp > XB_SPIN_CAP) { atomicAdd(&(bar)[XB_TMO], 1u); break; } } } } while (0)
struct XcdBarrier { unsigned* bar; unsigned x; volatile LAS unsigned* st; };
DI XcdBarrier xcd_barrier_post(unsigned* bar, volatile LAS unsigned* st) {
  XcdBarrier b; b.bar = bar; b.x = xb_xcc_id(); b.st = st;
  if (threadIdx.x == 0) (void)xb_add(&bar[XB_XCNT(b.x)], 1u);
  return b;
}
DI void xcd_barrier_complete(unsigned* bar, unsigned x, unsigned& nloc, unsigned& nx) {
  const unsigned G = gridDim.x * gridDim.y * gridDim.z;
  unsigned sum, cnt, mine, sp = 0u;
  for (;;) {
    sum = 0u; cnt = 0u; mine = 0u;
#pragma unroll
    for (unsigned j = 0; j < 16; ++j) { const unsigned c = xb_ld(&bar[XB_XCNT(j)]); sum += c; cnt += (c > 0u) ? 1u : 0u; mine = (j == x) ? c : mine; }
    if (sum == G) break;
    __builtin_amdgcn_s_sleep(1);
    if ((++sp & 255u) == 0u) { if (xb_ld(&bar[XB_TMO])) break; if (sp > XB_SPIN_CAP) { atomicAdd(&bar[XB_TMO], 1u); break; } }
  }
  nloc = mine > 0u ? mine : 1u; nx = cnt > 0u ? cnt : 1u;
}
DI void xcd_barrier(const XcdBarrier& b) {
  asm volatile("s_waitcnt vmcnt(0)" ::: "memory");
  __syncthreads();
  if (threadIdx.x == 0) {
    unsigned* bar = b.bar;
    __builtin_amdgcn_s_waitcnt(0);
    unsigned nloc = b.st[0], nx = b.st[1];
    if (nloc == 0u) { xcd_barrier_complete(bar, b.x, nloc, nx); b.st[0] = nloc; b.st[1] = nx; }
    const unsigned old = xb_add(&bar[XB_XSUB(b.x)], 1u);
    const unsigned gen = old / nloc;
    if (old + 1u == (gen + 1u) * nloc) {
      __builtin_amdgcn_fence(__ATOMIC_RELEASE, "agent");
      asm volatile("s_waitcnt vmcnt(0)" ::: "memory");
      const unsigned og = xb_add(&bar[XB_TOP], 1u);
      const unsigned tg = og / nx;
      if (og + 1u == (tg + 1u) * nx) xb_add(&bar[XB_TOPGEN], 1u);
      else XB_SPIN(xb_ld(&bar[XB_TOPGEN]) == tg, bar);
      __builtin_amdgcn_fence(__ATOMIC_ACQUIRE, "agent");
      xb_add(&bar[XB_XGEN(b.x)], 1u);
      asm volatile("s_waitcnt vmcnt(0)" ::: "memory");
    } else {
      XB_SPIN(xb_ld(&bar[XB_XGEN(b.x)]) == gen, bar);
      __builtin_amdgcn_fence(__ATOMIC_ACQUIRE, "agent");
      asm volatile("s_waitcnt vmcnt(0)" ::: "memory");
    }
  }
  __syncthreads();
}

DI bf16_t f2bf(float x) { return __builtin_bit_cast(bf16_t, (__bf16)x); }
DI float bf2f(bf16_t h) { return __uint_as_float(((unsigned)h) << 16); }
typedef __attribute__((ext_vector_type(2))) __bf16 bf16x2_t;
DI unsigned pack2(float a, float b) { bf16x2_t v; v.x = (__bf16)a; v.y = (__bf16)b; return __builtin_bit_cast(unsigned, v); }
DI bf16x8 pack8_mfma(float a0, float a1, float a2, float a3, float a4, float a5, float a6, float a7) {
  uint4 u = make_uint4(pack2(a0, a1), pack2(a2, a3), pack2(a4, a5), pack2(a6, a7));
  return __builtin_bit_cast(bf16x8, u);
}
DI float sigmf(float x) { return __builtin_amdgcn_rcpf(1.f + __expf(-x)); }
DI float siluf(float x) { return x * sigmf(x); }
DI float dppf(float v, const int ctrl_sel) {
  int iv = __float_as_int(v), r;
  switch (ctrl_sel) {
    case 0: r = __builtin_amdgcn_update_dpp(0, iv, 0xB1, 0xf, 0xf, false); break;
    case 1: r = __builtin_amdgcn_update_dpp(0, iv, 0x4E, 0xf, 0xf, false); break;
    case 2: r = __builtin_amdgcn_update_dpp(0, iv, 0x141, 0xf, 0xf, false); break;
    default: r = __builtin_amdgcn_update_dpp(0, iv, 0x140, 0xf, 0xf, false); break;
  }
  return __int_as_float(r);
}
DI float row16_sum(float v) { v += dppf(v, 0); v += dppf(v, 1); v += dppf(v, 2); v += dppf(v, 3); return v; }
DI float wave_sum(float v) { v = row16_sum(v); v += __shfl_xor(v, 16); v += __shfl_xor(v, 32); return v; }
DI float wave_max(float v) {
  for (int o = 1; o < 64; o <<= 1) v = fmaxf(v, __shfl_xor(v, o));
  return v;
}
DI int crow(int i, int h) { return (i & 3) + 8 * (i >> 2) + 4 * h; }

struct Ptrs {
  float* mod; int* ctr; int* cuf; float* rope; float* bonus; float* mdt; float* mcb; bf16_t* W3; bf16_t* LA; float* xc1; bf16_t* W1; bf16_t* H;
  bf16_t *pA, *pB, *pC, *pD, *VtA, *VtD; bf16_t* R1; bf16_t* R2;
};
DI Ptrs mkptrs(char* ws) {
  Ptrs q;
  q.mod = (float*)(ws + OFF_MOD); q.ctr = (int*)(ws + OFF_CTR); q.rope = (float*)(ws + OFF_ROPE); q.cuf = (int*)(ws + OFF_CUF); q.bonus = (float*)(ws + OFF_BONUS); q.mdt = (float*)(ws + OFF_MDT); q.mcb = (float*)(ws + OFF_MCB);
  q.W3 = (bf16_t*)(ws + OFF_W3); q.LA = (bf16_t*)(ws + OFF_LA); q.xc1 = (float*)(ws + OFF_XC1);
  q.W1 = (bf16_t*)(ws + OFF_W1); q.H = (bf16_t*)(ws + OFF_H);
  q.pA = (bf16_t*)(ws + OFF_PA); q.pB = (bf16_t*)(ws + OFF_PB); q.pC = (bf16_t*)(ws + OFF_PC); q.pD = (bf16_t*)(ws + OFF_PD);
  q.VtA = (bf16_t*)(ws + OFF_VTA); q.VtD = (bf16_t*)(ws + OFF_VTD);
  q.R1 = (bf16_t*)(ws + OFF_R1); q.R2 = (bf16_t*)(ws + OFF_R2);
  return q;
}

DI const float* xrow(CP p, const Ptrs& w, int l, int tok) {
  int b = tok / TPB, i = tok - b * TPB;
  if (l == 0) return i < CTXL ? p.in[2] + (size_t)(b * CTXL + i) * DM : p.in[0] + (size_t)(b * 8192 + i - CTXL) * DM;
  return i < CTXL ? w.xc1 + (size_t)(b * CTXL + i) * DM : p.out + (size_t)(b * 8192 + i - CTXL) * DM;
}

DI void transpose_tile(const float* __restrict__ src, int ld_src, int k0, int n0, bool win_map, bf16_t* __restrict__ dst, int ld_dst, float* sm) {
  const int tid = TIDX;
  __syncthreads();
  {
    int cgp = (tid & 15) * 4, n = n0 + cgp;
    int ns = n;
    if (win_map) ns = n < 5904 ? n : (n < 6016 ? -1 : n - 112);
#pragma unroll
    for (int i = 0; i < 4; ++i) {
      int kk = (tid >> 4) + 16 * i;
      float4 v = make_float4(0.f, 0.f, 0.f, 0.f);
      if (ns >= 0) v = *(const float4*)(src + (size_t)(k0 + kk) * ld_src + ns);
      float* d = sm + kk * 65 + cgp;
      d[0] = v.x; d[1] = v.y; d[2] = v.z; d[3] = v.w;
    }
  }
  __syncthreads();
  {
    int n = tid >> 2, kq = (tid & 3) * 16;
    unsigned o[8];
#pragma unroll
    for (int j = 0; j < 8; ++j) o[j] = pack2(sm[(kq + 2 * j) * 65 + n], sm[(kq + 2 * j + 1) * 65 + n]);
    uint4* dp = (uint4*)(dst + (size_t)(n0 + n) * ld_dst + k0 + kq);
    dp[0] = make_uint4(o[0], o[1], o[2], o[3]);
    dp[1] = make_uint4(o[4], o[5], o[6], o[7]);
  }
}

DI void gemm_128(const bf16_t* __restrict__ A, int lda, const bf16_t* __restrict__ B, int ldb, int K, f32x16 (&acc)[2][2], bf16_t* sA, bf16_t* sB) {
  const int tid = TIDX, lane = tid & 63, wid = tid >> 6, wm = wid >> 1, wn = wid & 1, r = lane & 31, h = lane >> 5;
  const int lrow = tid >> 3, lkc = (tid & 7) * 8;
  const bf16_t* ga = A + (size_t)lrow * lda + lkc;
  const bf16_t* gb = B + (size_t)lrow * ldb + lkc;
  uint4 ra0, ra1, ra2, ra3, rb0, rb1, rb2, rb3;
  ra0 = *(const uint4*)(ga); ra1 = *(const uint4*)(ga + (size_t)32 * lda); ra2 = *(const uint4*)(ga + (size_t)64 * lda); ra3 = *(const uint4*)(ga + (size_t)96 * lda);
  rb0 = *(const uint4*)(gb); rb1 = *(const uint4*)(gb + (size_t)32 * ldb); rb2 = *(const uint4*)(gb + (size_t)64 * ldb); rb3 = *(const uint4*)(gb + (size_t)96 * ldb);
  for (int k0 = 0; k0 < K; k0 += 64) {
    __syncthreads();
    *(uint4*)(sA + (lrow) * 72 + lkc) = ra0; *(uint4*)(sA + (lrow + 32) * 72 + lkc) = ra1; *(uint4*)(sA + (lrow + 64) * 72 + lkc) = ra2; *(uint4*)(sA + (lrow + 96) * 72 + lkc) = ra3;
    *(uint4*)(sB + (lrow) * 72 + lkc) = rb0; *(uint4*)(sB + (lrow + 32) * 72 + lkc) = rb1; *(uint4*)(sB + (lrow + 64) * 72 + lkc) = rb2; *(uint4*)(sB + (lrow + 96) * 72 + lkc) = rb3;
    __syncthreads();
    if (k0 + 64 < K) {
      const bf16_t* ga2 = ga + k0 + 64; const bf16_t* gb2 = gb + k0 + 64;
      ra0 = *(const uint4*)(ga2); ra1 = *(const uint4*)(ga2 + (size_t)32 * lda); ra2 = *(const uint4*)(ga2 + (size_t)64 * lda); ra3 = *(const uint4*)(ga2 + (size_t)96 * lda);
      rb0 = *(const uint4*)(gb2); rb1 = *(const uint4*)(gb2 + (size_t)32 * ldb); rb2 = *(const uint4*)(gb2 + (size_t)64 * ldb); rb3 = *(const uint4*)(gb2 + (size_t)96 * ldb);
    }
#pragma unroll
    for (int s = 0; s < 4; ++s) {
      bf16x8 a0 = *(const bf16x8*)(sA + (wm * 64 + r) * 72 + s * 16 + h * 8);
      bf16x8 a1 = *(const bf16x8*)(sA + (wm * 64 + 32 + r) * 72 + s * 16 + h * 8);
      bf16x8 b0 = *(const bf16x8*)(sB + (wn * 64 + r) * 72 + s * 16 + h * 8);
      bf16x8 b1 = *(const bf16x8*)(sB + (wn * 64 + 32 + r) * 72 + s * 16 + h * 8);
      acc[0][0] = MFMA(a0, b0, acc[0][0]); acc[0][1] = MFMA(a0, b1, acc[0][1]);
      acc[1][0] = MFMA(a1, b0, acc[1][0]); acc[1][1] = MFMA(a1, b1, acc[1][1]);
    }
  }
}
DI void gemm_128_2set(const bf16_t* __restrict__ A, int lda, const bf16_t* __restrict__ B, int ldb, int K, f32x16 (&acc)[2][2], bf16_t* sA, bf16_t* sB) {
  const int tid = TIDX, lane = tid & 63, wid = tid >> 6, wm = wid >> 1, wn = wid & 1, r = lane & 31, h = lane >> 5;
  const int lrow = tid >> 3, lkc = (tid & 7) * 8;
  const bf16_t* ga = A + (size_t)lrow * lda + lkc;
  const bf16_t* gb = B + (size_t)lrow * ldb + lkc;
  uint4 pa0, pa1, pa2, pa3, pb0, pb1, pb2, pb3, qa0, qa1, qa2, qa3, qb0, qb1, qb2, qb3;
#define GL2_P(off) { const bf16_t* x = ga + (off); const bf16_t* y = gb + (off); \
    pa0 = *(const uint4*)(x); pa1 = *(const uint4*)(x + (size_t)32 * lda); pa2 = *(const uint4*)(x + (size_t)64 * lda); pa3 = *(const uint4*)(x + (size_t)96 * lda); \
    pb0 = *(const uint4*)(y); pb1 = *(const uint4*)(y + (size_t)32 * ldb); pb2 = *(const uint4*)(y + (size_t)64 * ldb); pb3 = *(const uint4*)(y + (size_t)96 * ldb); }
#define GL2_Q(off) { const bf16_t* x = ga + (off); const bf16_t* y = gb + (off); \
    qa0 = *(const uint4*)(x); qa1 = *(const uint4*)(x + (size_t)32 * lda); qa2 = *(const uint4*)(x + (size_t)64 * lda); qa3 = *(const uint4*)(x + (size_t)96 * lda); \
    qb0 = *(const uint4*)(y); qb1 = *(const uint4*)(y + (size_t)32 * ldb); qb2 = *(const uint4*)(y + (size_t)64 * ldb); qb3 = *(const uint4*)(y + (size_t)96 * ldb); }
#define ST2(a0, a1, a2, a3, b0, b1, b2, b3) { \
    *(uint4*)(sA + (lrow) * 72 + lkc) = a0; *(uint4*)(sA + (lrow + 32) * 72 + lkc) = a1; *(uint4*)(sA + (lrow + 64) * 72 + lkc) = a2; *(uint4*)(sA + (lrow + 96) * 72 + lkc) = a3; \
    *(uint4*)(sB + (lrow) * 72 + lkc) = b0; *(uint4*)(sB + (lrow + 32) * 72 + lkc) = b1; *(uint4*)(sB + (lrow + 64) * 72 + lkc) = b2; *(uint4*)(sB + (lrow + 96) * 72 + lkc) = b3; }
#define MMA2() _Pragma("unroll") for (int s = 0; s < 4; ++s) { \
      bf16x8 a0 = *(const bf16x8*)(sA + (wm * 64 + r) * 72 + s * 16 + h * 8); \
      bf16x8 a1 = *(const bf16x8*)(sA + (wm * 64 + 32 + r) * 72 + s * 16 + h * 8); \
      bf16x8 b0 = *(const bf16x8*)(sB + (wn * 64 + r) * 72 + s * 16 + h * 8); \
      bf16x8 b1 = *(const bf16x8*)(sB + (wn * 64 + 32 + r) * 72 + s * 16 + h * 8); \
      acc[0][0] = MFMA(a0, b0, acc[0][0]); acc[0][1] = MFMA(a0, b1, acc[0][1]); \
      acc[1][0] = MFMA(a1, b0, acc[1][0]); acc[1][1] = MFMA(a1, b1, acc[1][1]); }
  GL2_P(0)
  GL2_Q(64)
  for (int k0 = 0; k0 < K - 128; k0 += 128) {
    __syncthreads();
    ST2(pa0, pa1, pa2, pa3, pb0, pb1, pb2, pb3)
    __syncthreads();
    GL2_P(k0 + 128)
    MMA2()
    __syncthreads();
    ST2(qa0, qa1, qa2, qa3, qb0, qb1, qb2, qb3)
    __syncthreads();
    GL2_Q(k0 + 192)
    MMA2()
  }
  __syncthreads();
  ST2(pa0, pa1, pa2, pa3, pb0, pb1, pb2, pb3)
  __syncthreads();
  MMA2()
  __syncthreads();
  ST2(qa0, qa1, qa2, qa3, qb0, qb1, qb2, qb3)
  __syncthreads();
  MMA2()
#undef GL2_P
#undef GL2_Q
#undef ST2
#undef MMA2
}
DI void gemm_128_deep(const bf16_t* __restrict__ A, int lda, const bf16_t* __restrict__ B, int ldb, int K, f32x16 (&acc)[2][2], bf16_t* sA, bf16_t* sBunused) {
  (void)sBunused;
  const int tid = TIDX, lane = tid & 63, wid = tid >> 6, wm = wid >> 1, wn = wid & 1, r = lane & 31, h = lane >> 5;
  const int lrow = tid >> 3, lkc = (tid & 7) * 8;
  const bf16_t* ga = A + (size_t)lrow * lda + lkc;
  const bf16_t* gb = B + (size_t)lrow * ldb + lkc;
  uint4 pa0, pa1, pa2, pa3, pb0, pb1, pb2, pb3, qa0, qa1, qa2, qa3, qb0, qb1, qb2, qb3;
#define GL_P(off) { const bf16_t* x = ga + (off); const bf16_t* y = gb + (off); \
    pa0 = *(const uint4*)(x); pa1 = *(const uint4*)(x + (size_t)32 * lda); pa2 = *(const uint4*)(x + (size_t)64 * lda); pa3 = *(const uint4*)(x + (size_t)96 * lda); \
    pb0 = *(const uint4*)(y); pb1 = *(const uint4*)(y + (size_t)32 * ldb); pb2 = *(const uint4*)(y + (size_t)64 * ldb); pb3 = *(const uint4*)(y + (size_t)96 * ldb); }
#define GL_Q(off) { const bf16_t* x = ga + (off); const bf16_t* y = gb + (off); \
    qa0 = *(const uint4*)(x); qa1 = *(const uint4*)(x + (size_t)32 * lda); qa2 = *(const uint4*)(x + (size_t)64 * lda); qa3 = *(const uint4*)(x + (size_t)96 * lda); \
    qb0 = *(const uint4*)(y); qb1 = *(const uint4*)(y + (size_t)32 * ldb); qb2 = *(const uint4*)(y + (size_t)64 * ldb); qb3 = *(const uint4*)(y + (size_t)96 * ldb); }
#define ST_LDS(buf, a0, a1, a2, a3, b0, b1, b2, b3) { bf16_t* da = sA + (buf) * (2 * 128 * 72); bf16_t* db = da + 128 * 72; \
    *(uint4*)(da + (lrow) * 72 + lkc) = a0; *(uint4*)(da + (lrow + 32) * 72 + lkc) = a1; *(uint4*)(da + (lrow + 64) * 72 + lkc) = a2; *(uint4*)(da + (lrow + 96) * 72 + lkc) = a3; \
    *(uint4*)(db + (lrow) * 72 + lkc) = b0; *(uint4*)(db + (lrow + 32) * 72 + lkc) = b1; *(uint4*)(db + (lrow + 64) * 72 + lkc) = b2; *(uint4*)(db + (lrow + 96) * 72 + lkc) = b3; }
#define MMA_TILE(buf) { const bf16_t* ca = sA + (buf) * (2 * 128 * 72); const bf16_t* cb = ca + 128 * 72; \
    _Pragma("unroll") for (int s = 0; s < 4; ++s) { \
      bf16x8 a0 = *(const bf16x8*)(ca + (wm * 64 + r) * 72 + s * 16 + h * 8); \
      bf16x8 a1 = *(const bf16x8*)(ca + (wm * 64 + 32 + r) * 72 + s * 16 + h * 8); \
      bf16x8 b0 = *(const bf16x8*)(cb + (wn * 64 + r) * 72 + s * 16 + h * 8); \
      bf16x8 b1 = *(const bf16x8*)(cb + (wn * 64 + 32 + r) * 72 + s * 16 + h * 8); \
      acc[0][0] = MFMA(a0, b0, acc[0][0]); acc[0][1] = MFMA(a0, b1, acc[0][1]); \
      acc[1][0] = MFMA(a1, b0, acc[1][0]); acc[1][1] = MFMA(a1, b1, acc[1][1]); } }
  GL_P(0)
  GL_Q(64)
  __syncthreads();
  ST_LDS(0, pa0, pa1, pa2, pa3, pb0, pb1, pb2, pb3)
  GL_P(128)
  __syncthreads();
  for (int k0 = 0; k0 < K - 256; k0 += 128) {
    MMA_TILE(0)
    ST_LDS(1, qa0, qa1, qa2, qa3, qb0, qb1, qb2, qb3)
    GL_Q(k0 + 192)
    __syncthreads();
    MMA_TILE(1)
    ST_LDS(0, pa0, pa1, pa2, pa3, pb0, pb1, pb2, pb3)
    GL_P(k0 + 256)
    __syncthreads();
  }
  MMA_TILE(0)
  ST_LDS(1, qa0, qa1, qa2, qa3, qb0, qb1, qb2, qb3)
  GL_Q(K - 64)
  __syncthreads();
  MMA_TILE(1)
  ST_LDS(0, pa0, pa1, pa2, pa3, pb0, pb1, pb2, pb3)
  __syncthreads();
  MMA_TILE(0)
  ST_LDS(1, qa0, qa1, qa2, qa3, qb0, qb1, qb2, qb3)
  __syncthreads();
  MMA_TILE(1)
  __syncthreads();
#undef GL_P
#undef GL_Q
#undef ST_LDS
#undef MMA_TILE
}
DI bool tile_map(int k, int MT, int NT, int& mt, int& nt) {
  const int gd = GDIM, b = BIDX;
  if (gd & 63) { int it = b + k * gd; if (it >= MT * NT) return false; mt = it / NT; nt = it - mt * NT; return true; }
  const int gsm = gd >> 6, x = b & 7, j = b >> 3;
  const int ngn = (NT + 7) >> 3, ngm = (MT + gsm - 1) / gsm;
  const int g = k * 8 + x;
  if (g >= ngm * ngn) return false;
  const int gm = g / ngn, gn = g - gm * ngn;
  mt = gm * gsm + (j >> 3); nt = gn * 8 + (j & 7);
  return mt < MT && nt < NT;
}
DI int tile_rounds(int MT, int NT) {
  const int gd = GDIM;
  if (gd & 63) return (MT * NT + gd - 1) / gd;
  const int gsm = gd >> 6;
  return (((NT + 7) >> 3) * ((MT + gsm - 1) / gsm) + 7) >> 3;
}
DI void zero_acc(f32x16 (&acc)[2][2]) {
#pragma unroll
  for (int a = 0; a < 2; ++a)
#pragma unroll
    for (int b = 0; b < 2; ++b)
#pragma unroll
      for (int i = 0; i < 16; ++i) acc[a][b][i] = 0.f;
}

DI void phase_ada_item(CP p, const Ptrs& w, int l, int item, int ksplit, float* sm) {
  const int tid = TIDX, lane = tid & 63, wid = tid >> 6;
  const int cgp = item % 96, kq = item / 96, j = cgp * 64 + lane;
  const int rows_w = 512 / ksplit;
  float* act = sm;
  float* red = sm + 3 * 2048;
  __syncthreads();
  for (int e = tid; e < 3 * 2048; e += 256) {
    int v = e >> 11, k = e & 2047;
    float x = v < 2 ? p.in[1][v * 2048 + k] : p.in[3][k];
    act[e] = siluf(x);
  }
  __syncthreads();
  const float* wa = p.in[5] + (size_t)l * 2048 * 6144 + j;
  float a0 = 0.f, a1 = 0.f, a2 = 0.f;
  const int kb = kq * (2048 / ksplit) + wid * rows_w;
#pragma unroll 32
  for (int k = 0; k < rows_w; ++k) {
    float wv = wa[(size_t)(kb + k) * 6144];
    a0 += act[kb + k] * wv; a1 += act[2048 + kb + k] * wv; a2 += act[4096 + kb + k] * wv;
  }
  red[(wid * 3 + 0) * 64 + lane] = a0; red[(wid * 3 + 1) * 64 + lane] = a1; red[(wid * 3 + 2) * 64 + lane] = a2;
  __syncthreads();
  if (tid < 192) {
    int v = tid >> 6, ll = tid & 63, jj = cgp * 64 + ll;
    float s = red[(0 * 3 + v) * 64 + ll] + red[(1 * 3 + v) * 64 + ll] + red[(2 * 3 + v) * 64 + ll] + red[(3 * 3 + v) * 64 + ll];
    if (ksplit == 1) w.mod[(l * 3 + v) * 6144 + jj] = s + p.in[6][l * 6144 + jj];
    else atomicAdd(&w.mod[(l * 3 + v) * 6144 + jj], kq == 0 ? s + p.in[6][l * 6144 + jj] : s);
  }
}
DI void conv_w1(CP p, const Ptrs& w, int l, float* sm) {
  const float* src = p.in[7] + (size_t)l * 2048 * 7952;
  for (int it = BIDX; it < 126 * 32; it += GDIM) {
    int nt = it >> 5, kt = it & 31;
    transpose_tile(src, 7952, kt * 64, nt * 64, true, w.W1, 2048, sm);
  }
}
DI void conv_w3(CP p, const Ptrs& w, int l, float* sm) {
  for (int it = BIDX; it < 32; it += GDIM) {
    int m = it >> 3, nt = it & 7, type = m >> 1, dir = m & 1;
    const float* src = p.in[type == 0 ? 13 : 15] + (size_t)((l * 2 + dir) * 64) * 512;
    transpose_tile(src, 512, 0, nt * 64, false, w.W3 + (size_t)m * 512 * 64, 64, sm);
  }
}
DI void conv_w2(CP p, const Ptrs& w, int l, float* sm) {
  bf16_t* gate_t = (bf16_t*)((char*)w.R1 + R1_GATE);
  bf16_t* up_t = (bf16_t*)((char*)w.R1 + R1_UP);
  bf16_t* out_t = (bf16_t*)((char*)w.R1 + R1_OUT);
  for (int it = BIDX; it < 6144; it += GDIM) {
    if (it < 4096) {
      int i = it >> 10, r = it & 1023, nt = r >> 5, kt = r & 31;
      transpose_tile(p.in[34] + (size_t)(l * 4 + i) * 2048 * 2048, 2048, kt * 64, nt * 64, false, gate_t + (size_t)i * 2048 * 2048, 2048, sm);
    } else if (it < 5120) {
      int q = it - 4096, i = q >> 8, r = q & 255, nt = r >> 3, kt = r & 7;
      transpose_tile(p.in[35] + (size_t)(l * 4 + i) * 512 * 2048, 2048, kt * 64, nt * 64, false, up_t + (size_t)i * 2048 * 512, 512, sm);
    } else {
      int r = it - 5120, nt = r >> 5, kt = r & 31;
      transpose_tile(p.in[36] + (size_t)l * 2048 * 2048, 2048, kt * 64, nt * 64, false, out_t, 2048, sm);
    }
  }
}

DI void phase_norm(CP p, const Ptrs& w, int l) {
  const int lane = TIDX & 63, gw = BIDX * 4 + (TIDX >> 6), nw = GDIM * 4;
  const float* nwt = p.in[4] + l * 2048;
  for (int tok = gw; tok < T; tok += nw) {
    int b = tok / TPB, i = tok - b * TPB, v = i < CTXL ? 2 : b;
    const float* xr = xrow(p, w, l, tok);
    const float* md = w.mod + (l * 3 + v) * 6144;
    float4 xv[8];
    float ss = 0.f;
#pragma unroll
    for (int j = 0; j < 8; ++j) { xv[j] = *(const float4*)(xr + (j * 64 + lane) * 4); ss += xv[j].x * xv[j].x + xv[j].y * xv[j].y + xv[j].z * xv[j].z + xv[j].w * xv[j].w; }
    ss = wave_sum(ss);
    float inv = rsqrtf(ss * (1.f / 2048.f) + 1e-6f);
#pragma unroll
    for (int j = 0; j < 8; ++j) {
      int c = (j * 64 + lane) * 4;
      float4 nw4 = *(const float4*)(nwt + c), sh = *(const float4*)(md + c), sc = *(const float4*)(md + 2048 + c);
      float y0 = xv[j].x * inv * nw4.x * (1.f + sc.x) + sh.x, y1 = xv[j].y * inv * nw4.y * (1.f + sc.y) + sh.y;
      float y2 = xv[j].z * inv * nw4.z * (1.f + sc.z) + sh.z, y3 = xv[j].w * inv * nw4.w * (1.f + sc.w) + sh.w;
      *(uint2*)(w.H + (size_t)tok * 2048 + c) = make_uint2(pack2(y0, y1), pack2(y2, y3));
    }
  }
}

DI void phase_inproj(CP p, const Ptrs& w, int l, bf16_t* sA, bf16_t* sB) {
  const int tid = TIDX, lane = tid & 63, wid = tid >> 6, wm = wid >> 1, wn = wid & 1, r = lane & 31, h = lane >> 5;
  const int nrounds = tile_rounds(132, 63);
  for (int kk = 0; kk < nrounds; ++kk) {
    int mt, nt;
    if (!tile_map(kk, 132, 63, mt, nt)) continue;
    int m0 = mt * 128, n0 = nt * 128;
    f32x16 acc[2][2];
    zero_acc(acc);
    gemm_128_deep(w.H + (size_t)m0 * 2048, 2048, w.W1 + (size_t)n0 * 2048, 2048, 2048, acc, sA, sB);
    bf16_t* dst = nullptr; int stride = 0, cbase = 0; bf16_t* vt = nullptr; int vbase = 0;
    if (n0 < 2048) { int sub = n0 >> 9; if (sub == 2) { vt = w.VtA; vbase = n0 - 1024; } else { dst = w.pA; stride = SPA; cbase = sub == 3 ? n0 - 512 : n0; } }
    else if (n0 < 4352) { dst = w.pB; stride = SPB; cbase = n0 - 2048; }
    else if (n0 < 6016) { dst = w.pC; stride = SPC; cbase = n0 - 4352; }
    else { int cd = n0 - 6016, sub = cd >> 9; if (sub == 2) { vt = w.VtD; vbase = cd - 1024; } else { dst = w.pD; stride = SPD; cbase = sub == 3 ? cd - 512 : cd; } }
    if (dst) {
#pragma unroll
      for (int mi = 0; mi < 2; ++mi)
#pragma unroll
        for (int ni = 0; ni < 2; ++ni)
#pragma unroll
          for (int i = 0; i < 16; ++i) {
            int row = m0 + wm * 64 + mi * 32 + crow(i, h), col = cbase + wn * 64 + ni * 32 + r;
            dst[(size_t)row * stride + col] = f2bf(acc[mi][ni][i]);
          }
    } else {
      int b = m0 / TPB, ib = m0 - b * TPB;
#pragma unroll
      for (int mi = 0; mi < 2; ++mi)
#pragma unroll
        for (int ni = 0; ni < 2; ++ni)
#pragma unroll
          for (int g = 0; g < 4; ++g) {
            int i0 = ib + wm * 64 + mi * 32 + 8 * g + 4 * h, vcol = vbase + wn * 64 + ni * 32 + r;
            *(uint2*)(vt + (size_t)(b * 512 + vcol) * TPB + i0) =
                make_uint2(pack2(acc[mi][ni][4 * g], acc[mi][ni][4 * g + 1]), pack2(acc[mi][ni][4 * g + 2], acc[mi][ni][4 * g + 3]));
          }
    }
  }
  if (l == 0) {
    __shared__ int s_ada;
    for (;;) {
      __syncthreads();
      if (TIDX == 0) s_ada = atomicAdd(&w.ctr[40], 1);
      __syncthreads();
      const int it = s_ada;
      if (it >= 96) break;
      phase_ada_item(p, w, 1, it, 1, (float*)sA);
    }
  }
}

DI float quad_sum(float v) { v += dppf(v, 0); v += dppf(v, 1); return v; }
DI float row8_sum(float v) { v += dppf(v, 0); v += dppf(v, 1); v += dppf(v, 2); return v; }
DI void unpack8(uint4 u, float* f) {
  f[0] = __uint_as_float(u.x << 16); f[1] = __uint_as_float(u.x & 0xffff0000u); f[2] = __uint_as_float(u.y << 16); f[3] = __uint_as_float(u.y & 0xffff0000u);
  f[4] = __uint_as_float(u.z << 16); f[5] = __uint_as_float(u.z & 0xffff0000u); f[6] = __uint_as_float(u.w << 16); f[7] = __uint_as_float(u.w & 0xffff0000u);
}
DI uint4 pack8(const float* f) { return make_uint4(pack2(f[0], f[1]), pack2(f[2], f[3]), pack2(f[4], f[5]), pack2(f[6], f[7])); }
DI void phase_prep(CP p, const Ptrs& w, int l) {
  const int lane = TIDX & 63, gw = BIDX * 4 + (TIDX >> 6), nw = GDIM * 4;
  const int qd = lane & 3, vec = lane >> 2;
  float wa[16], wd[16];
  {
    const float* sa = (vec < 8 ? p.in[8] : p.in[9]) + l * 64 + qd * 16;
    const float* sd = (vec < 8 ? p.in[27] : p.in[28]) + l * 64 + qd * 16;
    const float qs = vec < 8 ? QS : 1.f;
#pragma unroll
    for (int j = 0; j < 16; ++j) { wa[j] = sa[j] * qs; wd[j] = sd[j] * qs; }
  }
  float mu4[4];
#pragma unroll
  for (int j = 0; j < 4; ++j) mu4[j] = p.in[11][l * 1792 + 1536 + lane * 4 + j];
  float cwB[4][4], cwC[4][4];
#pragma unroll
  for (int j = 0; j < 4; ++j) {
#pragma unroll
    for (int q = 0; q < 3; ++q) { cwB[q][j] = p.in[21][(l * 3 + q) * 1024 + 512 + lane * 4 + j]; cwC[q][j] = p.in[21][(l * 3 + q) * 1024 + 768 + lane * 4 + j]; }
    cwB[3][j] = p.in[22][l * 1024 + 512 + lane * 4 + j]; cwC[3][j] = p.in[22][l * 1024 + 768 + lane * 4 + j];
  }
  const float dtb_l = lane < 16 ? p.in[23][l * 16 + lane] : 0.f;
  const float Aneg_l = lane < 16 ? -__expf(p.in[24][l * 16 + lane]) : 0.f;
  for (int tok = gw; tok < T; tok += nw) {
    int b = tok / TPB, i = tok - b * TPB;
    bool isx = i >= CTXL;
    int ti = i - CTXL;
    uint4* pa = (uint4*)(w.pA + (size_t)tok * SPA) + lane * 2;
    uint4* pd = (uint4*)(w.pD + (size_t)tok * SPD) + lane * 2;
    const bf16_t* rb = w.pB + (size_t)tok * SPB + 1536 + lane * 4;
    bool hp = (i != 0) && (i != CTXL), hn = (i != CTXL - 1) && (i != TPB - 1);
    uint4 a0 = pa[0], a1 = pa[1], d0 = pd[0], d1 = pd[1];
    uint2 lc = *(const uint2*)rb, lp = make_uint2(0, 0), ln = make_uint2(0, 0);
    if (hp) lp = *(const uint2*)(rb - SPB);
    if (hn) ln = *(const uint2*)(rb + SPB);
    float4 rt[8];
    if (isx) {
      const float4* tp = (const float4*)(w.rope + (size_t)((qd < 2 ? (ti >> 6) : (ti & 63)) * 32));
#pragma unroll
      for (int j = 0; j < 8; ++j) rt[j] = tp[j];
    }
    float e[16];
    unpack8(a0, e); unpack8(a1, e + 8);
    {
      float ss = 0.f;
#pragma unroll
      for (int j = 0; j < 16; ++j) ss += e[j] * e[j];
      ss = quad_sum(ss);
      float sc = rsqrtf(ss * (1.f / 64.f) + 1e-6f);
#pragma unroll
      for (int j = 0; j < 16; ++j) e[j] = e[j] * sc * wa[j];
      pa[0] = pack8(e); pa[1] = pack8(e + 8);
    }
    unpack8(d0, e); unpack8(d1, e + 8);
    {
      float ss = 0.f;
#pragma unroll
      for (int j = 0; j < 16; ++j) ss += e[j] * e[j];
      ss = quad_sum(ss);
      float sc = rsqrtf(ss * (1.f / 64.f) + 1e-6f);
#pragma unroll
      for (int j = 0; j < 16; ++j) e[j] = e[j] * sc * wd[j];
      if (isx) {
#pragma unroll
        for (int j = 0; j < 16; ++j) {
          float pr = dppf(e[j], 0);
          float cs = (j & 1) ? rt[j >> 1].z : rt[j >> 1].x, sn = (j & 1) ? rt[j >> 1].w : rt[j >> 1].y;
          e[j] = e[j] * cs + ((qd & 1) ? pr : -pr) * sn;
        }
      }
      pd[0] = pack8(e); pd[1] = pack8(e + 8);
    }
    {
      const bf16_t* rc = w.pC + (size_t)tok * SPC;
      uint2 bc = *(const uint2*)(rc + 512 + lane * 4), cc = *(const uint2*)(rc + 768 + lane * 4);
      uint2 bp = make_uint2(0, 0), bn = make_uint2(0, 0), cp = make_uint2(0, 0), cn = make_uint2(0, 0);
      if (hp) { bp = *(const uint2*)(rc + 512 + lane * 4 - SPC); cp = *(const uint2*)(rc + 768 + lane * 4 - SPC); }
      if (hn) { bn = *(const uint2*)(rc + 512 + lane * 4 + SPC); cn = *(const uint2*)(rc + 768 + lane * 4 + SPC); }
      float dtraw = lane < 16 ? bf2f(rc[1024 + lane]) : 0.f;
      float Bc[4] = {__uint_as_float(bc.x << 16), __uint_as_float(bc.x & 0xffff0000u), __uint_as_float(bc.y << 16), __uint_as_float(bc.y & 0xffff0000u)};
      float Bp[4] = {__uint_as_float(bp.x << 16), __uint_as_float(bp.x & 0xffff0000u), __uint_as_float(bp.y << 16), __uint_as_float(bp.y & 0xffff0000u)};
      float Bn[4] = {__uint_as_float(bn.x << 16), __uint_as_float(bn.x & 0xffff0000u), __uint_as_float(bn.y << 16), __uint_as_float(bn.y & 0xffff0000u)};
      float Cc[4] = {__uint_as_float(cc.x << 16), __uint_as_float(cc.x & 0xffff0000u), __uint_as_float(cc.y << 16), __uint_as_float(cc.y & 0xffff0000u)};
      float Cp[4] = {__uint_as_float(cp.x << 16), __uint_as_float(cp.x & 0xffff0000u), __uint_as_float(cp.y << 16), __uint_as_float(cp.y & 0xffff0000u)};
      float Cn[4] = {__uint_as_float(cn.x << 16), __uint_as_float(cn.x & 0xffff0000u), __uint_as_float(cn.y << 16), __uint_as_float(cn.y & 0xffff0000u)};
      float ob[4], oc[4], prod = 0.f;
#pragma unroll
      for (int j = 0; j < 4; ++j) {
        ob[j] = bf2f(f2bf(siluf(cwB[0][j] * Bp[j] + cwB[1][j] * Bc[j] + cwB[2][j] * Bn[j] + cwB[3][j])));
        oc[j] = bf2f(f2bf(siluf(cwC[0][j] * Cp[j] + cwC[1][j] * Cc[j] + cwC[2][j] * Cn[j] + cwC[3][j])));
        prod += ob[j] * oc[j];
      }
      prod = row16_sum(prod); prod += __shfl_xor(prod, 16);
      bf16_t* mb = w.W1 + (size_t)tok * 512;
      *(uint2*)(mb + lane * 4) = make_uint2(pack2(ob[0], ob[1]), pack2(ob[2], ob[3]));
      *(uint2*)(mb + 256 + lane * 4) = make_uint2(pack2(oc[0], oc[1]), pack2(oc[2], oc[3]));
      if ((lane & 31) == 0) w.mcb[(size_t)tok * 2 + (lane >> 5)] = prod;
      if (lane < 16) {
        float dr = dtraw + dtb_l;
        float dt = dr > 20.f ? dr : log1pf(__expf(dr));
        *(float2*)(w.mdt + ((size_t)tok * 16 + lane) * 2) = make_float2(dt, __expf(dt * Aneg_l));
      }
    }
    {
      float c4[4] = {__uint_as_float(lc.x << 16), __uint_as_float(lc.x & 0xffff0000u), __uint_as_float(lc.y << 16), __uint_as_float(lc.y & 0xffff0000u)};
      float p4[4] = {__uint_as_float(lp.x << 16), __uint_as_float(lp.x & 0xffff0000u), __uint_as_float(lp.y << 16), __uint_as_float(lp.y & 0xffff0000u)};
      float n4[4] = {__uint_as_float(ln.x << 16), __uint_as_float(ln.x & 0xffff0000u), __uint_as_float(ln.y << 16), __uint_as_float(ln.y & 0xffff0000u)};
      float o[4];
#pragma unroll
      for (int j = 0; j < 4; ++j) { float sft = c4[j] + (0.5f * (p4[j] + n4[j]) - c4[j]) * mu4[j]; o[j] = lane < 32 ? tanhf(sft) : sft; }
      *(uint2*)(w.LA + (size_t)tok * 256 + lane * 4) = make_uint2(pack2(o[0], o[1]), pack2(o[2], o[3]));
    }
  }
}

DI void phase_lora(CP p, const Ptrs& w, int l, bf16_t* sA, bf16_t* sB) {
  const int tid = TIDX, lane = tid & 63, wid = tid >> 6, wm = wid >> 1, wn = wid & 1, r = lane & 31, h = lane >> 5;
  for (int it = BIDX; it < 132 * 16; it += GDIM) {
    int mt = it >> 4, q = it & 15, m = q >> 2, nt = q & 3, type = m >> 1, dir = m & 1, m0 = mt * 128, n0 = nt * 128;
    f32x16 acc[2][2];
    zero_acc(acc);
    gemm_128(w.LA + (size_t)m0 * 256 + m * 64, 256, w.W3 + (size_t)(m * 512 + n0) * 64, 64, 64, acc, sA, sB);
    const float* bias = p.in[type == 0 ? 12 : 14] + (l * 2 + dir) * 512;
    bf16_t* dst = w.R1 + (size_t)m * T * 512;
#pragma unroll
    for (int mi = 0; mi < 2; ++mi)
#pragma unroll
      for (int ni = 0; ni < 2; ++ni) {
        int col = n0 + wn * 64 + ni * 32 + r;
        float bc = bias[col];
#pragma unroll
        for (int i = 0; i < 16; ++i) {
          int row = m0 + wm * 64 + mi * 32 + crow(i, h);
          float x = acc[mi][ni][i] + bc, o;
          if (type == 0) o = 1.f - __expf(-0.6065306597126334f * sigmf(x));
          else o = sigmf(x);
          dst[(size_t)row * 512 + col] = f2bf(o);
        }
      }
  }
}

DI void phase_rwscal(CP p, const Ptrs& w, int l) {
  const int lane = TIDX & 63, gw = BIDX * 4 + (TIDX >> 6), nw = GDIM * 4;
  const int c0 = lane * 8, hd = lane >> 3;
  float mur[8], muk[8], kkc[8], kac[8], rkc[8];
#pragma unroll
  for (int j = 0; j < 8; ++j) {
    mur[j] = p.in[11][l * 1792 + c0 + j]; muk[j] = p.in[11][l * 1792 + 512 + c0 + j];
    kkc[j] = p.in[16][l * 512 + c0 + j]; kac[j] = p.in[17][l * 512 + c0 + j]; rkc[j] = p.in[18][l * 512 + c0 + j];
  }
  const bf16_t* Ad0 = w.R1 + (size_t)2 * T * 512, *Ad1 = w.R1 + (size_t)3 * T * 512;
  for (int tok = gw; tok < T; tok += nw) {
    int b = tok / TPB, i = tok - b * TPB;
    bool hp = (i != 0) && (i != CTXL), hn = (i != CTXL - 1) && (i != TPB - 1);
    const bf16_t* rb = w.pB + (size_t)tok * SPB + c0;
    uint4 ur = *(const uint4*)rb, uk = *(const uint4*)(rb + 512);
    uint4 urp = make_uint4(0, 0, 0, 0), urn = urp, ukp = urp, ukn = urp;
    if (hp) { urp = *(const uint4*)(rb - SPB); ukp = *(const uint4*)(rb + 512 - SPB); }
    if (hn) { urn = *(const uint4*)(rb + SPB); ukn = *(const uint4*)(rb + 512 + SPB); }
    uint4 ua0 = *(const uint4*)(Ad0 + (size_t)tok * 512 + c0), ua1 = *(const uint4*)(Ad1 + (size_t)tok * 512 + c0);
    float r[8], k[8], t0[8], t1[8];
    unpack8(ur, r); unpack8(urp, t0); unpack8(urn, t1);
#pragma unroll
    for (int j = 0; j < 8; ++j) r[j] = r[j] + (0.5f * (t0[j] + t1[j]) - r[j]) * mur[j];
    unpack8(uk, k); unpack8(ukp, t0); unpack8(ukn, t1);
    float ss = 0.f;
#pragma unroll
    for (int j = 0; j < 8; ++j) { k[j] = k[j] + (0.5f * (t0[j] + t1[j]) - k[j]) * muk[j]; float kv = k[j] * kkc[j]; ss += kv * kv; }
    ss = row8_sum(ss);
    float inv = 1.f / fmaxf(sqrtf(ss), 1e-12f);
    unpack8(ua0, t0); unpack8(ua1, t1);
    float br0 = 0.f, kr0 = 0.f, bo0 = 0.f, br1 = 0.f, kr1 = 0.f, bo1 = 0.f;
#pragma unroll
    for (int j = 0; j < 8; ++j) {
      float kk = k[j] * kkc[j] * inv;
      float kd0 = k[j] * (1.f + (t0[j] - 1.f) * kac[j]), kd1 = k[j] * (1.f + (t1[j] - 1.f) * kac[j]);
      br0 += kk * t0[j] * r[j]; br1 += kk * t1[j] * r[j];
      kr0 += kd0 * r[j]; kr1 += kd1 * r[j];
      bo0 += r[j] * kd0 * rkc[j]; bo1 += r[j] * kd1 * rkc[j];
    }
    br0 = row8_sum(br0); br1 = row8_sum(br1); kr0 = row8_sum(kr0); kr1 = row8_sum(kr1); bo0 = row8_sum(bo0); bo1 = row8_sum(bo1);
    if ((lane & 7) == 0) {
      float4* dst = (float4*)(w.bonus + ((size_t)tok * 8 + hd) * 8);
      dst[0] = make_float4(inv, br0, kr0, bo0);
      dst[1] = make_float4(br1, kr1, bo1, 0.f);
    }
  }
}

DI int pos2i(int pos, int dir) { return dir == 0 ? pos : (pos < CTXL ? CTXL - 1 - pos : (TPB + CTXL - 1) - pos); }

DI void rwkv_scan(CP p, const Ptrs& w, int l, int item, float* sm) {
  const int tid = TIDX, lane = tid & 63, wid = tid >> 6;
  const int chain = item >> 2, rq = item & 3, b = chain >> 4, hd = (chain >> 1) & 7, dir = chain & 1;
  const int sj = tid >> 4, skq = (tid & 15) * 4, sc_ = hd * 64 + skq;
  float mu_r[4], mu_k[4], mu_v[4], kk_c[4], ka_c[4];
#pragma unroll
  for (int j = 0; j < 4; ++j) {
    mu_r[j] = p.in[11][l * 1792 + sc_ + j]; mu_k[j] = p.in[11][l * 1792 + 512 + sc_ + j]; mu_v[j] = p.in[11][l * 1792 + 1024 + sc_ + j];
    kk_c[j] = p.in[16][l * 512 + sc_ + j]; ka_c[j] = p.in[17][l * 512 + sc_ + j];
  }
  const bf16_t* Wd = w.R1 + (size_t)(0 * 2 + dir) * T * 512;
  const bf16_t* Ad = w.R1 + (size_t)(1 * 2 + dir) * T * 512;
  bf16_t* yout = w.R2 + (size_t)dir * T * 512;
  constexpr int BUF = 6 * 1024 + 32;
  const int kg = lane & 15, rs = lane >> 4, row = rq * 16 + wid * 4 + rs;
  f2v SA = {0.f, 0.f}, SB = {0.f, 0.f};
  struct RPre { uint2 pq[3][3], pwd, pad_; float psc[3], pmk[2]; };
  RPre PA, PB;
  auto load = [&](int c, RPre& P) {
    int ii = pos2i(c * 16 + sj, dir);
    size_t tok = (size_t)b * TPB + ii;
    const bf16_t* prow = w.pB + tok * SPB + sc_;
    bool hp = (ii != 0) && (ii != CTXL), hn = (ii != CTXL - 1) && (ii != TPB - 1);
    const int op = hp ? -SPB : 0, on = hn ? SPB : 0;
    P.pmk[0] = hp ? 0.5f : 0.f; P.pmk[1] = hn ? 0.5f : 0.f;
#pragma unroll
    for (int q = 0; q < 3; ++q) {
      P.pq[q][0] = *(const uint2*)(prow + q * 512);
      P.pq[q][1] = *(const uint2*)(prow + q * 512 + op);
      P.pq[q][2] = *(const uint2*)(prow + q * 512 + on);
    }
    P.pwd = *(const uint2*)(Wd + tok * 512 + sc_);
    P.pad_ = *(const uint2*)(Ad + tok * 512 + sc_);
    const float* sc = w.bonus + (tok * 8 + hd) * 8;
    P.psc[0] = sc[0]; P.psc[1] = sc[1 + 3 * dir]; P.psc[2] = sc[2 + 3 * dir];
  };
  auto up4 = [](uint2 u, float* f) { f[0] = __uint_as_float(u.x << 16); f[1] = __uint_as_float(u.x & 0xffff0000u); f[2] = __uint_as_float(u.y << 16); f[3] = __uint_as_float(u.y & 0xffff0000u); };
  auto stage = [&](const RPre& P, float* bufp) {
    float rc[4], rp[4], rn[4], kc[4], kp[4], kn[4], vc[4], vp[4], vn[4], wd4[4], ad4[4];
    up4(P.pq[0][0], rc); up4(P.pq[0][1], rp); up4(P.pq[0][2], rn);
    up4(P.pq[1][0], kc); up4(P.pq[1][1], kp); up4(P.pq[1][2], kn);
    up4(P.pq[2][0], vc); up4(P.pq[2][1], vp); up4(P.pq[2][2], vn);
    up4(P.pwd, wd4); up4(P.pad_, ad4);
    float o0[4], o1[4], o2[4], o3[4], o4[4], o5[4];
#pragma unroll
    for (int j = 0; j < 4; ++j) {
      float r_s = rc[j] + ((P.pmk[0] * rp[j] + P.pmk[1] * rn[j]) - rc[j]) * mu_r[j];
      float k_s = kc[j] + ((P.pmk[0] * kp[j] + P.pmk[1] * kn[j]) - kc[j]) * mu_k[j];
      float v_s = vc[j] + ((P.pmk[0] * vp[j] + P.pmk[1] * vn[j]) - vc[j]) * mu_v[j];
      float kk = k_s * kk_c[j] * P.psc[0];
      float a = ad4[j], wv = 1.f - wd4[j];
      o0[j] = -kk; o1[j] = wv * r_s; o2[j] = wv; o3[j] = kk * a; o4[j] = k_s * (1.f + (a - 1.f) * ka_c[j]); o5[j] = v_s;
    }
    float* d = bufp + sj * 64 + skq;
    *(float4*)(d + 0 * 1024) = make_float4(o0[0], o0[1], o0[2], o0[3]);
    *(float4*)(d + 1 * 1024) = make_float4(o1[0], o1[1], o1[2], o1[3]);
    *(float4*)(d + 2 * 1024) = make_float4(o2[0], o2[1], o2[2], o2[3]);
    *(float4*)(d + 3 * 1024) = make_float4(o3[0], o3[1], o3[2], o3[3]);
    *(float4*)(d + 4 * 1024) = make_float4(o4[0], o4[1], o4[2], o4[3]);
    *(float4*)(d + 5 * 1024) = make_float4(o5[0], o5[1], o5[2], o5[3]);
    if (skq == 0) *(float2*)(bufp + 6 * 1024 + sj * 2) = make_float2(P.psc[1], P.psc[2]);
  };
  float* sY = sm + 2 * BUF;
  const int prow16 = wid * 4 + rs;
  const int ysel = (kg == 0) ? prow16 : (512 + tid);
  struct RStep { f4v a4, wr4, w4, b4, k4; float vv; float2 sc; };
  auto lds_step = [&](const float* bf, int j) {
    RStep q;
    q.a4 = *(const f4v*)(bf + 0 * 1024 + j * 64 + 4 * kg);
    q.wr4 = *(const f4v*)(bf + 1 * 1024 + j * 64 + 4 * kg);
    q.w4 = *(const f4v*)(bf + 2 * 1024 + j * 64 + 4 * kg);
    q.b4 = *(const f4v*)(bf + 3 * 1024 + j * 64 + 4 * kg);
    q.k4 = *(const f4v*)(bf + 4 * 1024 + j * 64 + 4 * kg);
    q.vv = bf[5 * 1024 + j * 64 + row];
    q.sc = *(const float2*)(bf + 6 * 1024 + j * 2);
    return q;
  };
  auto flush = [&](int c) {
    {
      int j = tid >> 4, rr = tid & 15;
      int ii = pos2i(c * 16 + j, dir);
      yout[((size_t)b * TPB + ii) * 512 + hd * 64 + rq * 16 + rr] = f2bf(sY[(c & 1) * 256 + j * 16 + rr]);
    }
  };
  __syncthreads();
  load(0, PA);
  stage(PA, sm);
  load(1, PB);
  __syncthreads();
  const int NCH = TPB / 16;
  auto run_chunk = [&](int c, const float* bf, float* sy) {
    flush(max(c - 1, 0));
    RStep cur = lds_step(bf, 0);
#pragma unroll
    for (int j = 0; j < 16; ++j) {
      RStep nxt = cur;
      if (j + 1 < 16) nxt = lds_step(bf, j + 1);
      f2v sa2 = SA * cur.a4.xy + SB * cur.a4.zw;
      f2v yp2 = SA * cur.wr4.xy + SB * cur.wr4.zw;
      float sa = sa2.x + sa2.y, yp = yp2.x + yp2.y;
      sa = row16_sum(sa); yp = row16_sum(yp);
      float y = yp + sa * cur.sc.x + cur.vv * cur.sc.y;
      SA = SA * cur.w4.xy + (sa * cur.b4.xy + cur.vv * cur.k4.xy);
      SB = SB * cur.w4.zw + (sa * cur.b4.zw + cur.vv * cur.k4.zw);
      sy[(kg == 0 ? j * 16 : 0) + ysel - (c & 1) * 0] = y;
      cur = nxt;
    }
  };
  for (int c = 0; c < NCH; c += 2) {
    load(min(c + 2, NCH - 1), PA);
    run_chunk(c, sm, sY);
    stage(PB, sm + BUF);
    __syncthreads();
    load(min(c + 3, NCH - 1), PB);
    run_chunk(c + 1, sm + BUF, sY + 256);
    stage(PA, sm);
    __syncthreads();
  }
  flush(NCH - 1);
}

DI void mamba_scan(CP p, const Ptrs& w, int l, int item, float* sm) {
  const int tid = TIDX, lane = tid & 63, wid = tid >> 6;
  const int chain = item >> 2, pq = item & 3, b = chain >> 4, hd = (chain >> 1) & 7, dir = chain & 1, gp = hd >> 2;
  const float* cw = p.in[21] + l * 3 * 1024;
  const float* cbv = p.in[22] + l * 1024;
  const int n_ = tid & 127, jh = tid >> 7;
  const int chB = 512 + gp * 128 + n_, chC = 768 + gp * 128 + n_;
  const float wB0 = cw[chB], wB1 = cw[1024 + chB], wB2 = cw[2048 + chB], bB = cbv[chB];
  const float wC0 = cw[chC], wC1 = cw[1024 + chC], wC2 = cw[2048 + chC], bC = cbv[chC];
  const int xj = tid >> 4, xp = tid & 15, chX = hd * 64 + pq * 16 + xp;
  const float wX0 = cw[chX], wX1 = cw[1024 + chX], wX2 = cw[2048 + chX], bX = cbv[chX];
  const float dtb = p.in[23][(l * 2 + dir) * 8 + hd];
  const float Aneg = -__expf(p.in[24][(l * 2 + dir) * 8 + hd]);
  const float Dsk = dir == 0 ? p.in[25][l * 8 + hd] : 0.f;
  bf16_t* yout = w.R2 + (size_t)(2 + dir) * T * 512;
  constexpr int BUF = 2 * 2048 + 256 + 256 + 64;
  const int ng = lane & 15, rs = lane >> 4, prow = wid * 4 + rs;
  f2v M0 = {0.f, 0.f}, M1 = {0.f, 0.f}, M2 = {0.f, 0.f}, M3 = {0.f, 0.f};
  struct MPre { uint4 pbq[2]; bf16_t px[3]; float pdt[3], pxm[2]; };
  MPre PA, PB;
  const bf16_t* mbc = w.W1;
  auto load = [&](int c, MPre& P) {
#pragma unroll
    for (int i = 0; i < 2; ++i) {
      int idx = tid + 256 * i, j = idx >> 5, q = idx & 31;
      int ii = pos2i(c * 16 + j, dir);
      P.pbq[i] = *(const uint4*)(mbc + ((size_t)b * TPB + ii) * 512 + (q < 16 ? 0 : 256) + gp * 128 + (q & 15) * 8);
    }
    {
      int pos = c * 16 + xj, ii = pos2i(pos, dir);
      size_t tok = (size_t)b * TPB + ii;
      const bf16_t* prw = w.pC + tok * SPC;
      bool hp = (ii != 0) && (ii != CTXL), hn = (ii != CTXL - 1) && (ii != TPB - 1);
      P.px[0] = prw[chX + (hp ? -SPC : 0)]; P.px[1] = prw[chX]; P.px[2] = prw[chX + (hn ? SPC : 0)];
      P.pxm[0] = hp ? 1.f : 0.f; P.pxm[1] = hn ? 1.f : 0.f;
      float2 dd = *(const float2*)(w.mdt + (tok * 16 + dir * 8 + hd) * 2);
      P.pdt[0] = dd.x; P.pdt[1] = dd.y; P.pdt[2] = w.mcb[tok * 2 + gp];
    }
  };
  auto stage = [&](const MPre& P, float* bufp) {
#pragma unroll
    for (int i = 0; i < 2; ++i) {
      int idx = tid + 256 * i, j = idx >> 5, q = idx & 31;
      float f[8];
      unpack8(P.pbq[i], f);
      float* d = bufp + (q < 16 ? 0 : 2048) + j * 128 + (q & 15) * 8;
      *(float4*)d = make_float4(f[0], f[1], f[2], f[3]);
      *(float4*)(d + 4) = make_float4(f[4], f[5], f[6], f[7]);
    }
    {
      float xs = siluf(wX0 * P.pxm[0] * bf2f(P.px[0]) + wX1 * bf2f(P.px[1]) + wX2 * P.pxm[1] * bf2f(P.px[2]) + bX);
      bufp[4096 + xj * 16 + xp] = xs * P.pdt[0];
      bufp[4096 + 256 + xj * 16 + xp] = Dsk * xs;
      if (xp == 0) *(float4*)(bufp + 4096 + 512 + xj * 4) = make_float4(P.pdt[1], P.pdt[2], 0.f, 0.f);
    }
  };
  float* sY = sm + 2 * BUF;
  const int ysel = (ng == 0) ? prow : (512 + tid);
  struct MStep { f4v B0, B1, C0, C1; float xq, ds; float4 sc; };
  auto lds_step = [&](const float* bf, int j) {
    MStep q;
    q.B0 = *(const f4v*)(bf + j * 128 + 8 * ng); q.B1 = *(const f4v*)(bf + j * 128 + 8 * ng + 4);
    q.C0 = *(const f4v*)(bf + 2048 + j * 128 + 8 * ng); q.C1 = *(const f4v*)(bf + 2048 + j * 128 + 8 * ng + 4);
    q.xq = bf[4096 + j * 16 + prow]; q.ds = bf[4096 + 256 + j * 16 + prow];
    q.sc = *(const float4*)(bf + 4096 + 512 + j * 4);
    return q;
  };
  auto flush = [&](int c) {
    {
      int j = tid >> 4, rr = tid & 15;
      int ii = pos2i(c * 16 + j, dir);
      yout[((size_t)b * TPB + ii) * 512 + hd * 64 + pq * 16 + rr] = f2bf(sY[(c & 1) * 256 + j * 16 + rr]);
    }
  };
  __syncthreads();
  load(0, PA);
  stage(PA, sm);
  load(1, PB);
  __syncthreads();
  const int NCH = TPB / 16;
  auto run_chunk = [&](int c, const float* bf, float* sy) {
    flush(max(c - 1, 0));
    MStep cur = lds_step(bf, 0);
#pragma unroll
    for (int j = 0; j < 16; ++j) {
      MStep nxt = cur;
      if (j + 1 < 16) nxt = lds_step(bf, j + 1);
      f2v ya = M0 * cur.C0.xy + M1 * cur.C0.zw, yb = M2 * cur.C1.xy + M3 * cur.C1.zw;
      ya += yb;
      float yp = row16_sum(ya.x + ya.y);
      float y = cur.sc.x * yp + cur.xq * cur.sc.y + cur.ds;
      const float dA = cur.sc.x, xq = cur.xq;
      M0 = M0 * dA + xq * cur.B0.xy; M1 = M1 * dA + xq * cur.B0.zw;
      M2 = M2 * dA + xq * cur.B1.xy; M3 = M3 * dA + xq * cur.B1.zw;
      sy[(ng == 0 ? j * 16 : 0) + ysel] = y;
      cur = nxt;
    }
  };
  for (int c = 0; c < NCH; c += 2) {
    load(min(c + 2, NCH - 1), PA);
    run_chunk(c, sm, sY);
    stage(PB, sm + BUF);
    __syncthreads();
    load(min(c + 3, NCH - 1), PB);
    run_chunk(c + 1, sm + BUF, sY + 256);
    stage(PA, sm);
    __syncthreads();
  }
  flush(NCH - 1);
}

DI void da_block(CP p, const Ptrs& w, int l, int b, int q0, int nkeys, int hd, bf16_t* sK, bf16_t* sV, float* smf, bf16_t* obase) {
  const int tid = TIDX, lane = tid & 63, wid = tid >> 6, r = lane & 31, h = lane >> 5;
  const int qb = wid >> 1, c = wid & 1;
  const size_t tokq = (size_t)b * TPB + q0 + qb * 32 + r;
  const bf16_t* qp = w.pD + tokq * SPD + hd * 128 + c * 64;
  bf16x8 Q0 = *(const bf16x8*)(qp + 0 * 16 + h * 8), Q1 = *(const bf16x8*)(qp + 1 * 16 + h * 8);
  bf16x8 Q2 = *(const bf16x8*)(qp + 2 * 16 + h * 8), Q3 = *(const bf16x8*)(qp + 3 * 16 + h * 8);
  const float mq = wave_max(fabsf(p.in[27][l * 64 + lane])), mk = wave_max(fabsf(p.in[28][l * 64 + lane]));
  const float Mb = 8.f * LOG2E * mq * mk + 0.5f;
  const float lam_init = 0.8f - 0.6f * __expf(-0.3f * (float)l);
  const float lam = __expf(wave_sum(p.in[29][l * 64 + lane] * p.in[30][l * 64 + lane])) - __expf(wave_sum(p.in[31][l * 64 + lane] * p.in[32][l * 64 + lane])) + lam_init;
  f32x16 O0, O1, O2, O3;
#pragma unroll
  for (int i = 0; i < 16; ++i) { O0[i] = 0.f; O1[i] = 0.f; O2[i] = 0.f; O3[i] = 0.f; }
  float ls = 0.f;
  f2v ls2 = {0.f, 0.f};
  const bf16_t* kbase = w.pD + (size_t)b * TPB * SPD + 512 + hd * 128;
  const bf16_t* vbase = w.VtD + (size_t)(b * 512 + hd * 128) * TPB;
  const int kkey = tid >> 4, kch = tid & 15, ve = tid >> 3, vch = tid & 7;
  const bf16_t* kg_ = kbase + (size_t)kkey * SPD + kch * 8;
  const bf16_t* vg_ = vbase + (size_t)ve * TPB + vch * 8;
  uint4 pk0, pk1, pk2, pk3, pv0, pv1, pv2, pv3;
#define DA_GLOAD(k0_) { const bf16_t* a_ = kg_ + (size_t)(k0_) * SPD; const bf16_t* b_ = vg_ + (k0_); \
    pk0 = *(const uint4*)(a_); pk1 = *(const uint4*)(a_ + (size_t)16 * SPD); pk2 = *(const uint4*)(a_ + (size_t)32 * SPD); pk3 = *(const uint4*)(a_ + (size_t)48 * SPD); \
    pv0 = *(const uint4*)(b_); pv1 = *(const uint4*)(b_ + (size_t)32 * TPB); pv2 = *(const uint4*)(b_ + (size_t)64 * TPB); pv3 = *(const uint4*)(b_ + (size_t)96 * TPB); }
  constexpr int DA_BUF = 64 * 136 + 128 * 72;
#define DA_STORE(bufi) { bf16_t* k_ = sK + (bufi) * DA_BUF; bf16_t* v_ = sV + (bufi) * DA_BUF; \
    *(uint4*)(k_ + (kkey) * 136 + kch * 8) = pk0; *(uint4*)(k_ + (kkey + 16) * 136 + kch * 8) = pk1; \
    *(uint4*)(k_ + (kkey + 32) * 136 + kch * 8) = pk2; *(uint4*)(k_ + (kkey + 48) * 136 + kch * 8) = pk3; \
    *(uint4*)(v_ + (ve) * 72 + vch * 8) = pv0; *(uint4*)(v_ + (ve + 32) * 72 + vch * 8) = pv1; \
    *(uint4*)(v_ + (ve + 64) * 72 + vch * 8) = pv2; *(uint4*)(v_ + (ve + 96) * 72 + vch * 8) = pv3; }
  DA_GLOAD(0)
  __syncthreads();
  DA_STORE(0)
  if (64 < nkeys) DA_GLOAD(64)
  __syncthreads();
  for (int k0 = 0; k0 < nkeys; k0 += 64) {
    const int cb_ = (k0 >> 6) & 1;
    const bf16_t* sKc = sK + cb_ * DA_BUF;
    const bf16_t* sVc = sV + cb_ * DA_BUF;
#pragma unroll
    for (int sub = 0; sub < 2; ++sub) {
      f32x16 S;
#pragma unroll
      for (int i = 0; i < 16; ++i) S[i] = -Mb;
      const bf16_t* kp = sKc + (sub * 32 + r) * 136 + c * 64 + h * 8;
      S = MFMA(*(const bf16x8*)(kp), Q0, S);
      S = MFMA(*(const bf16x8*)(kp + 16), Q1, S);
      S = MFMA(*(const bf16x8*)(kp + 32), Q2, S);
      S = MFMA(*(const bf16x8*)(kp + 48), Q3, S);
#pragma unroll
      for (int i = 0; i < 16; i += 2) {
        S[i] = __builtin_amdgcn_exp2f(S[i]); S[i + 1] = __builtin_amdgcn_exp2f(S[i + 1]);
        f2v e2 = {S[i], S[i + 1]};
        ls2 += e2;
      }
      bf16x8 P0, P1;
      P0 = pack8_mfma(S[0], S[1], S[2], S[3], S[4], S[5], S[6], S[7]);
      P1 = pack8_mfma(S[8], S[9], S[10], S[11], S[12], S[13], S[14], S[15]);
#define DA_PV(OX, et)                                                                                   \
      {                                                                                                 \
        const bf16_t* vp = sVc + ((et) * 32 + r) * 72 + sub * 32 + 4 * h;                               \
        s16x4 lo = *(const s16x4*)vp, hi = *(const s16x4*)(vp + 8);                                     \
        s16x4 lo2 = *(const s16x4*)(vp + 16), hi2 = *(const s16x4*)(vp + 24);                           \
        OX = MFMA(__builtin_shufflevector(lo, hi, 0, 1, 2, 3, 4, 5, 6, 7), P0, OX);                     \
        OX = MFMA(__builtin_shufflevector(lo2, hi2, 0, 1, 2, 3, 4, 5, 6, 7), P1, OX);                   \
      }
      DA_PV(O0, 0) DA_PV(O1, 1) DA_PV(O2, 2) DA_PV(O3, 3)
#undef DA_PV
    }
    if (k0 + 64 < nkeys) {
      DA_STORE(cb_ ^ 1)
      if (k0 + 128 < nkeys) DA_GLOAD(k0 + 128)
    }
    __syncthreads();
  }
#undef DA_STORE
  ls = ls2.x + ls2.y;
  ls += __shfl_xor(ls, 32);
  const float scl = c == 0 ? 1.f / ls : lam / ls;
#pragma unroll
  for (int i = 0; i < 16; ++i) { O0[i] *= scl; O1[i] *= scl; O2[i] *= scl; O3[i] *= scl; }
  __syncthreads();
  float* xb = smf + qb * 4096;
  if (c == 1) {
#pragma unroll
    for (int i = 0; i < 16; ++i) {
      int e = crow(i, h);
      xb[(e) * 32 + r] = O0[i]; xb[(32 + e) * 32 + r] = O1[i]; xb[(64 + e) * 32 + r] = O2[i]; xb[(96 + e) * 32 + r] = O3[i];
    }
  }
  __syncthreads();
  if (c == 0) {
    float ss = 0.f;
#pragma unroll
    for (int i = 0; i < 16; ++i) {
      int e = crow(i, h);
      O0[i] -= xb[(e) * 32 + r]; O1[i] -= xb[(32 + e) * 32 + r]; O2[i] -= xb[(64 + e) * 32 + r]; O3[i] -= xb[(96 + e) * 32 + r];
      ss += O0[i] * O0[i] + O1[i] * O1[i] + O2[i] * O2[i] + O3[i] * O3[i];
    }
    ss += __shfl_xor(ss, 32);
    const float inv = rsqrtf(ss * (1.f / 128.f) + 1e-6f) * (1.f - lam_init);
    const float* sub_w = p.in[33] + l * 128;
    const bf16_t* gp_ = w.pD + tokq * SPD + 1024 + hd * 128;
    bf16_t* op = obase + tokq * SPD + hd * 128;
#define DA_ST(OX, et)                                                                                   \
    _Pragma("unroll") for (int g = 0; g < 4; ++g) {                                                     \
      int e0 = (et) * 32 + 8 * g + 4 * h;                                                               \
      uint2 gg = *(const uint2*)(gp_ + e0);                                                             \
      float4 sw = *(const float4*)(sub_w + e0);                                                         \
      float g0 = bf2f((bf16_t)(gg.x & 0xffff)), g1 = bf2f((bf16_t)(gg.x >> 16)), g2 = bf2f((bf16_t)(gg.y & 0xffff)), g3 = bf2f((bf16_t)(gg.y >> 16)); \
      float o0 = OX[4 * g] * inv * sw.x * siluf(g0), o1 = OX[4 * g + 1] * inv * sw.y * siluf(g1);       \
      float o2 = OX[4 * g + 2] * inv * sw.z * siluf(g2), o3 = OX[4 * g + 3] * inv * sw.w * siluf(g3);   \
      *(uint2*)(op + e0) = make_uint2(pack2(o0, o1), pack2(o2, o3));                                    \
    }
    DA_ST(O0, 0) DA_ST(O1, 1) DA_ST(O2, 2) DA_ST(O3, 3)
#undef DA_ST
  }
}

DI void na_wave(CP p, const Ptrs& w, int l, int witem, bool ctxq, bf16_t* obase) {
  const int lane = TIDX & 63, r = lane & 31, h = lane >> 5;
  int b, hd, qi, gr0 = 0, cq = 0, qrow = 0, qcol = 0;
  if (!ctxq) {
    hd = witem & 7; cq = (witem >> 3) & 3; gr0 = ((witem >> 5) & 63) * 2; b = witem >> 11;
    qrow = gr0 + (r >> 4); qcol = cq * 16 + (r & 15); qi = CTXL + qrow * 64 + qcol;
  } else { hd = witem & 7; int qt = (witem >> 3) & 7; b = witem >> 6; qi = qt * 32 + r; }
  const size_t tokq = (size_t)b * TPB + qi;
  const bf16_t* qp = w.pA + tokq * SPA + hd * 64;
  bf16x8 Q[4];
#pragma unroll
  for (int s = 0; s < 4; ++s) Q[s] = *(const bf16x8*)(qp + s * 16 + h * 8);
  const float mq = wave_max(fabsf(p.in[8][l * 64 + lane])), mk = wave_max(fabsf(p.in[9][l * 64 + lane]));
  const float* rpb = p.in[10] + (size_t)(l * 8 + hd) * 15 * 31;
  float mb = 0.f;
  for (int e = lane; e < 465; e += 64) mb = fmaxf(mb, fabsf(rpb[e]));
  mb = wave_max(mb);
  const float Mb = 8.f * LOG2E * mq * mk + mb * LOG2E + 0.5f;
  f32x16 O[2];
#pragma unroll
  for (int e = 0; e < 2; ++e)
#pragma unroll
    for (int i = 0; i < 16; ++i) O[e][i] = 0.f;
  float ls = 0.f;
  const bf16_t* kbase = w.pA + (size_t)b * TPB * SPA + 512 + hd * 64;
  const bf16_t* vbase = w.VtA + (size_t)(b * 512 + hd * 64) * TPB;
  const int r0q = min(max(qrow - 4, 0), 120);
  const int c0 = min(max(qcol - 8, 0), 48);
  const int kr_lo = min(max(gr0 - 4, 0), 120), kr_hi = min(max(gr0 - 3, 0), 120) + 8;
  const int kc0 = min(max(cq * 16 - 8, 0), 32);
  const int ntile = ctxq ? 8 : 8 + (kr_hi - kr_lo);
  auto kidx = [&](int t) { return t < 8 ? t * 32 : CTXL + (kr_lo + (t - 8)) * 64 + kc0; };
  bf16x8 nK0, nK1, nK2, nK3;
  s16x4 nV[8];
#define NA_LOAD(t_) { const int ki_ = kidx(t_); const bf16_t* kp_ = kbase + (size_t)(ki_ + r) * SPA + h * 8; \
    nK0 = *(const bf16x8*)(kp_); nK1 = *(const bf16x8*)(kp_ + 16); nK2 = *(const bf16x8*)(kp_ + 32); nK3 = *(const bf16x8*)(kp_ + 48); \
    _Pragma("unroll") for (int et = 0; et < 2; ++et) _Pragma("unroll") for (int s2 = 0; s2 < 2; ++s2) { \
      const bf16_t* vp_ = vbase + (size_t)(et * 32 + r) * TPB + ki_ + s2 * 16 + 4 * h; \
      nV[(et * 2 + s2) * 2] = *(const s16x4*)vp_; nV[(et * 2 + s2) * 2 + 1] = *(const s16x4*)(vp_ + 8); } }
  NA_LOAD(0)
  for (int t = 0; t < ntile; ++t) {
    bool local = t >= 8;
    const int kr = kr_lo + (t - 8);
    bf16x8 cK0 = nK0, cK1 = nK1, cK2 = nK2, cK3 = nK3;
    s16x4 cV[8];
#pragma unroll
    for (int i = 0; i < 8; ++i) cV[i] = nV[i];
    if (t + 1 < ntile) NA_LOAD(t + 1)
    f32x16 S;
#pragma unroll
    for (int i = 0; i < 16; ++i) S[i] = -Mb;
    S = MFMA(cK0, Q[0], S); S = MFMA(cK1, Q[1], S); S = MFMA(cK2, Q[2], S); S = MFMA(cK3, Q[3], S);
    if (local) {
      const bool row_ok = (kr >= r0q) && (kr < r0q + 8);
      const float* rp = rpb + min(max(kr - qrow + 7, 0), 14) * 31;
#pragma unroll
      for (int i = 0; i < 16; ++i) {
        int kcol = kc0 + crow(i, h);
        bool ok = row_ok && (kcol >= c0) && (kcol < c0 + 16);
        int dc = min(max(kcol - qcol + 15, 0), 30);
        float bias = rp[dc] * LOG2E;
        S[i] = ok ? __builtin_amdgcn_exp2f(S[i] + bias) : 0.f;
      }
    } else {
#pragma unroll
      for (int i = 0; i < 16; ++i) S[i] = __builtin_amdgcn_exp2f(S[i]);
    }
    bf16x8 P[2];
#pragma unroll
    for (int i = 0; i < 16; ++i) ls += S[i];
#pragma unroll
    for (int s2 = 0; s2 < 2; ++s2) {
      P[s2] = pack8_mfma(S[8 * s2 + 0], S[8 * s2 + 1], S[8 * s2 + 2], S[8 * s2 + 3], S[8 * s2 + 4], S[8 * s2 + 5], S[8 * s2 + 6], S[8 * s2 + 7]);
    }
#pragma unroll
    for (int et = 0; et < 2; ++et)
#pragma unroll
      for (int s2 = 0; s2 < 2; ++s2) {
        bf16x8 vf = __builtin_shufflevector(cV[(et * 2 + s2) * 2], cV[(et * 2 + s2) * 2 + 1], 0, 1, 2, 3, 4, 5, 6, 7);
        O[et] = MFMA(vf, P[s2], O[et]);
      }
  }
#undef NA_LOAD
  ls += __shfl_xor(ls, 32);
  const float inv = 1.f / ls;
  const bf16_t* gp_ = w.pA + tokq * SPA + 1024 + hd * 64;
  bf16_t* op = obase + tokq * SPA + hd * 64;
#pragma unroll
  for (int et = 0; et < 2; ++et)
#pragma unroll
    for (int g = 0; g < 4; ++g) {
      int e0 = et * 32 + 8 * g + 4 * h;
      uint2 gg = *(const uint2*)(gp_ + e0);
      float g0 = bf2f((bf16_t)(gg.x & 0xffff)), g1 = bf2f((bf16_t)(gg.x >> 16)), g2 = bf2f((bf16_t)(gg.y & 0xffff)), g3 = bf2f((bf16_t)(gg.y >> 16));
      float o0 = O[et][4 * g] * inv * siluf(g0), o1 = O[et][4 * g + 1] * inv * siluf(g1);
      float o2 = O[et][4 * g + 2] * inv * siluf(g2), o3 = O[et][4 * g + 3] * inv * siluf(g3);
      *(uint2*)(op + e0) = make_uint2(pack2(o0, o1), pack2(o2, o3));
    }
}

template <int MM, int DUMMY = 0>
DI void phase_mixers(CP p, const Ptrs& w, int l, float* sm) {
  __shared__ int s_item;
  const bool ctxo = (l == 0);
  const int n_scan = (MM & 1) ? 256 : 0, n_da = (MM & 2) ? 1024 : 0, n_dac = ((MM & 2) && ctxo) ? 32 : 0;
  const int n_na = (MM & 4) ? 1024 : 0, n_nac = ((MM & 4) && ctxo) ? 32 : 0;
  const int total = n_scan + n_da + n_dac + n_na + n_nac;
  int* ctr = &w.ctr[l * 16 + MM + ((MM != 1) ? DUMMY * 8 : 0)];
  bf16_t* oD = DUMMY ? w.R1 : w.pD; bf16_t* oA = DUMMY ? w.R1 : w.pA;
  if constexpr (MM == 1 && DUMMY == 1) {
    __syncthreads();
    if (TIDX == 0) {
      unsigned hw = (unsigned)__builtin_amdgcn_s_getreg((31 << 11) | 4);
      unsigned key = ((hw >> 8) & 0xffu) | (xb_xcc_id() << 8);
      s_item = atomicAdd(&w.cuf[l * 4096 + key], 1);
    }
    __syncthreads();
    int first = s_item;
    if (first != 0) return;
  }
  for (;;) {
    __syncthreads();
    if (TIDX == 0) s_item = atomicAdd(ctr, 1);
    __syncthreads();
    int it = s_item;
    if (it >= total) break;
    if constexpr ((MM & 1) != 0) {
      if (it < 128) { __builtin_amdgcn_s_setprio(3); rwkv_scan(p, w, l, it, sm); __builtin_amdgcn_s_setprio(0); if (DUMMY) break; continue; }
      if (it < 256) { __builtin_amdgcn_s_setprio(3); mamba_scan(p, w, l, it - 128, sm); __builtin_amdgcn_s_setprio(0); if (DUMMY) break; continue; }
      it -= 256;
    }
    if constexpr ((MM & 2) != 0) {
      if (it < n_da) { int hd = it & 3, qt = (it >> 2) & 127, b = it >> 9; da_block(p, w, l, b, CTXL + qt * 64, TPB, hd, (bf16_t*)sm, (bf16_t*)sm + 64 * 136, sm, oD); continue; }
      it -= n_da;
      if (it < n_dac) { int hd = it & 3, qt = (it >> 2) & 3, b = it >> 4; da_block(p, w, l, b, qt * 64, CTXL, hd, (bf16_t*)sm, (bf16_t*)sm + 64 * 136, sm, oD); continue; }
      it -= n_dac;
    }
    if constexpr ((MM & 4) != 0) {
      if (it < n_na) { na_wave(p, w, l, it * 4 + (TIDX >> 6), false, oA); continue; }
      it -= n_na;
      na_wave(p, w, l, it * 4 + (TIDX >> 6), true, oA);
    }
  }
}

DI void phase_finish(CP p, const Ptrs& w, int l) {
  const int lane = TIDX & 63, gw = BIDX * 4 + (TIDX >> 6), nw = GDIM * 4;
  const int c0 = lane * 8, hd = lane >> 3;
  float lnw[8], lnb[8], muv[8], nrm[8];
#pragma unroll
  for (int j = 0; j < 8; ++j) { lnw[j] = p.in[19][l * 512 + c0 + j]; lnb[j] = p.in[20][l * 512 + c0 + j]; muv[j] = p.in[11][l * 1792 + 1024 + c0 + j]; nrm[j] = p.in[26][l * 512 + c0 + j]; }
  const bf16_t* yB0 = w.R2, *yB1 = w.R2 + (size_t)T * 512, *yM0 = w.R2 + (size_t)2 * T * 512, *yM1 = w.R2 + (size_t)3 * T * 512;
  for (int tok = gw; tok < T; tok += nw) {
    int b = tok / TPB, i = tok - b * TPB;
    if (l != 0 && i < CTXL) continue;
    bool hp = (i != 0) && (i != CTXL), hn = (i != CTXL - 1) && (i != TPB - 1);
    bf16_t* rb = w.pB + (size_t)tok * SPB;
    bf16_t* rc = w.pC + (size_t)tok * SPC + 1040;
    uint4 u0 = *(const uint4*)(yB0 + (size_t)tok * 512 + c0), u1 = *(const uint4*)(yB1 + (size_t)tok * 512 + c0);
    uint4 uv = *(const uint4*)(rb + 1024 + c0), up = make_uint4(0, 0, 0, 0), un = make_uint4(0, 0, 0, 0);
    if (hp) up = *(const uint4*)(rb + 1024 + c0 - SPB);
    if (hn) un = *(const uint4*)(rb + 1024 + c0 + SPB);
    uint4 ug = *(const uint4*)(rb + 1792 + c0);
    const float* bsc = w.bonus + ((size_t)tok * 8 + hd) * 8;
    float2 bon2 = make_float2(bsc[3], bsc[6]);
    uint4 m0 = *(const uint4*)(yM0 + (size_t)tok * 512 + c0), m1 = *(const uint4*)(yM1 + (size_t)tok * 512 + c0);
    uint4 uz = *(const uint4*)(rc + c0);
    float y[8], t[8], vv[8], vp[8], vn[8], g[8];
    unpack8(u0, y); unpack8(u1, t);
    float sm_ = 0.f;
#pragma unroll
    for (int j = 0; j < 8; ++j) { y[j] += t[j]; sm_ += y[j]; }
    float mean = row8_sum(sm_) * (1.f / 64.f);
    float vs = 0.f;
#pragma unroll
    for (int j = 0; j < 8; ++j) { y[j] -= mean; vs += y[j] * y[j]; }
    float rstd = rsqrtf(row8_sum(vs) * (1.f / 64.f) + 64e-5f);
    unpack8(uv, vv); unpack8(up, vp); unpack8(un, vn); unpack8(ug, g);
    float bon = bon2.x + bon2.y;
#pragma unroll
    for (int j = 0; j < 8; ++j) {
      float yn = y[j] * rstd * lnw[j] + lnb[j];
      float v_s = vv[j] + (0.5f * (vp[j] + vn[j]) - vv[j]) * muv[j];
      t[j] = (yn + bon * v_s) * siluf(g[j]);
    }
    *(uint4*)(rb + 1792 + c0) = pack8(t);
    unpack8(m0, y); unpack8(m1, t); unpack8(uz, g);
    float ss = 0.f;
#pragma unroll
    for (int j = 0; j < 8; ++j) { y[j] = (y[j] + t[j]) * siluf(g[j]); ss += y[j] * y[j]; }
    ss = row16_sum(ss); ss += __shfl_xor(ss, 16);
    float inv = rsqrtf(ss * (1.f / 256.f) + 1e-6f);
#pragma unroll
    for (int j = 0; j < 8; ++j) t[j] = y[j] * inv * nrm[j];
    *(uint4*)(rc + c0) = pack8(t);
  }
}

DI void phase_merge(CP p, const Ptrs& w, int l, bf16_t* sA, bf16_t* sB, unsigned* sU) {
  const int tid = TIDX, lane = tid & 63, wid = tid >> 6, wm = wid >> 1, wn = wid & 1, r = lane & 31, h = lane >> 5;
  const bf16_t* gate_t = (const bf16_t*)((const char*)w.R1 + R1_GATE);
  const bf16_t* up_t = (const bf16_t*)((const char*)w.R1 + R1_UP);
  const int nmt = l == 0 ? 132 : 128;
  const int nrounds = tile_rounds(nmt, 16);
  for (int kk = 0; kk < nrounds; ++kk) {
    int mt, nt;
    if (!tile_map(kk, nmt, 16, mt, nt)) continue;
    if (l != 0) mt += mt < 64 ? 2 : 4;
    int m0 = mt * 128, n0 = nt * 128;
    unsigned totp[2][2][8];
#pragma unroll
    for (int a = 0; a < 2; ++a)
#pragma unroll
      for (int c = 0; c < 2; ++c)
#pragma unroll
        for (int i = 0; i < 8; ++i) totp[a][c][i] = 0u;
#pragma unroll 1
    for (int br = 0; br < 4; ++br) {
      const bf16_t* ys; int lds_;
      if (br == 0) { ys = w.pA; lds_ = SPA; } else if (br == 1) { ys = w.pB + 1792; lds_ = SPB; } else if (br == 2) { ys = w.pC + 1040; lds_ = SPC; } else { ys = w.pD; lds_ = SPD; }
      {
        f32x16 U[2][2];
        zero_acc(U);
        gemm_128_2set(ys + (size_t)m0 * lds_, lds_, up_t + (size_t)(br * 2048 + n0) * 512, 512, 512, U, sA, sB);
#pragma unroll
        for (int a = 0; a < 2; ++a)
#pragma unroll
          for (int c = 0; c < 2; ++c)
#pragma unroll
            for (int i = 0; i < 8; ++i) sU[((a * 2 + c) * 8 + i) * 256 + tid] = pack2(U[a][c][2 * i], U[a][c][2 * i + 1]);
      }
      f32x16 G[2][2];
      zero_acc(G);
      gemm_128_2set(w.H + (size_t)m0 * 2048, 2048, gate_t + (size_t)(br * 2048 + n0) * 2048, 2048, 2048, G, sA, sB);
#pragma unroll
      for (int a = 0; a < 2; ++a)
#pragma unroll
        for (int c = 0; c < 2; ++c)
#pragma unroll
          for (int i = 0; i < 8; ++i) {
            unsigned uv = sU[((a * 2 + c) * 8 + i) * 256 + tid];
            float u0 = __uint_as_float(uv << 16), u1 = __uint_as_float(uv & 0xffff0000u);
            const unsigned tv = totp[a][c][i];
            float t0 = __uint_as_float(tv << 16) + sigmf(G[a][c][2 * i]) * u0;
            float t1 = __uint_as_float(tv & 0xffff0000u) + sigmf(G[a][c][2 * i + 1]) * u1;
            totp[a][c][i] = pack2(t0, t1);
          }
    }
    bf16_t* dst = w.R2;
#pragma unroll
    for (int mi = 0; mi < 2; ++mi)
#pragma unroll
      for (int ni = 0; ni < 2; ++ni)
#pragma unroll
        for (int i = 0; i < 16; ++i) {
          int row = m0 + wm * 64 + mi * 32 + crow(i, h), col = n0 + wn * 64 + ni * 32 + r;
          const unsigned tv = totp[mi][ni][i >> 1];
          dst[(size_t)row * 2048 + col] = (bf16_t)((i & 1) ? (tv >> 16) : (tv & 0xffffu));
        }
  }
}

DI void phase_out(CP p, const Ptrs& w, int l, bf16_t* sA, bf16_t* sB) {
  const int tid = TIDX, lane = tid & 63, wid = tid >> 6, wm = wid >> 1, wn = wid & 1, r = lane & 31, h = lane >> 5;
  const bf16_t* out_t = (const bf16_t*)((const char*)w.R1 + R1_OUT);
  const int nmt = l == 0 ? 132 : 128;
  const int nrounds = tile_rounds(nmt, 16);
  for (int kk = 0; kk < nrounds; ++kk) {
    int mt, nt;
    if (!tile_map(kk, nmt, 16, mt, nt)) continue;
    if (l != 0) mt += mt < 64 ? 2 : 4;
    int m0 = mt * 128, n0 = nt * 128;
    int b = m0 / TPB, ib = m0 - b * TPB;
    bool isctx = ib < CTXL;
    f32x16 acc[2][2];
    zero_acc(acc);
    gemm_128_deep(w.R2 + (size_t)m0 * 2048, 2048, out_t + (size_t)n0 * 2048, 2048, 2048, acc, sA, sB);
    const float* gate = w.mod + (l * 3 + (isctx ? 2 : b)) * 6144 + 4096;
#pragma unroll
    for (int mi = 0; mi < 2; ++mi)
#pragma unroll
      for (int ni = 0; ni < 2; ++ni) {
        int col = n0 + wn * 64 + ni * 32 + r;
        float gt = gate[col];
#pragma unroll
        for (int i = 0; i < 16; ++i) {
          int ii = ib + wm * 64 + mi * 32 + crow(i, h);
          const float* src = xrow(p, w, l, b * TPB + ii);
          float* dstp = isctx ? w.xc1 + (size_t)(b * CTXL + ii) * DM : p.out + (size_t)(b * 8192 + ii - CTXL) * DM;
          dstp[col] = src[col] + gt * acc[mi][ni][i];
        }
      }
  }
}

constexpr int SMEM_BYTES = 4 * 128 * 72 * 2;
constexpr int NPH = 18;
#ifndef ONE_LAUNCH
#define ONE_LAUNCH 1
#endif
#ifndef PHMASK
#define PHMASK 0x1ff
#endif

template <int SP>
DI void run_phase(int l, char* smem_raw) {
  CP p = launder_params();
  const Ptrs w = mkptrs(p.ws);
  float* smf = (float*)smem_raw;
  bf16_t* sA = (bf16_t*)smem_raw;
  bf16_t* sB = sA + 128 * 72;
  if constexpr (SP == 0) {
    if (l == 0) {
      if (BIDX == 0 && TIDX < 64) w.ctr[TIDX] = 0;
      if (BIDX >= 2 && BIDX < 34) w.cuf[(BIDX - 2) * 256 + TIDX] = 0;
      if (BIDX == 1) for (int e = TIDX; e < 2048; e += 256) { float ang = (float)(e >> 4) * exp2f(-(float)(e & 15) * (13.287712379549449f / 16.f)); w.rope[2 * e] = cosf(ang); w.rope[2 * e + 1] = sinf(ang); }
      for (int it = BIDX; it < 384; it += GDIM) phase_ada_item(p, w, 0, it, 4, smf);
      conv_w1(p, w, 0, smf);
    }
    conv_w3(p, w, l, smf);
  } else if constexpr (SP == 1) phase_norm(p, w, l);
  else if constexpr (SP == 2) phase_inproj(p, w, l, sA, sB);
  else if constexpr (SP == 3) {
    phase_prep(p, w, l);
  } else if constexpr (SP == 4) phase_lora(p, w, l, sA, sB);
  else if constexpr (SP == 5) phase_mixers<1>(p, w, l, smf);
  else if constexpr (SP == 9) phase_mixers<2>(p, w, l, smf);
  else if constexpr (SP == 10) phase_mixers<4>(p, w, l, smf);
  else if constexpr (SP == 13) phase_rwscal(p, w, l);
  else if constexpr (SP == 14) phase_mixers<1, 1>(p, w, l, smf);
  else if constexpr (SP == 11) phase_mixers<2, 1>(p, w, l, smf);
  else if constexpr (SP == 12) phase_mixers<4, 1>(p, w, l, smf);
  else if constexpr (SP == 6) {
    conv_w2(p, w, l, smf);
    if (l + 1 < 2) conv_w1(p, w, l + 1, smf);
    phase_finish(p, w, l);
  } else if constexpr (SP == 7) phase_merge(p, w, l, sA, sB, (unsigned*)(smem_raw + 2 * 128 * 72 * 2));
  else phase_out(p, w, l, sA, sB);
}

template <int SP>
__global__ void __launch_bounds__(256, 2) phase_kernel(Params p, int l) {
  __shared__ __attribute__((aligned(16))) char smem_raw[SMEM_BYTES];
  run_phase<SP>(l, smem_raw);
}

template <int SP>
__device__ __attribute__((noinline)) void run_phase_ni(int l, char* smem_raw) {
  run_phase<SP>(l, smem_raw);
}
#ifndef CMASK
#define CMASK 0x7fff
#endif
#ifndef DUPMASK
#define DUPMASK 0
#endif
#define RUNP(k) if ((CMASK & (1 << k)) && (pmask & (1 << k))) { run_phase<k>(RP_ARGS); if ((DUPMASK & (1 << k)) && (k != 8 || l == 0)) { xcd_barrier(xb); run_phase<k>(RP_ARGS); } }
#ifdef NOINL
#define run_phase run_phase_ni
#define RP_ARGS l, smem_raw
#else
#define RP_ARGS l, smem_raw
#endif
__global__ void __launch_bounds__(256, 2) fwd_kernel(Params p) {
  __shared__ __attribute__((aligned(16))) char smem_raw[SMEM_BYTES];
#if ONE_LAUNCH
  __shared__ uint4 xb_words;
  if (threadIdx.x == 0) xb_words = make_uint4(0u, 0u, 0u, 0u);
  __syncthreads();
  XcdBarrier xb = xcd_barrier_post((unsigned*)(launder_params().ws + OFF_BAR), (volatile LAS unsigned*)&xb_words);
  const int lmask = launder_params().ph_lo, pmask = launder_params().ph_hi;
#ifdef PROBE_SYNC
  for (int q = 0; q < 50; ++q) xcd_barrier(xb);
#endif
  for (int l = 0; l < 2; ++l) {
    if (!((lmask >> l) & 1)) continue;
    RUNP(0); xcd_barrier(xb);
    if (lmask == 0x7fffffff) cg::this_grid().sync();
    RUNP(1); xcd_barrier(xb);
    RUNP(2); xcd_barrier(xb);
    RUNP(3); xcd_barrier(xb);
    RUNP(4); xcd_barrier(xb);
    RUNP(13); xcd_barrier(xb);
#ifndef SEQMIX
#define SEQMIX 0
#endif
    RUNP(14); if (SEQMIX) xcd_barrier(xb);
#ifdef PROBE_DA
    RUNP(11); xcd_barrier(xb);
#endif
#ifdef PROBE_NA
    RUNP(12); xcd_barrier(xb);
#endif
    RUNP(9); if (SEQMIX) xcd_barrier(xb); RUNP(10); RUNP(5); xcd_barrier(xb);
    RUNP(6); xcd_barrier(xb);
    RUNP(7); xcd_barrier(xb);
    RUNP(8); xcd_barrier(xb);
  }
#endif
}


extern "C" void kernel_launch(void* const* d_in, const int* in_sizes, int n_in, void* d_out, int out_size, void* d_ws, size_t ws_size, hipStream_t stream) {
  static int grid_blocks = 0;
  if (!grid_blocks) {
    int dev = 0, cus = 0, per_cu = 0;
    (void)hipGetDevice(&dev);
    (void)hipDeviceGetAttribute(&cus, hipDeviceAttributeMultiprocessorCount, dev);
    (void)hipOccupancyMaxActiveBlocksPerMultiprocessor(&per_cu, fwd_kernel, 256, 0);
    if (per_cu > 2) per_cu = 2;
    if (per_cu < 1) per_cu = 1;
    grid_blocks = cus * per_cu;
  }
  if (n_in < 37 || ws_size < WS_NEED) { fprintf(stderr, "bad args: n_in=%d ws=%zu need=%zu\n", n_in, ws_size, (size_t)WS_NEED); return; }
  Params p;
  memset(&p, 0, sizeof(p));
  for (int i = 0; i < 37; ++i) p.in[i] = (const float*)d_in[i];
  p.out = (float*)d_out;
  p.ws = (char*)d_ws;
#if ONE_LAUNCH
  p.ph_lo = 3; p.ph_hi = 0x7fff;
  (void)hipMemsetAsync((char*)d_ws + OFF_BAR, 0, XCD_BAR_WORDS * 4, stream);
  (void)hipMemsetAsync((char*)d_ws + OFF_MOD, 0, 3 * 6144 * 4, stream);
  void* args[] = {&p};
  hipError_t e = hipLaunchCooperativeKernel((void*)fwd_kernel, dim3(grid_blocks), dim3(256), args, 0, stream);
  if (e != hipSuccess) fprintf(stderr, "cooperative launch failed: %s (grid %d)\n", hipGetErrorString(e), grid_blocks);
#ifdef PROBE_EXTRA
  {
    (void)hipMemsetAsync((char*)d_ws + OFF_BAR, 0, XCD_BAR_WORDS * 4, stream);
    Params p2 = p; p2.ph_lo = 1; p2.ph_hi = PROBE_EXTRA;
    void* args2[] = {&p2};
    (void)hipLaunchCooperativeKernel((void*)fwd_kernel, dim3(grid_blocks), dim3(256), args2, 0, stream);
  }
#endif
#else
  for (int l = 0; l < 2; ++l) {
    hipLaunchKernelGGL(phase_kernel<0>, dim3(grid_blocks), dim3(256), 0, stream, p, l);
    hipLaunchKernelGGL(phase_kernel<1>, dim3(grid_blocks), dim3(256), 0, stream, p, l);
    hipLaunchKernelGGL(phase_kernel<2>, dim3(grid_blocks), dim3(256), 0, stream, p, l);
    hipLaunchKernelGGL(phase_kernel<3>, dim3(grid_blocks), dim3(256), 0, stream, p, l);
    hipLaunchKernelGGL(phase_kernel<4>, dim3(grid_blocks), dim3(256), 0, stream, p, l);
    hipLaunchKernelGGL(phase_kernel<5>, dim3(grid_blocks), dim3(256), 0, stream, p, l);
    hipLaunchKernelGGL(phase_kernel<9>, dim3(grid_blocks), dim3(256), 0, stream, p, l);
    hipLaunchKernelGGL(phase_kernel<10>, dim3(grid_blocks), dim3(256), 0, stream, p, l);
    hipLaunchKernelGGL(phase_kernel<6>, dim3(grid_blocks), dim3(256), 0, stream, p, l);
    hipLaunchKernelGGL(phase_kernel<7>, dim3(grid_blocks), dim3(256), 0, stream, p, l);
    hipLaunchKernelGGL(phase_kernel<8>, dim3(grid_blocks), dim3(256), 0, stream, p, l);
  }
#endif
}
```
